# Optimizing an MI355X kernel written in HIP

```python
import math
import jax
import jax.numpy as jnp
from jax import lax
import numpy as np

D_MODEL = 2048
BATCH = 4
SEQ = 2048
DEPTH = 4

CTX_LEN = 256
GRID_W = 64
N_MIXERS = 4
N_MOD = 9

N_HEADS = 16
N_KV_HEADS = 4
HEAD_DIM = D_MODEL // N_HEADS
GROUP = N_HEADS // N_KV_HEADS
Q_WIDTH = N_HEADS * HEAD_DIM
KV_WIDTH = N_KV_HEADS * HEAD_DIM
QKV_WIDTH = Q_WIDTH + 2 * KV_WIDTH
Q_BLOCK = 128
WINDOW = 128
ROPE_BASE = 10000.0
ROPE_PAIRS_PER_AXIS = HEAD_DIM // 4

S5_GROUP_SIZE = 16
S5_GROUPS = D_MODEL // S5_GROUP_SIZE
S5_STATE = 64
S5_DT_MIN = 1e-3
S5_DT_MAX = 1e-1
S5_MAX_REAL = -1e-4

MLSTM_HEADS = 8
MLSTM_DQK = D_MODEL // (2 * MLSTM_HEADS)
MLSTM_DV = D_MODEL // MLSTM_HEADS
MLSTM_QK_WIDTH = MLSTM_HEADS * MLSTM_DQK
MLSTM_V_WIDTH = MLSTM_HEADS * MLSTM_DV
MLSTM_IN_WIDTH = 2 * MLSTM_QK_WIDTH + 2 * MLSTM_V_WIDTH
MLSTM_CHUNK = 64
GATE_CAP = 15.0

D_FF = 5632
NORM_EPS = 1e-6

kernel_name = 'hybrid_interleaved_dit_backbone'


def rms_norm(x, gain):
    xf = x.astype(jnp.float32)
    y = xf * lax.rsqrt(jnp.mean(xf * xf, axis=-1, keepdims=True) + NORM_EPS)
    return y.astype(x.dtype) * gain


def modulate(x, gain, shift, scale):
    return rms_norm(x, gain) * (1 + scale) + shift


def swiglu(h, w_in, w_out):
    a, g = jnp.split(h @ w_in, 2, axis=-1)
    return (jax.nn.silu(g) * a) @ w_out


def axial_rope_tables(n_tokens):
    n_rows = n_tokens // GRID_W
    grid = jnp.arange(n_rows * GRID_W)
    row = (grid // GRID_W).astype(jnp.float32)
    col = (grid % GRID_W).astype(jnp.float32)
    inv = ROPE_BASE ** (-jnp.arange(ROPE_PAIRS_PER_AXIS, dtype=jnp.float32) / ROPE_PAIRS_PER_AXIS)
    ang = jnp.concatenate([row[:, None] * inv, col[:, None] * inv], axis=-1)
    ang = jnp.concatenate([ang, ang], axis=-1)
    return jnp.cos(ang), jnp.sin(ang)


def apply_rope(x, cos, sin):
    shape = (1, x.shape[1]) + (1,) * (x.ndim - 3) + (HEAD_DIM,)
    cos = cos.reshape(shape)
    sin = sin.reshape(shape)
    xf = x.astype(jnp.float32)
    x1, x2 = jnp.split(xf, 2, axis=-1)
    rot = jnp.concatenate([-x2, x1], axis=-1)
    return (xf * cos + rot * sin).astype(x.dtype)


def attn_project(h, w_qkv, qk_g, rope):
    b_, t_, _ = h.shape
    q, k, v = jnp.split(h @ w_qkv, [Q_WIDTH, Q_WIDTH + KV_WIDTH], axis=-1)
    q = rms_norm(q.reshape(b_, t_, N_KV_HEADS, GROUP, HEAD_DIM), qk_g[0]) * (HEAD_DIM ** -0.5)
    k = rms_norm(k.reshape(b_, t_, N_KV_HEADS, HEAD_DIM), qk_g[1])
    v = v.reshape(b_, t_, N_KV_HEADS, HEAD_DIM)
    if rope is not None:
        q = apply_rope(q, rope[0], rope[1])
        k = apply_rope(k, rope[0], rope[1])
    return q, k, v


def gqa_scores(q, k):
    return jnp.einsum('btkgd,bskd->bkgts', q, k, preferred_element_type=jnp.float32)


def gqa_values(p, v):
    return jnp.einsum('bkgts,bskd->btkgd', p.astype(v.dtype), v)


def full_attention(hc, hl, w_qkv, qk_g, w_o, rope, ctx_out):
    qc, kc, vc = attn_project(hc, w_qkv, qk_g, None)
    ql, kl, vl = attn_project(hl, w_qkv, qk_g, rope)
    b_, s_ = hl.shape[0], hl.shape[1]
    nb = s_ // Q_BLOCK
    k_all = jnp.concatenate([kc, kl], axis=1)
    v_all = jnp.concatenate([vc, vl], axis=1)

    def block(qb):
        p = jax.nn.softmax(gqa_scores(qb, k_all), axis=-1)
        return gqa_values(p, v_all)

    qb = jnp.moveaxis(ql.reshape(b_, nb, Q_BLOCK, N_KV_HEADS, GROUP, HEAD_DIM), 1, 0)
    ol = jnp.moveaxis(lax.map(block, qb), 0, 1).reshape(b_, s_, Q_WIDTH)
    yl = ol @ w_o
    yc = None
    if ctx_out:
        oc = gqa_values(jax.nn.softmax(gqa_scores(qc, kc), axis=-1), vc)
        yc = oc.reshape(b_, -1, Q_WIDTH) @ w_o
    return yc, yl


def window_attention(hc, hl, w_qkv, qk_g, sink, w_o, rope, ctx_out):
    qc, kc, vc = attn_project(hc, w_qkv, qk_g, None)
    ql, kl, vl = attn_project(hl, w_qkv, qk_g, rope)
    b_, s_ = hl.shape[0], hl.shape[1]
    n_ctx = kc.shape[1]
    nb = s_ // Q_BLOCK
    sink_logit = sink.astype(jnp.float32).reshape(N_KV_HEADS, GROUP, 1, 1)

    def softmax_with_sink(logits):
        sk = jnp.broadcast_to(sink_logit, logits.shape[:-1] + (1,))
        p = jax.nn.softmax(jnp.concatenate([logits, sk], axis=-1), axis=-1)
        return p[..., :-1]

    def band(a):
        ap = jnp.pad(a, ((0, 0), (Q_BLOCK, Q_BLOCK), (0, 0), (0, 0)))
        ap = ap.reshape(b_, nb + 2, Q_BLOCK, N_KV_HEADS, HEAD_DIM)
        w = jnp.concatenate([ap[:, :-2], ap[:, 1:-1], ap[:, 2:]], axis=2)
        return jnp.moveaxis(w, 1, 0)

    tq = jnp.arange(nb)[:, None] * Q_BLOCK + jnp.arange(Q_BLOCK)[None, :]
    tk = (jnp.arange(nb)[:, None] - 1) * Q_BLOCK + jnp.arange(3 * Q_BLOCK)[None, :]
    valid = ((jnp.abs(tq[:, :, None] - tk[:, None, :]) <= WINDOW)
             & (tk >= 0)[:, None, :] & (tk < s_)[:, None, :])

    def block(args):
        qb, kb, vb, vmask = args
        s_ctx = gqa_scores(qb, kc)
        s_loc = jnp.where(vmask, gqa_scores(qb, kb), -jnp.inf)
        p = softmax_with_sink(jnp.concatenate([s_ctx, s_loc], axis=-1))
        return gqa_values(p[..., :n_ctx], vc) + gqa_values(p[..., n_ctx:], vb)

    qb = jnp.moveaxis(ql.reshape(b_, nb, Q_BLOCK, N_KV_HEADS, GROUP, HEAD_DIM), 1, 0)
    ol = lax.map(block, (qb, band(kl), band(vl), valid))
    yl = jnp.moveaxis(ol, 0, 1).reshape(b_, s_, Q_WIDTH) @ w_o
    yc = None
    if ctx_out:
        oc = gqa_values(softmax_with_sink(gqa_scores(qc, kc)), vc)
        yc = oc.reshape(b_, -1, Q_WIDTH) @ w_o
    return yc, yl


def _complex_affine_combine(e1, e2):
    a1r, a1i, b1r, b1i = e1
    a2r, a2i, b2r, b2i = e2
    return (a2r * a1r - a2i * a1i, a2r * a1i + a2i * a1r,
            a2r * b1r - a2i * b1i + b2r, a2r * b1i + a2i * b1r + b2i)


def s5_discretize(lam_re, lam_im, log_dt):
    lr = jnp.minimum(lam_re.astype(jnp.float32), S5_MAX_REAL)
    li = lam_im.astype(jnp.float32)
    dt = jnp.exp(log_dt.astype(jnp.float32))[:, None]
    mag = jnp.exp(lr * dt)
    ar, ai = mag * jnp.cos(li * dt), mag * jnp.sin(li * dt)
    den = lr * lr + li * li
    kr = ((ar - 1) * lr + ai * li) / den
    ki = (ai * lr - (ar - 1) * li) / den
    return ar, ai, kr, ki


def s5_drive(u, b_re, b_im, kr, ki):
    ur = jnp.einsum('tbgc,gnc->tbgn', u, b_re.astype(jnp.float32))
    ui = jnp.einsum('tbgc,gnc->tbgn', u, b_im.astype(jnp.float32))
    return kr * ur - ki * ui, kr * ui + ki * ur


def s5_scan(ar, ai, br, bi, x0, reverse):
    if x0 is not None:
        idx = -1 if reverse else 0
        x0r, x0i = x0
        br = br.at[idx].add(ar * x0r - ai * x0i)
        bi = bi.at[idx].add(ar * x0i + ai * x0r)
    t_ = br.shape[0]
    arb = jnp.broadcast_to(ar, (t_, 1) + ar.shape)
    aib = jnp.broadcast_to(ai, (t_, 1) + ai.shape)
    _, _, xr, xi = lax.associative_scan(_complex_affine_combine, (arb, aib, br, bi), reverse=reverse, axis=0)
    return xr, xi


def s5_readout(xr, xi, c_re, c_im):
    y = (jnp.einsum('tbgn,gcn->tbgc', xr, c_re.astype(jnp.float32))
         - jnp.einsum('tbgn,gcn->tbgc', xi, c_im.astype(jnp.float32)))
    y = jnp.moveaxis(y, 0, 1)
    return y.reshape(y.shape[0], y.shape[1], D_MODEL)


def s5_mixer(hc, hl, lam_re, lam_im, log_dt, b_re, b_im, c_re, c_im, d_skip, w_glu, ctx_out):
    def groups(h):
        return jnp.moveaxis(h.astype(jnp.float32).reshape(h.shape[0], h.shape[1], S5_GROUPS, S5_GROUP_SIZE), 1, 0)

    uc, ul = groups(hc), groups(hl)
    dsk = d_skip.astype(jnp.float32)
    yl = dsk * hl.astype(jnp.float32)
    yc = dsk * hc.astype(jnp.float32)
    for dr in range(2):
        rev = dr == 1
        ar, ai, kr, ki = s5_discretize(lam_re[dr], lam_im[dr], log_dt[dr])
        xcr, xci = s5_scan(ar, ai, *s5_drive(uc, b_re[dr], b_im[dr], kr, ki), None, rev)
        end = 0 if rev else -1
        xlr, xli = s5_scan(ar, ai, *s5_drive(ul, b_re[dr], b_im[dr], kr, ki), (xcr[end], xci[end]), rev)
        yl = yl + s5_readout(xlr, xli, c_re[dr], c_im[dr])
        if ctx_out:
            yc = yc + s5_readout(xcr, xci, c_re[dr], c_im[dr])

    def glu(y):
        z = jax.nn.gelu(y).astype(hl.dtype)
        a, g = jnp.split(z @ w_glu, 2, axis=-1)
        return a * jax.nn.sigmoid(g)

    return (glu(yc) if ctx_out else None), glu(yl)


def mlstm_project(h, w_in, w_gate, b_gate):
    b_, t_, _ = h.shape
    q, k, v, o = jnp.split(h @ w_in, [MLSTM_QK_WIDTH, 2 * MLSTM_QK_WIDTH, 2 * MLSTM_QK_WIDTH + MLSTM_V_WIDTH], axis=-1)

    def heads(a, d):
        return jnp.moveaxis(a.astype(jnp.float32).reshape(b_, t_, MLSTM_HEADS, d), 2, 1)

    q = heads(q, MLSTM_DQK)
    k = heads(k, MLSTM_DQK) * (MLSTM_DQK ** -0.5)
    v = heads(v, MLSTM_DV)
    g = (h @ w_gate + b_gate).astype(jnp.float32)
    g = GATE_CAP * jnp.tanh(g / GATE_CAP)
    g = jnp.moveaxis(g.reshape(b_, t_, 2, 2, MLSTM_HEADS), 1, -1)
    return q, k, v, o, g


def mlstm_chunkwise(q, k, v, ig, fg, state, need_out):
    b_, h_, t_ = ig.shape
    nc = t_ // MLSTM_CHUNK

    def chunks(a):
        a = a.reshape((b_, h_, nc, MLSTM_CHUNK) + a.shape[3:])
        return jnp.moveaxis(a, 2, 0)

    lower = jnp.tril(jnp.ones((MLSTM_CHUNK, MLSTM_CHUNK), dtype=bool))

    def step(carry, xs):
        c_prev, n_prev, m_prev = carry
        qc, kc, vc, ic, fc = xs
        b = jnp.cumsum(jax.nn.log_sigmoid(fc), axis=-1)
        b_end = b[..., -1]
        w_log = b_end[..., None] - b + ic
        m_new = jnp.maximum(b_end + m_prev, jnp.max(w_log, axis=-1))
        decay = jnp.exp(b_end + m_prev - m_new)
        w = jnp.exp(w_log - m_new[..., None])
        c_new = decay[..., None, None] * c_prev + jnp.einsum('bhs,bhsv,bhsk->bhvk', w, vc, kc)
        n_new = decay[..., None] * n_prev + jnp.einsum('bhs,bhsk->bhk', w, kc)
        carry_new = (c_new, n_new, m_new)
        if not need_out:
            return carry_new, None
        d_log = jnp.where(lower, b[..., :, None] - b[..., None, :] + ic[..., None, :], -jnp.inf)
        inter_log = b + m_prev[..., None]
        m_t = jnp.maximum(jnp.max(d_log, axis=-1), inter_log)
        a_inter = jnp.exp(inter_log - m_t)
        s = jnp.einsum('bhtk,bhsk->bhts', qc, kc) * jnp.exp(d_log - m_t[..., None])
        num = jnp.einsum('bhts,bhsv->bhtv', s, vc) + a_inter[..., None] * jnp.einsum('bhvk,bhtk->bhtv', c_prev, qc)
        den = jnp.sum(s, axis=-1) + a_inter * jnp.einsum('bhk,bhtk->bht', n_prev, qc)
        h = num / jnp.maximum(jnp.abs(den), jnp.exp(-m_t))[..., None]
        return carry_new, h

    state, hs = lax.scan(step, state, tuple(chunks(a) for a in (q, k, v, ig, fg)))
    if not need_out:
        return state, None
    return state, jnp.moveaxis(hs, 0, 2).reshape(b_, h_, t_, MLSTM_DV)


def mlstm_mixer(hc, hl, w_in, w_gate, b_gate, norm_g, w_out, ctx_out):
    qc, kc, vc, oc, gc = mlstm_project(hc, w_in, w_gate, b_gate)
    ql, kl, vl, ol, gl = mlstm_project(hl, w_in, w_gate, b_gate)
    b_ = hl.shape[0]
    zero = (jnp.zeros((b_, MLSTM_HEADS, MLSTM_DV, MLSTM_DQK), jnp.float32),
            jnp.zeros((b_, MLSTM_HEADS, MLSTM_DQK), jnp.float32),
            jnp.zeros((b_, MLSTM_HEADS), jnp.float32))
    h_lat = 0.0
    h_ctx = 0.0
    for dr in range(2):
        if dr == 1:
            flip = lambda a: jnp.flip(a, axis=2)
        else:
            flip = lambda a: a
        st_c, hc_dir = mlstm_chunkwise(flip(qc), flip(kc), flip(vc), flip(gc[:, dr, 0]), flip(gc[:, dr, 1]), zero, ctx_out)
        _, hl_dir = mlstm_chunkwise(flip(ql), flip(kl), flip(vl), flip(gl[:, dr, 0]), flip(gl[:, dr, 1]), st_c, True)
        h_lat = h_lat + flip(hl_dir)
        if ctx_out:
            h_ctx = h_ctx + flip(hc_dir)

    def readout(h, o):
        h = jnp.moveaxis(h, 1, 2)
        h = rms_norm(h, norm_g.reshape(MLSTM_HEADS, MLSTM_DV))
        h = h.reshape(h.shape[0], h.shape[1], MLSTM_V_WIDTH).astype(o.dtype) * jax.nn.sigmoid(o)
        return h @ w_out

    return (readout(h_ctx, oc) if ctx_out else None), readout(h_lat, ol)


def setup_inputs(seed: int = 0) -> dict:
    key = jax.random.key(seed)
    ks = iter(jax.random.split(key, 32))
    f32 = jnp.float32

    def nrm(shape, std):
        return jax.random.normal(next(ks), shape, f32) * std

    n_a, n_b, n_c, n_d = [len(range(m, DEPTH, N_MIXERS)) for m in range(N_MIXERS)]
    d = D_MODEL
    x = nrm((BATCH, SEQ, d), 1.0)
    c = nrm((BATCH, d), 1.0)
    ctx = nrm((BATCH, CTX_LEN, d), 1.0)
    c_ctx = nrm((d,), 1.0)
    mod_w = nrm((DEPTH, d, N_MOD * d), 0.5 * d ** -0.5)
    mod_b = nrm((DEPTH, N_MOD * d), 0.02)
    norm_g = 1.0 + nrm((DEPTH, 3, d), 0.02)
    ffn_wi = nrm((DEPTH, 2, d, 2 * D_FF), d ** -0.5)
    ffn_wo = nrm((DEPTH, 2, D_FF, d), D_FF ** -0.5)
    a_wqkv = nrm((n_a, d, QKV_WIDTH), d ** -0.5)
    a_qk_g = 1.0 + nrm((n_a, 2, HEAD_DIM), 0.02)
    a_wo = nrm((n_a, Q_WIDTH, d), Q_WIDTH ** -0.5)
    s5_shape = (n_b, 2, S5_GROUPS, S5_STATE)
    s5_lam_re = -0.5 + nrm(s5_shape, 0.01)
    s5_lam_im = jnp.pi * jnp.arange(S5_STATE, dtype=f32) + nrm(s5_shape, 0.01)
    s5_log_dt = jax.random.uniform(next(ks), (n_b, 2, S5_GROUPS), f32, math.log(S5_DT_MIN), math.log(S5_DT_MAX))
    s5_b_re = nrm((n_b, 2, S5_GROUPS, S5_STATE, S5_GROUP_SIZE), (0.5 / S5_GROUP_SIZE) ** 0.5)
    s5_b_im = nrm((n_b, 2, S5_GROUPS, S5_STATE, S5_GROUP_SIZE), (0.5 / S5_GROUP_SIZE) ** 0.5)
    s5_c_re = nrm((n_b, 2, S5_GROUPS, S5_GROUP_SIZE, S5_STATE), (0.5 / S5_STATE) ** 0.5)
    s5_c_im = nrm((n_b, 2, S5_GROUPS, S5_GROUP_SIZE, S5_STATE), (0.5 / S5_STATE) ** 0.5)
    s5_d = nrm((n_b, d), 1.0)
    s5_w_glu = nrm((n_b, d, 2 * d), d ** -0.5)
    m_w_in = nrm((n_c, d, MLSTM_IN_WIDTH), d ** -0.5)
    m_w_gate = nrm((n_c, d, 4 * MLSTM_HEADS), 0.1 * d ** -0.5)
    i_bias = nrm((n_c, 2, 1, MLSTM_HEADS), 0.1)
    f_bias = jnp.linspace(3.0, 6.0, MLSTM_HEADS, dtype=f32) + nrm((n_c, 2, 1, MLSTM_HEADS), 0.1)
    m_b_gate = jnp.concatenate([i_bias, f_bias], axis=2).reshape(n_c, 4 * MLSTM_HEADS)
    m_norm_g = 1.0 + nrm((n_c, MLSTM_V_WIDTH), 0.02)
    m_w_out = nrm((n_c, MLSTM_V_WIDTH, d), MLSTM_V_WIDTH ** -0.5)
    w_wqkv = nrm((n_d, d, QKV_WIDTH), d ** -0.5)
    w_qk_g = 1.0 + nrm((n_d, 2, HEAD_DIM), 0.02)
    w_sink = nrm((n_d, N_HEADS), 0.5)
    w_wo = nrm((n_d, Q_WIDTH, d), Q_WIDTH ** -0.5)
    return {'x': x, 'c': c, 'ctx': ctx, 'c_ctx': c_ctx,
            'mod_w': mod_w, 'mod_b': mod_b, 'norm_g': norm_g, 'ffn_wi': ffn_wi, 'ffn_wo': ffn_wo,
            'a_wqkv': a_wqkv, 'a_qk_g': a_qk_g, 'a_wo': a_wo,
            's5_lam_re': s5_lam_re, 's5_lam_im': s5_lam_im, 's5_log_dt': s5_log_dt,
            's5_b_re': s5_b_re, 's5_b_im': s5_b_im, 's5_c_re': s5_c_re, 's5_c_im': s5_c_im,
            's5_d': s5_d, 's5_w_glu': s5_w_glu,
            'm_w_in': m_w_in, 'm_w_gate': m_w_gate, 'm_b_gate': m_b_gate, 'm_norm_g': m_norm_g, 'm_w_out': m_w_out,
            'w_wqkv': w_wqkv, 'w_qk_g': w_qk_g, 'w_sink': w_sink, 'w_wo': w_wo}


def reference(x, c, ctx, c_ctx, mod_w, mod_b, norm_g, ffn_wi, ffn_wo,
              a_wqkv, a_qk_g, a_wo,
              s5_lam_re, s5_lam_im, s5_log_dt, s5_b_re, s5_b_im, s5_c_re, s5_c_im, s5_d, s5_w_glu,
              m_w_in, m_w_gate, m_b_gate, m_norm_g, m_w_out,
              w_wqkv, w_qk_g, w_sink, w_wo):
    b_, s_ = x.shape[0], x.shape[1]
    rope = axial_rope_tables(s_)
    xl, xc = x, ctx
    cond_l = jax.nn.silu(c)
    cond_c = jax.nn.silu(c_ctx)
    for i in range(DEPTH):
        kind, occ, last = i % N_MIXERS, i // N_MIXERS, i == DEPTH - 1
        ml = (cond_l @ mod_w[i] + mod_b[i]).reshape(b_, 1, N_MOD, D_MODEL)
        mc = (cond_c @ mod_w[i] + mod_b[i]).reshape(N_MOD, D_MODEL)
        xl = xl + 0.5 * ml[..., 2, :] * swiglu(modulate(xl, norm_g[i, 0], ml[..., 0, :], ml[..., 1, :]), ffn_wi[i, 0], ffn_wo[i, 0])
        xc = xc + 0.5 * mc[..., 2, :] * swiglu(modulate(xc, norm_g[i, 0], mc[..., 0, :], mc[..., 1, :]), ffn_wi[i, 0], ffn_wo[i, 0])
        hl = modulate(xl, norm_g[i, 1], ml[..., 3, :], ml[..., 4, :])
        hc = modulate(xc, norm_g[i, 1], mc[..., 3, :], mc[..., 4, :])
        if kind == 0:
            yc, yl = full_attention(hc, hl, a_wqkv[occ], a_qk_g[occ], a_wo[occ], rope, not last)
        elif kind == 1:
            yc, yl = s5_mixer(hc, hl, s5_lam_re[occ], s5_lam_im[occ], s5_log_dt[occ], s5_b_re[occ], s5_b_im[occ],
                              s5_c_re[occ], s5_c_im[occ], s5_d[occ], s5_w_glu[occ], not last)
        elif kind == 2:
            yc, yl = mlstm_mixer(hc, hl, m_w_in[occ], m_w_gate[occ], m_b_gate[occ], m_norm_g[occ], m_w_out[occ], not last)
        else:
            yc, yl = window_attention(hc, hl, w_wqkv[occ], w_qk_g[occ], w_sink[occ], w_wo[occ], rope, not last)
        xl = xl + ml[..., 5, :] * yl
        xl = xl + 0.5 * ml[..., 8, :] * swiglu(modulate(xl, norm_g[i, 2], ml[..., 6, :], ml[..., 7, :]), ffn_wi[i, 1], ffn_wo[i, 1])
        if not last:
            xc = xc + mc[..., 5, :] * yc
            xc = xc + 0.5 * mc[..., 8, :] * swiglu(modulate(xc, norm_g[i, 2], mc[..., 6, :], mc[..., 7, :]), ffn_wi[i, 1], ffn_wo[i, 1])
    return xl
```

```cpp
#include <hip/hip_runtime.h>
#include <cstdio>
#include <cstdint>

#ifndef MK_PER_PHASE
#define MK_PER_PHASE 0
#endif

#ifndef FAST_MLSTM
#define FAST_MLSTM 1
#endif
#ifndef CTX_SPLIT
#define CTX_SPLIT 1
#endif
#ifndef PROBE_DUP
#define PROBE_DUP 0
#endif
#ifndef FAST_S5
#define FAST_S5 1
#endif
#ifndef FAST_ATTN
#define FAST_ATTN 1
#endif
#ifndef FAST_GEMM
#define FAST_GEMM 1
#endif

#define GAS __attribute__((address_space(1)))
#define LAS __attribute__((address_space(3)))
typedef unsigned short bf16;
typedef float f32x4 __attribute__((ext_vector_type(4)));
typedef float f32x2 __attribute__((ext_vector_type(2)));
typedef unsigned u32x4 __attribute__((ext_vector_type(4)));
typedef unsigned u32x2 __attribute__((ext_vector_type(2)));

constexpr int D = 2048, NB = 4, SEQ = 2048, CTXL = 256, TPB = SEQ + CTXL, NR = NB * TPB;
constexpr int DFF = 5632, NMOD = 9, DEPTH = 4, GRID_W = 64;
constexpr int NH = 16, NKV = 4, HD = 128, QW = 2048, KVW = 512, QKVW = 3072;
constexpr int S5G = 128, S5GS = 16, S5N = 64;
constexpr int MH = 8, MDQK = 128, MDV = 256, MQKW = 1024, MVW = 2048, MINW = 6144;
constexpr float NORM_EPS = 1e-6f, GATE_CAP = 15.0f;
constexpr int NWAVES = 8, NTHREADS = 512;

constexpr size_t MiB = 1u << 20;
constexpr size_t WS_CTL = 0, CTL_BYTES = 1 * MiB;
constexpr size_t WS_MOD = 1 * MiB;
constexpr size_t WS_X = 4 * MiB;
constexpr size_t WS_H = 76 * MiB;
constexpr size_t WS_HID = 112 * MiB;
constexpr size_t WS_Q = 212 * MiB;
constexpr size_t WS_K = 248 * MiB;
constexpr size_t WS_V = 257 * MiB;
constexpr size_t WS_O = 266 * MiB;
constexpr size_t WS_QKVO = 302 * MiB;
constexpr size_t WS_GATES = 410 * MiB;
constexpr size_t WS_HD = 412 * MiB;
constexpr size_t WS_WT = 556 * MiB;
constexpr size_t WT_FFNWI = 0, WT_FFNWO = WT_FFNWI + (size_t)8 * D * 2 * DFF, WT_AWQKV = WT_FFNWO + (size_t)8 * DFF * D, WT_AWO = WT_AWQKV + (size_t)D * QKVW, WT_GLU = WT_AWO + (size_t)D * D,
                 WT_MWIN = WT_GLU + (size_t)D * 2 * D, WT_MWOUT = WT_MWIN + (size_t)D * (MINW + 256), WT_WWQKV = WT_MWOUT + (size_t)D * D, WT_WWO = WT_WWQKV + (size_t)D * QKVW, WT_ELEMS = WT_WWO + (size_t)D * D;
constexpr size_t WS_PEND = 1176 * MiB;
static_assert(WS_WT + WT_ELEMS * 2 <= WS_PEND, "ws map");
constexpr size_t WS_END = WS_PEND + 64 * MiB;

constexpr int CW_BAR = 4096;

__device__ __forceinline__ float bf2f(unsigned v) { return __uint_as_float(v << 16); }
typedef __bf16 bf16x2_t __attribute__((ext_vector_type(2)));
__device__ __forceinline__ unsigned pk2(float lo, float hi) { const f32x2 v = {lo, hi}; const bf16x2_t r = __builtin_convertvector(v, bf16x2_t); return __builtin_bit_cast(unsigned, r); }
__device__ __forceinline__ unsigned f2bf(float f) { return pk2(f, 0.f) & 0xffffu; }
template <int X> __device__ __forceinline__ float swz_xor(float v) { return __int_as_float(__builtin_amdgcn_ds_swizzle(__float_as_int(v), (X << 10) | 0x1f)); }
__device__ __forceinline__ float xor32(float v) { auto rr = __builtin_amdgcn_permlane32_swap(__float_as_uint(v), __float_as_uint(v), false, false); return __uint_as_float(rr[0]) + __uint_as_float(rr[1]) - v; }
__device__ __forceinline__ float wave_sum(float v) {
    v += swz_xor<1>(v); v += swz_xor<2>(v); v += swz_xor<4>(v); v += swz_xor<8>(v); v += swz_xor<16>(v);
    { auto rr = __builtin_amdgcn_permlane32_swap(__float_as_uint(v), __float_as_uint(v), false, false); v = __uint_as_float(rr[0]) + __uint_as_float(rr[1]); }
    return v;
}
__device__ __forceinline__ float sigmoid_f(float v) { return __builtin_amdgcn_rcpf(1.0f + __builtin_amdgcn_exp2f(v * -1.4426950408889634f)); }
__device__ __forceinline__ float silu_f(float v) { return v * sigmoid_f(v); }
__device__ __forceinline__ float gelu_tanh_f(float x) { const float u = 0.7978845608028654f * (x + 0.044715f * x * x * x); return 0.5f * x * (1.0f + tanhf(u)); }
__device__ __forceinline__ int row_ms(int r) { const int b = r / TPB; const int p = r - b * TPB; return p < CTXL ? 4 : b; }

#define XB_TMO      128
#define XB_XCNT(j)  (256  + 64 * (j))
#define XB_XSUB(j)  (1280 + 64 * (j))
#define XB_XGEN(j)  (2304 + 64 * (j))
#define XB_TOP      3328
#define XB_TOPGEN   3392
#define XCD_BAR_WORDS 3456
#define XB_SPIN_CAP (1u << 22)
__device__ __forceinline__ unsigned xb_ld(unsigned* p)              { return __hip_atomic_load(p, __ATOMIC_RELAXED, __HIP_MEMORY_SCOPE_AGENT); }
__device__ __forceinline__ unsigned xb_add(unsigned* p, unsigned v) { return __hip_atomic_fetch_add(p, v, __ATOMIC_RELAXED, __HIP_MEMORY_SCOPE_AGENT); }
__device__ __forceinline__ unsigned xb_xcc_id() { return (unsigned)__builtin_amdgcn_s_getreg((3 << 11) | 20) & 0xFu; }
#define XB_SPIN(cond, bar) do { unsigned _sp = 0; while (cond) { __builtin_amdgcn_s_sleep(1); \
    if ((++_sp & 255u) == 0u) { if (xb_ld(&(bar)[XB_TMO])) break; if (_sp > XB_SPIN_CAP) { atomicAdd(&(bar)[XB_TMO], 1u); break; } } } } while (0)
struct XcdBarrier { unsigned* bar; unsigned x; volatile LAS unsigned* st; };
__device__ __forceinline__ XcdBarrier xcd_barrier_post(unsigned* bar, volatile LAS unsigned* st) {
    XcdBarrier b; b.bar = bar; b.x = xb_xcc_id(); b.st = st;
    if (threadIdx.x == 0) (void)xb_add(&bar[XB_XCNT(b.x)], 1u);
    return b;
}
__device__ __forceinline__ void xcd_barrier_complete(unsigned* bar, unsigned x, unsigned& nloc, unsigned& nx) {
    const unsigned G = gridDim.x * gridDim.y * gridDim.z;
    unsigned sum, cnt, mine, sp = 0u;
    for (;;) {
        sum = 0u; cnt = 0u; mine = 0u;
#pragma unroll
        for (unsigned j = 0; j < 16; ++j) { const unsigned c = xb_ld(&bar[XB_XCNT(j)]); sum += c; cnt += (c > 0u) ? 1u : 0u; mine = (j == x) ? c : mine; }
        if (sum == G) break;
        __builtin_amdgcn_s_sleep(1);
        if ((++sp & 255u) == 0u) { if (xb_ld(&bar[XB_TMO])) break; if (sp > XB_SPIN_CAP) { atomicAdd(&bar[XB_TMO], 1u); break; } }
    }
    nloc = mine > 0u ? mine : 1u; nx = cnt > 0u ? cnt : 1u;
}
__device__ __noinline__ void xcd_barrier(unsigned* bar_, unsigned x_, volatile LAS unsigned* st_) {
    XcdBarrier b; b.bar = bar_; b.x = x_; b.st = st_;
    asm volatile("s_waitcnt vmcnt(0)" ::: "memory");
    __syncthreads();
    if (threadIdx.x == 0) {
        unsigned* bar = b.bar;
        __builtin_amdgcn_s_waitcnt(0);
        unsigned nloc = b.st[0], nx = b.st[1];
        if (nloc == 0u) { xcd_barrier_complete(bar, b.x, nloc, nx); b.st[0] = nloc; b.st[1] = nx; }
        const unsigned old = xb_add(&bar[XB_XSUB(b.x)], 1u);
        const unsigned gen = old / nloc;
        if (old + 1u == (gen + 1u) * nloc) {
            __builtin_amdgcn_fence(__ATOMIC_RELEASE, "agent");
            asm volatile("s_waitcnt vmcnt(0)" ::: "memory");
            const unsigned og = xb_add(&bar[XB_TOP], 1u);
            const unsigned tg = og / nx;
            if (og + 1u == (tg + 1u) * nx) xb_add(&bar[XB_TOPGEN], 1u);
            else XB_SPIN(xb_ld(&bar[XB_TOPGEN]) == tg, bar);
            __builtin_amdgcn_fence(__ATOMIC_ACQUIRE, "agent");
            xb_add(&bar[XB_XGEN(b.x)], 1u);
            asm volatile("s_waitcnt vmcnt(0)" ::: "memory");
        } else {
            XB_SPIN(xb_ld(&bar[XB_XGEN(b.x)]) == gen, bar);
            __builtin_amdgcn_fence(__ATOMIC_ACQUIRE, "agent");
            asm volatile("s_waitcnt vmcnt(0)" ::: "memory");
        }
    }
    __syncthreads();
}

constexpr int LDS_BYTES = 147456;
constexpr int MISC_OFF = 131072 + 320;
struct Args { const float* in[30]; float* out; unsigned char* ws; int ph_lo, ph_hi; };
struct Frame {
    LAS unsigned char* lds; int tid, lane, wave, G, gw, NGW;
    const float* const* in; float* out; unsigned char* ws;
    __device__ __forceinline__ float* MOD() const { return (float*)(ws + WS_MOD); }
    __device__ __forceinline__ float* X() const { return (float*)(ws + WS_X); }
    __device__ __forceinline__ bf16* H() const { return (bf16*)(ws + WS_H); }
    __device__ __forceinline__ bf16* HID() const { return (bf16*)(ws + WS_HID); }
    __device__ __forceinline__ bf16* Q() const { return (bf16*)(ws + WS_Q); }
    __device__ __forceinline__ bf16* K() const { return (bf16*)(ws + WS_K); }
    __device__ __forceinline__ bf16* V() const { return (bf16*)(ws + WS_V); }
    __device__ __forceinline__ bf16* O() const { return (bf16*)(ws + WS_O); }
    __device__ __forceinline__ bf16* QKVO() const { return (bf16*)(ws + WS_QKVO); }
    __device__ __forceinline__ float* GATES() const { return (float*)(ws + WS_GATES); }
    __device__ __forceinline__ float* HDb() const { return (float*)(ws + WS_HD); }
    __device__ __forceinline__ bf16* WT() const { return (bf16*)(ws + WS_WT); }
    __device__ __forceinline__ float* PEND() const { return (float*)(ws + WS_PEND); }
};
__device__ __forceinline__ Frame launder(const Frame& F0) {
    Frame F = F0; asm volatile("" : "+v"(F.tid));
    { unsigned lo = (unsigned)(uintptr_t)F0.ws, hi = (unsigned)((uintptr_t)F0.ws >> 32); asm volatile("" : "+v"(lo), "+v"(hi));
      F.ws = (unsigned char*)(((uintptr_t)(unsigned)__builtin_amdgcn_readfirstlane(hi) << 32) | (uintptr_t)(unsigned)__builtin_amdgcn_readfirstlane(lo)); }
    F.lane = F.tid & 63; F.wave = __builtin_amdgcn_readfirstlane(F.tid >> 6); F.gw = blockIdx.x * NWAVES + F.wave; return F;
}
enum { IN_X = 0, IN_C, IN_CTX, IN_CCTX, IN_MODW, IN_MODB, IN_NORMG, IN_FFNWI, IN_FFNWO, IN_AWQKV, IN_AQKG, IN_AWO,
       IN_S5LRE, IN_S5LIM, IN_S5LDT, IN_S5BRE, IN_S5BIM, IN_S5CRE, IN_S5CIM, IN_S5D, IN_S5WGLU,
       IN_MWIN, IN_MWGATE, IN_MBGATE, IN_MNORMG, IN_MWOUT, IN_WWQKV, IN_WQKG, IN_WSINK, IN_WWO };

__device__ __forceinline__ const float* modp(const Frame& F, int L, int ms, int j) { return F.MOD() + ((size_t)(L * 5 + ms) * NMOD + j) * D; }

__device__ __forceinline__ void ph_init(const Frame& F0) {
    const Frame F = launder(F0);
    const f32x4* xin = (const f32x4*)F.in[IN_X]; const f32x4* cin = (const f32x4*)F.in[IN_CTX]; f32x4* X = (f32x4*)F.X();
    const size_t n4 = (size_t)NR * D / 4, stride = (size_t)F.G * NTHREADS;
    for (size_t i0 = (size_t)blockIdx.x * NTHREADS + F.tid; i0 < n4; i0 += 4 * stride) {
        f32x4 v[4];
#pragma unroll
        for (int k = 0; k < 4; ++k) { const size_t i = i0 + k * stride; const int r = (int)(i / (D / 4)), c4 = (int)(i % (D / 4)); const int b = r / TPB, p = r - b * TPB;
            v[k] = p < CTXL ? cin[((size_t)b * CTXL + p) * (D / 4) + c4] : xin[((size_t)b * SEQ + (p - CTXL)) * (D / 4) + c4]; }
#pragma unroll
        for (int k = 0; k < 4; ++k) X[i0 + k * stride] = v[k];
    }
}
__device__ __forceinline__ void ph_mod(const Frame& F0) {
    const Frame F = launder(F0);
    LAS float* sc = (LAS float*)F.lds;
    for (int i = F.tid; i < 5 * D; i += NTHREADS) { const int ms = i / D, k = i % D; const float v = ms < 4 ? F.in[IN_C][ms * D + k] : F.in[IN_CCTX][k]; sc[i] = silu_f(v); }
    __syncthreads();
    const int NC = NMOD * D;
    for (int idx = blockIdx.x * NTHREADS + F.tid; idx < DEPTH * NC; idx += F.G * NTHREADS) {
        const int L = idx / NC, col = idx % NC; const float* w = F.in[IN_MODW] + (size_t)L * D * NC + col;
        float a0 = 0, a1 = 0, a2 = 0, a3 = 0, a4 = 0;
#pragma unroll 8
        for (int k = 0; k < D; ++k) { const float wv = w[(size_t)k * NC]; a0 += sc[k] * wv; a1 += sc[D + k] * wv; a2 += sc[2 * D + k] * wv; a3 += sc[3 * D + k] * wv; a4 += sc[4 * D + k] * wv; }
        const float bb = F.in[IN_MODB][(size_t)L * NC + col];
        float* o = F.MOD() + (size_t)L * 5 * NC + col;
        o[0] = a0 + bb; o[NC] = a1 + bb; o[2 * NC] = a2 + bb; o[3 * NC] = a3 + bb; o[4 * NC] = a4 + bb;
    }
    __syncthreads();
}
template <bool GATES>
__device__ __forceinline__ void ph_norm(const Frame& F0, int L, int j, const float* pend_gate, float pcoef) {
    const Frame F = launder(F0);
    const float* ng = F.in[IN_NORMG] + (size_t)(L * 3 + j) * D;
    if (!CTX_SPLIT) pend_gate = nullptr;
    for (int r = F.gw; r < NR; r += F.NGW) {
        const int ms = row_ms(r);
        const f32x4* xr = (const f32x4*)(F.X() + (size_t)r * D) + F.lane;
        const f32x4* g4 = (const f32x4*)ng + F.lane; const f32x4* sh4 = (const f32x4*)modp(F, L, ms, 3 * j) + F.lane; const f32x4* sc4 = (const f32x4*)modp(F, L, ms, 3 * j + 1) + F.lane;
        f32x4 v[8], gg[8], shv[8], scv[8]; float ss = 0.f;
#pragma unroll
        for (int q = 0; q < 8; ++q) { v[q] = xr[64 * q]; gg[q] = g4[64 * q]; shv[q] = sh4[64 * q]; scv[q] = sc4[64 * q]; }
        if (pend_gate != nullptr && ms == 4) {
            const int b = r / TPB, cr = b * CTXL + (r - b * TPB); const f32x4* pg4 = (const f32x4*)pend_gate + F.lane; const f32x4* p4 = (const f32x4*)(F.PEND() + (size_t)cr * D) + F.lane;
            f32x4* xw = (f32x4*)(F.X() + (size_t)r * D) + F.lane;
            f32x4 ps[8];
#pragma unroll
            for (int q = 0; q < 8; ++q) { constexpr size_t SL = (size_t)NB * CTXL * D / 4;
                ps[q] = (((p4[64 * q] + p4[64 * q + SL]) + (p4[64 * q + 2 * SL] + p4[64 * q + 3 * SL])) + ((p4[64 * q + 4 * SL] + p4[64 * q + 5 * SL]) + (p4[64 * q + 6 * SL] + p4[64 * q + 7 * SL]))) * pg4[64 * q]; }
#pragma unroll
            for (int q = 0; q < 8; ++q) { v[q] = v[q] + pcoef * ps[q]; xw[64 * q] = v[q]; }
        }
#pragma unroll
        for (int q = 0; q < 8; ++q) ss += (v[q].x * v[q].x + v[q].y * v[q].y) + (v[q].z * v[q].z + v[q].w * v[q].w);
        const float rstd = 1.0f / sqrtf(wave_sum(ss) * (1.0f / D) + NORM_EPS);
        u32x2* o = (u32x2*)(F.H() + (size_t)r * D) + F.lane;
#pragma unroll
        for (int q = 0; q < 8; ++q) { v[q] = (v[q] * rstd) * gg[q] * (scv[q] + 1.0f) + shv[q];
            u32x2 w; w.x = pk2(v[q].x, v[q].y); w.y = pk2(v[q].z, v[q].w); o[64 * q] = w; }
        if constexpr (GATES) {
            LAS float* hrow = (LAS float*)F.lds + F.wave * D;
#pragma unroll
            for (int q = 0; q < 8; ++q) *(LAS f32x4*)(hrow + (F.lane + 64 * q) * 4) = v[q];
            const int t = F.lane & 31, hf = F.lane >> 5; const float* wg = F.in[IN_MWGATE] + t; float acc = 0.f;
#pragma unroll 8
            for (int d = hf * 1024; d < hf * 1024 + 1024; ++d) acc += hrow[d] * wg[(size_t)d * 32];
            { auto rr = __builtin_amdgcn_permlane32_swap(__float_as_uint(acc), __float_as_uint(acc), false, false); acc = __uint_as_float(rr[0]) + __uint_as_float(rr[1]); }
            if (F.lane < 32) { const float g = acc + F.in[IN_MBGATE][t]; F.GATES()[(size_t)r * 32 + t] = GATE_CAP * tanhf(g / GATE_CAP); }
        }
    }
}

struct EpiSwiglu { bf16* HID;
    __device__ __forceinline__ void operator()(int r, int c, f32x4 a, f32x4 g) const {
        u32x2 w; w.x = pk2(silu_f(g.x) * a.x, silu_f(g.y) * a.y); w.y = pk2(silu_f(g.z) * a.z, silu_f(g.w) * a.w);
        *(u32x2*)(HID + (size_t)r * DFF + c) = w; } };
template <int HALF> struct EpiResid { float* X; const float* gate;
    __device__ __forceinline__ void operator()(int r, int c, f32x4 a, f32x4) const {
        const int ms = row_ms(r); const f32x4 g = *(const f32x4*)(gate + (size_t)ms * NMOD * D + c);
        f32x4* xp = (f32x4*)(X + (size_t)r * D + c); *xp = *xp + (HALF ? 0.5f : 1.0f) * (g * a); } };
struct EpiFinal { const float* X; const float* gate; float* out;
    __device__ __forceinline__ void operator()(int r, int c, f32x4 a, f32x4) const {
        const int b = r / TPB, p = r - b * TPB; if (p < CTXL) return;
        const f32x4 g = *(const f32x4*)(gate + (size_t)b * NMOD * D + c);
        *(f32x4*)(out + ((size_t)b * SEQ + (p - CTXL)) * D + c) = *(const f32x4*)(X + (size_t)r * D + c) + 0.5f * (g * a); } };
struct EpiGluResid { float* X; const float* gate;
    __device__ __forceinline__ void operator()(int r, int c, f32x4 a, f32x4 g) const {
        const int ms = row_ms(r); const f32x4 gt = *(const f32x4*)(gate + (size_t)ms * NMOD * D + c);
        f32x4* xp = (f32x4*)(X + (size_t)r * D + c); f32x4 s; s.x = sigmoid_f(g.x); s.y = sigmoid_f(g.y); s.z = sigmoid_f(g.z); s.w = sigmoid_f(g.w);
        *xp = *xp + gt * a * s; } };
struct EpiQKV { bf16 *Q, *K, *V;
    __device__ __forceinline__ void operator()(int r, int c, f32x4 a, f32x4) const {
        u32x2 w; w.x = pk2(a.x, a.y); w.y = pk2(a.z, a.w);
        bf16* p = c < QW ? Q + (size_t)r * QW + c : (c < QW + KVW ? K + (size_t)r * KVW + (c - QW) : V + (size_t)r * KVW + (c - QW - KVW));
        *(u32x2*)p = w; } };
struct EpiMlstmIn { bf16* O; float* G; const float* bg;
    __device__ __forceinline__ void operator()(int r, int c, f32x4 a, f32x4) const {
        if (c < MINW) { u32x2 w; w.x = pk2(a.x, a.y); w.y = pk2(a.z, a.w); *(u32x2*)(O + (size_t)r * MINW + c) = w; }
        else if (c < MINW + 32) { const f32x4 b = *(const f32x4*)(bg + (c - MINW)); f32x4 g;
            g.x = GATE_CAP * tanhf((a.x + b.x) * (1.0f / GATE_CAP)); g.y = GATE_CAP * tanhf((a.y + b.y) * (1.0f / GATE_CAP)); g.z = GATE_CAP * tanhf((a.z + b.z) * (1.0f / GATE_CAP)); g.w = GATE_CAP * tanhf((a.w + b.w) * (1.0f / GATE_CAP));
            *(f32x4*)(G + (size_t)r * 32 + (c - MINW)) = g; }
    } };
struct EpiBf16 { bf16* O; int ld;
    __device__ __forceinline__ void operator()(int r, int c, f32x4 a, f32x4) const { u32x2 w; w.x = pk2(a.x, a.y); w.y = pk2(a.z, a.w); *(u32x2*)(O + (size_t)r * ld + c) = w; } };

template <bool DUAL, class Epi>
__device__ __forceinline__ void gemm_naive(const Frame& F0, const bf16* A, int lda, const float* W, int ldw, int M, int N, int K, int dual_off, const Epi E) {
    const Frame F = launder(F0);
    constexpr int BM = 128, BN = 128, BK = 16;
    LAS float* As = (LAS float*)F.lds;
    LAS float* Bs = As + BK * (BM + 4);
    LAS float* B2 = Bs + BK * BN;
    const int ty = F.tid >> 5, tx = F.tid & 31;
    const int ntm = M / BM, ntn = N / BN, nt = ntm * ntn;
    for (int t = blockIdx.x; t < nt; t += F.G) {
        const int tm = t / ntn, tn = t % ntn; const int m0 = tm * BM, n0 = tn * BN;
        f32x4 acc[8], acc2[8];
#pragma unroll
        for (int i = 0; i < 8; ++i) { acc[i] = (f32x4){0.f, 0.f, 0.f, 0.f}; acc2[i] = (f32x4){0.f, 0.f, 0.f, 0.f}; }
        for (int k0 = 0; k0 < K; k0 += BK) {
            { const int row = F.tid >> 2, kq = (F.tid & 3) * 4; const u32x2 w = *(const u32x2*)(A + (size_t)(m0 + row) * lda + k0 + kq);
              As[(kq + 0) * (BM + 4) + row] = bf2f(w.x & 0xffffu); As[(kq + 1) * (BM + 4) + row] = bf2f(w.x >> 16); As[(kq + 2) * (BM + 4) + row] = bf2f(w.y & 0xffffu); As[(kq + 3) * (BM + 4) + row] = bf2f(w.y >> 16); }
            { const int kk = F.tid >> 5, c4 = (F.tid & 31) * 4; *(LAS f32x4*)(Bs + kk * BN + c4) = *(const f32x4*)(W + (size_t)(k0 + kk) * ldw + n0 + c4);
              if constexpr (DUAL) *(LAS f32x4*)(B2 + kk * BN + c4) = *(const f32x4*)(W + (size_t)(k0 + kk) * ldw + dual_off + n0 + c4); }
            __syncthreads();
#pragma unroll
            for (int kk = 0; kk < BK; ++kk) {
                const f32x4 a0 = *(LAS f32x4*)(As + kk * (BM + 4) + ty * 8), a1 = *(LAS f32x4*)(As + kk * (BM + 4) + ty * 8 + 4);
                const f32x4 b = *(LAS f32x4*)(Bs + kk * BN + tx * 4);
                acc[0] += a0.x * b; acc[1] += a0.y * b; acc[2] += a0.z * b; acc[3] += a0.w * b; acc[4] += a1.x * b; acc[5] += a1.y * b; acc[6] += a1.z * b; acc[7] += a1.w * b;
                if constexpr (DUAL) { const f32x4 b2 = *(LAS f32x4*)(B2 + kk * BN + tx * 4);
                    acc2[0] += a0.x * b2; acc2[1] += a0.y * b2; acc2[2] += a0.z * b2; acc2[3] += a0.w * b2; acc2[4] += a1.x * b2; acc2[5] += a1.y * b2; acc2[6] += a1.z * b2; acc2[7] += a1.w * b2; }
            }
            __syncthreads();
        }
#pragma unroll
        for (int i = 0; i < 8; ++i) E(m0 + ty * 8 + i, n0 + tx * 4, acc[i], acc2[i]);
    }
}

namespace pg8 {
#define PG8_LAS __attribute__((address_space(3)))
typedef unsigned short bf16_t;
typedef short bf16x8 __attribute__((ext_vector_type(8)));
typedef float f32x4 __attribute__((ext_vector_type(4)));
typedef unsigned u32x4 __attribute__((ext_vector_type(4)));
constexpr int BM = 256, BK = 64, HALF = 128, HTB = HALF * BK * 2  , STAGE_BYTES = 8 * HTB, NXCD = 8, WGM = 8;

__host__ __device__ __forceinline__ int lds_byte(int r, int c) { const int st = (r >> 4) * 2 + (c >> 5), rr = r & 15, cc = c & 31, ob = rr * 64 + cc * 2; return st * 1024 + (ob ^ (((ob >> 9) & 1) << 5)); }
__host__ __device__ __forceinline__ void stage_rc(int b, int& R, int& C) { const int st = b / 1024, sb = b % 1024, swz = sb ^ (((sb >> 9) & 1) << 5); R = (st >> 1) * 16 + swz / 64; C = (st & 1) * 32 + (swz % 64) / 2; }
__host__ __device__ __forceinline__ int perm32(int rho) { const int n = rho >> 4, i = rho & 15; return 8 * (i >> 2) + 4 * n + (i & 3); }

struct Unit { int pm, pn, ks; };
struct Gemm { const bf16_t* A; const bf16_t* Bt; int lda, ldb; };

struct StaticOrder {
    int nM, nN, nwg, G, c;
    __host__ __device__ void init(int M, int N, int G_, int c_) { nM = M / BM; nN = N / BM; nwg = nM * nN; G = G_; c = c_; }
    __host__ __device__ bool next(int i, Unit& u) const {
        const long L = (long)i * G + c; if (L >= nwg) { u.pm = 0; u.pn = 0; return false; }
        int wgid = (int)L; { const int q = nwg / NXCD, r = nwg % NXCD, xcd = wgid % NXCD, off = wgid / NXCD; wgid = (xcd < r ? xcd * (q + 1) : r * (q + 1) + (xcd - r) * q) + off; }
        const int nig = WGM * nN, gid = wgid / nig, fm = gid * WGM, gsz = (nM - fm) < WGM ? (nM - fm) : WGM;
        u.pm = fm + ((wgid % nig) % gsz); u.pn = (wgid % nig) / gsz; return true;
    }
    __device__ __forceinline__ void a_ready(const Unit&) const {}
    __device__ __forceinline__ void done(const Unit&) const {}
};
struct TileSched {
    StaticOrder so; int lat, ctx_split, lda, ldb, ntK;
    __device__ __forceinline__ void init(int nMlog, int Nbt, int G, int c, int lat_, int ctx_split_, int lda_, int ldb_, int K) { so.init(nMlog * BM, Nbt, G, c); lat = lat_; ctx_split = ctx_split_; lda = lda_; ldb = ldb_; ntK = K / BK; }
    __device__ __forceinline__ bool next(int i, Unit& u) const {
        Unit t; t.pm = 0; t.pn = 0; t.ks = -1; const bool main = so.next(i, t);
        int pm = lat ? t.pm + t.pm / 8 + 1 : t.pm, pn = t.pn, ks = -1; bool ok = main;
        if (!main && ctx_split) { const long e = (long)i * so.G + so.c - so.nwg; ok = (e >= 0 && e < 256); const int tile = (int)e >> 3; ks = (int)e & 7; pm = 9 * (tile >> 3); pn = tile & 7; }
        u.pm = pm; u.pn = pn; u.ks = ks; return ok;
    }
    __device__ __forceinline__ int n1() const { return (((ntK >> 2) >> 1) + 1) & ~1; }
    __device__ __forceinline__ int k0(const Unit& u) const { return u.ks <= 0 ? 0 : (ntK >> 2) * (u.ks >> 1) + ((u.ks & 1) ? n1() : 0); }
    __device__ __forceinline__ int nt(const Unit& u) const { return u.ks < 0 ? ntK : ((u.ks & 1) ? (ntK >> 2) - n1() : n1()); }
    __device__ __forceinline__ size_t a_off(const Unit& u) const { return ((size_t)u.pm * BM * lda + (size_t)k0(u) * BK) * 2; }
    __device__ __forceinline__ size_t b_off(const Unit& u) const { return ((size_t)u.pn * BM * ldb + (size_t)k0(u) * BK) * 2; }
    __device__ __forceinline__ void a_ready(const Unit&) const {}
    __device__ __forceinline__ void done(const Unit&) const {}
};
template <class Epi, class Sched, bool ALIGN_EPI = false, bool SP2 = false>
__device__ __forceinline__ void gemm_phase(PG8_LAS unsigned char* lds, const Gemm g, const Sched& S, const Epi& E) {
    int tid_ = threadIdx.x; asm volatile("" : "+v"(tid_));
    const int tid = tid_, wid = __builtin_amdgcn_readfirstlane(tid >> 6), lane = tid & 63, wr = wid >> 2, wc = wid & 3, fr = lane & 15, fq = lane >> 4;
    unsigned voffA[2], voffB[2];
#pragma unroll
    for (int i = 0; i < 2; ++i) { int R, C; stage_rc(tid * 16 + i * 8192, R, C); const int Rb = Epi::PERM ? ((R & ~31) + perm32(R & 31)) : R;
        voffA[i] = (unsigned)(R * g.lda + C) * 2u; voffB[i] = (unsigned)(Rb * g.ldb + C) * 2u; }
    const size_t kstep = (size_t)(BK * 2);
    const size_t hstepA = (size_t)HALF * g.lda * 2, hstepB = (size_t)HALF * g.ldb * 2;
    const unsigned ldsw = (unsigned)wid * 1024u;
    const int aoff = lds_byte(wr * 64 + fr, fq * 8), boff = lds_byte(wc * 32 + fr, fq * 8);
#define PG8_SA(b, h) (((b) * 2 + (h)) * HTB)
#define PG8_SB(b, h) ((4 + (b) * 2 + (h)) * HTB)
#define PG8_STAGE(bufoff, gbase, voff) do { _Pragma("unroll") for (int _i = 0; _i < 2; ++_i) \
        __builtin_amdgcn_global_load_lds((const unsigned*)((const char*)(gbase) + (voff)[_i]), (PG8_LAS unsigned*)(lds + (bufoff) + ldsw + _i * 8192), 16, 0, 0); } while (0)
#define PG8_LDA(dst, b, h) do { _Pragma("unroll") for (int m = 0; m < 4; ++m) _Pragma("unroll") for (int k = 0; k < 2; ++k) dst[m][k] = *(const PG8_LAS bf16x8*)(lds + PG8_SA(b, h) + aoff + m * 2048 + k * 1024); } while (0)
#define PG8_LDB(dst, b, h) do { _Pragma("unroll") for (int n = 0; n < 2; ++n) _Pragma("unroll") for (int k = 0; k < 2; ++k) dst[n][k] = *(const PG8_LAS bf16x8*)(lds + PG8_SB(b, h) + boff + n * 2048 + k * 1024); } while (0)
#define PG8_MMA(ai, bj, At, Bt) do { __builtin_amdgcn_s_setprio(1); _Pragma("unroll") for (int m = 0; m < 4; ++m) _Pragma("unroll") for (int n = 0; n < 2; ++n) _Pragma("unroll") for (int k = 0; k < 2; ++k) \
        acc[ai][bj][m][n] = __builtin_amdgcn_mfma_f32_16x16x32_bf16(Bt[n][k], At[m][k], acc[ai][bj][m][n], 0, 0, 0); __builtin_amdgcn_s_setprio(0); } while (0)
#define PG8_WAIT_V(n) asm volatile("s_waitcnt vmcnt(" #n ")" ::: "memory")
#define PG8_WAIT_L(n) asm volatile("s_waitcnt lgkmcnt(" #n ")" ::: "memory")
#define PG8_BAR __builtin_amdgcn_s_barrier()
#define PG8_SCHED __builtin_amdgcn_sched_barrier(0)
    Unit cur, nxt; int ui = 0;
    if (!S.next(0, cur)) return;
    f32x4 acc[2][2][4][2];
#pragma unroll
    for (int a = 0; a < 2; ++a)
#pragma unroll
        for (int b = 0; b < 2; ++b)
#pragma unroll
            for (int m = 0; m < 4; ++m)
#pragma unroll
                for (int n = 0; n < 2; ++n) acc[a][b][m][n] = (f32x4){0.f, 0.f, 0.f, 0.f};
    bf16x8 At[4][2], B0[2][2], B1[2][2];
    const char* cA = (const char*)g.A + S.a_off(cur); const char* cB = (const char*)g.Bt + S.b_off(cur);
    S.a_ready(cur);
    if constexpr (SP2) {
        PG8_STAGE(PG8_SB(0, 0), cB, voffB); PG8_STAGE(PG8_SB(0, 1), cB + hstepB, voffB); PG8_STAGE(PG8_SA(0, 0), cA, voffA); PG8_STAGE(PG8_SA(0, 1), cA + hstepA, voffA);
        if (wr == 1) PG8_BAR;
        PG8_WAIT_V(2); PG8_BAR;
        PG8_STAGE(PG8_SB(1, 0), cB + kstep, voffB); PG8_STAGE(PG8_SA(1, 0), cA + kstep, voffA); PG8_STAGE(PG8_SB(1, 1), cB + hstepB + kstep, voffB);
        PG8_WAIT_V(6); PG8_BAR;
    } else {
        PG8_STAGE(PG8_SB(0, 0), cB, voffB); PG8_STAGE(PG8_SA(0, 0), cA, voffA); PG8_STAGE(PG8_SB(0, 1), cB + hstepB, voffB); PG8_STAGE(PG8_SA(0, 1), cA + hstepA, voffA);
        if (wr == 1) PG8_BAR;
        PG8_WAIT_V(4); PG8_BAR;
        PG8_STAGE(PG8_SB(1, 0), cB + kstep, voffB); PG8_STAGE(PG8_SA(1, 0), cA + kstep, voffA); PG8_STAGE(PG8_SB(1, 1), cB + hstepB + kstep, voffB);
        PG8_WAIT_V(6); PG8_BAR;
    }
    for (;;) {
        const bool has_next = S.next(ui + 1, nxt);
        const char* nA = has_next ? (const char*)g.A + S.a_off(nxt) : cA; const char* nB = has_next ? (const char*)g.Bt + S.b_off(nxt) : cB;
        const int nt = S.nt(cur);
        for (int t = 0; t < nt; t += 2) {
            const bool last = (t == nt - 2);
            const char* a1 = cA + (size_t)(t + 1) * kstep;
            const char* a2 = last ? nA : cA + (size_t)(t + 2) * kstep; const char* b2 = last ? nB : cB + (size_t)(t + 2) * kstep;
            const char* a3 = a2 + kstep; const char* b3 = b2 + kstep;
            if (last && has_next) S.a_ready(nxt);
            if constexpr (SP2) {
            PG8_LDB(B0, 0, 0); PG8_LDB(B1, 0, 1); PG8_SCHED; PG8_LDA(At, 0, 0); PG8_STAGE(PG8_SA(1, 1), a1 + hstepA, voffA);
            PG8_WAIT_V(8); PG8_WAIT_L(0); PG8_BAR; PG8_MMA(0, 0, At, B0); PG8_MMA(0, 1, At, B1); PG8_BAR; PG8_SCHED;
            PG8_LDA(At, 0, 1); PG8_STAGE(PG8_SB(0, 0), b2, voffB); PG8_STAGE(PG8_SB(0, 1), b2 + hstepB, voffB); PG8_STAGE(PG8_SA(0, 0), a2, voffA);
            PG8_WAIT_V(8); PG8_WAIT_L(0); PG8_BAR; PG8_MMA(1, 0, At, B0); PG8_MMA(1, 1, At, B1); PG8_BAR; PG8_SCHED;
            PG8_LDB(B0, 1, 0); PG8_LDB(B1, 1, 1); PG8_SCHED; PG8_LDA(At, 1, 0); PG8_STAGE(PG8_SA(0, 1), a2 + hstepA, voffA);
            PG8_WAIT_V(8); PG8_WAIT_L(0); PG8_BAR; PG8_MMA(0, 0, At, B0); PG8_MMA(0, 1, At, B1); PG8_BAR; PG8_SCHED;
            PG8_LDA(At, 1, 1); PG8_STAGE(PG8_SB(1, 0), b3, voffB); PG8_STAGE(PG8_SB(1, 1), b3 + hstepB, voffB); PG8_STAGE(PG8_SA(1, 0), a3, voffA);
            PG8_WAIT_V(8); PG8_WAIT_L(0); PG8_BAR; PG8_MMA(1, 0, At, B0); PG8_MMA(1, 1, At, B1); PG8_BAR; PG8_SCHED;
            } else {
            PG8_LDB(B0, 0, 0); PG8_SCHED; PG8_LDA(At, 0, 0); PG8_STAGE(PG8_SA(1, 1), a1 + hstepA, voffA);
            PG8_WAIT_L(8); PG8_BAR; PG8_WAIT_L(0); PG8_MMA(0, 0, At, B0); PG8_BAR; PG8_SCHED;
            PG8_LDB(B1, 0, 1); PG8_STAGE(PG8_SB(0, 0), b2, voffB);
            PG8_BAR; PG8_WAIT_L(0); PG8_MMA(0, 1, At, B1); PG8_BAR;
            PG8_LDA(At, 0, 1); PG8_STAGE(PG8_SA(0, 0), a2, voffA);
            PG8_BAR; PG8_WAIT_L(0); PG8_MMA(1, 0, At, B0); PG8_BAR; PG8_SCHED;
            PG8_STAGE(PG8_SB(0, 1), b2 + hstepB, voffB);
            PG8_WAIT_V(6); PG8_BAR; PG8_MMA(1, 1, At, B1); PG8_BAR;
            PG8_LDB(B0, 1, 0); PG8_SCHED; PG8_LDA(At, 1, 0); PG8_STAGE(PG8_SA(0, 1), a2 + hstepA, voffA);
            PG8_WAIT_L(8); PG8_BAR; PG8_WAIT_L(0); PG8_MMA(0, 0, At, B0); PG8_BAR; PG8_SCHED;
            PG8_LDB(B1, 1, 1); PG8_STAGE(PG8_SB(1, 0), b3, voffB);
            PG8_BAR; PG8_WAIT_L(0); PG8_MMA(0, 1, At, B1); PG8_BAR;
            PG8_LDA(At, 1, 1); PG8_STAGE(PG8_SA(1, 0), a3, voffA);
            PG8_BAR; PG8_WAIT_L(0); PG8_MMA(1, 0, At, B0); PG8_BAR; PG8_SCHED;
            PG8_STAGE(PG8_SB(1, 1), b3 + hstepB, voffB);
            PG8_WAIT_V(6); PG8_BAR; PG8_MMA(1, 1, At, B1); PG8_BAR;
            }
        }
        if constexpr (ALIGN_EPI) { if (wr == 0) PG8_BAR; }
        if constexpr (!Epi::AFTER_DRAIN) { E(acc, cur, wr, wc, fr, fq); S.done(cur); }
        if (!has_next) break;
#pragma unroll
        for (int a = 0; a < 2; ++a)
#pragma unroll
            for (int b = 0; b < 2; ++b)
#pragma unroll
                for (int m = 0; m < 4; ++m)
#pragma unroll
                    for (int n = 0; n < 2; ++n) acc[a][b][m][n] = (f32x4){0.f, 0.f, 0.f, 0.f};
        cur = nxt; cA = nA; cB = nB; ++ui;
        if constexpr (ALIGN_EPI) { if (wr == 1) PG8_BAR; }
    }
    PG8_WAIT_V(0);
    if constexpr (!ALIGN_EPI) { if (wr == 0) PG8_BAR; }
    PG8_BAR;
    if constexpr (Epi::AFTER_DRAIN) { E.fused(acc, cur, wr, wc, fr, fq, lds, wid, lane); S.done(cur); }
#undef PG8_SA
#undef PG8_SB
#undef PG8_STAGE
#undef PG8_LDA
#undef PG8_LDB
#undef PG8_MMA
#undef PG8_WAIT_V
#undef PG8_WAIT_L
#undef PG8_BAR
#undef PG8_SCHED
}
}

template <int KIND> struct EpiRmw { static constexpr bool RMW = true; float* X; const float* gate; float* out; };
template <int KIND, bool DUAL>
__device__ __forceinline__ void rmw_tile(const EpiRmw<KIND>& e, const pg8::f32x4 (&acc)[2][2][4][2], const pg8::Unit& u, int wr, int wc, int fr, int fq) {
    constexpr int NC = DUAL ? 2 : 4;
    const int b = u.pm / 9, ms = (u.pm - 9 * b) == 0 ? 4 : b;
    int col[NC]; f32x4 gv[NC];
#pragma unroll
    for (int k = 0; k < NC; ++k) { col[k] = DUAL ? u.pn * 128 + wc * 32 + k * 16 + 4 * fq : u.pn * 256 + (k >> 1) * 128 + wc * 32 + (k & 1) * 16 + 4 * fq;
        gv[k] = *(const f32x4*)(e.gate + (size_t)ms * NMOD * D + col[k]); if (KIND == 1 || KIND == 2) gv[k] = gv[k] * 0.5f; }
#pragma unroll
    for (int ai = 0; ai < 2; ++ai)
#pragma unroll
        for (int mp = 0; mp < 2; ++mp) {
            f32x4 x[2][NC];
#pragma unroll
            for (int mi = 0; mi < 2; ++mi) { const int r = u.pm * 256 + ai * 128 + wr * 64 + (2 * mp + mi) * 16 + fr;
#pragma unroll
                for (int k = 0; k < NC; ++k) x[mi][k] = *(const f32x4*)(e.X + (size_t)r * D + col[k]); }
#pragma unroll
            for (int mi = 0; mi < 2; ++mi) { const int m = 2 * mp + mi, rl = ai * 128 + wr * 64 + m * 16 + fr, r = u.pm * 256 + rl;
                float* dst = KIND == 2 ? e.out + ((size_t)b * SEQ + (size_t)(u.pm - 9 * b - 1) * 256 + rl) * D : e.X + (size_t)r * D;
#pragma unroll
                for (int k = 0; k < NC; ++k) { f32x4 a;
                    if constexpr (DUAL) { const f32x4 aa = acc[ai][0][m][k], gg = acc[ai][1][m][k]; a.x = aa.x * sigmoid_f(gg.x); a.y = aa.y * sigmoid_f(gg.y); a.z = aa.z * sigmoid_f(gg.z); a.w = aa.w * sigmoid_f(gg.w); }
                    else a = acc[ai][k >> 1][m][k & 1];
                    *(f32x4*)(dst + col[k]) = x[mi][k] + gv[k] * a; } }
            asm volatile("" ::: "memory");
        }
}
template <class T> struct is_rmw { static constexpr bool value = false; static constexpr int kind = -1; };
template <int KIND> struct is_rmw<EpiRmw<KIND>> { static constexpr bool value = true; static constexpr int kind = KIND; };

template <bool DUAL, class SE> struct EpiWrap {
    static constexpr bool PERM = false, AFTER_DRAIN = false;
    SE e;
    __device__ __forceinline__ void operator()(const pg8::f32x4 (&acc)[2][2][4][2], const pg8::Unit& u, int wr, int wc, int fr, int fq) const {
        if constexpr (is_rmw<SE>::value) { rmw_tile<is_rmw<SE>::kind, DUAL>(e, acc, u, wr, wc, fr, fq); return; } else {
#pragma unroll
        for (int ai = 0; ai < 2; ++ai)
#pragma unroll
            for (int m = 0; m < 4; ++m) { const int r = u.pm * 256 + ai * 128 + wr * 64 + m * 16 + fr;
                if constexpr (DUAL) {
#pragma unroll
                    for (int n = 0; n < 2; ++n) e(r, u.pn * 128 + wc * 32 + n * 16 + 4 * fq, acc[ai][0][m][n], acc[ai][1][m][n]);
                } else {
#pragma unroll
                    for (int bj = 0; bj < 2; ++bj)
#pragma unroll
                        for (int n = 0; n < 2; ++n) e(r, u.pn * 256 + bj * 128 + wc * 32 + n * 16 + 4 * fq, acc[ai][bj][m][n], acc[ai][bj][m][n]);
                }
                asm volatile("" ::: "memory"); }
        }
    }
};
template <bool DUAL, class SE>
__device__ __forceinline__ void gemm_fast(const Frame& F, const bf16* A, const bf16* Bt, int nMlog, int lat, int Nbt, int K, const SE e) {
    pg8::Gemm g{A, Bt, K, K}; pg8::TileSched S; S.init(nMlog, Nbt, F.G, (int)blockIdx.x, lat, 0, K, K, K);
    EpiWrap<DUAL, SE> E{e};
    pg8::gemm_phase<EpiWrap<DUAL, SE>, pg8::TileSched, true, true>(F.lds, g, S, E);
}
template <class SE> struct EpiDownWrap {
    static constexpr bool PERM = false, AFTER_DRAIN = false;
    SE e; float* P;
    __device__ __forceinline__ void operator()(const pg8::f32x4 (&acc)[2][2][4][2], const pg8::Unit& u, int wr, int wc, int fr, int fq) const {
        if (u.ks < 0) { rmw_tile<is_rmw<SE>::kind, false>(e, acc, u, wr, wc, fr, fq); return; }
#pragma unroll
        for (int ai = 0; ai < 2; ++ai)
#pragma unroll
            for (int m = 0; m < 4; ++m) { const int rl = ai * 128 + wr * 64 + m * 16 + fr, r = u.pm * 256 + rl;
                if (u.ks < 0) { (void)r; } else { float* pr = P + ((size_t)u.ks * (NB * CTXL) + (u.pm / 9) * 256 + rl) * D + u.pn * 256 + wc * 32 + 4 * fq;
#pragma unroll
                    for (int bj = 0; bj < 2; ++bj)
#pragma unroll
                        for (int n = 0; n < 2; ++n) *(f32x4*)(pr + bj * 128 + n * 16) = acc[ai][bj][m][n];
                }
                asm volatile("" ::: "memory"); }
    }
};
template <class SE>
__device__ __forceinline__ void gemm_down(const Frame& F, const bf16* A, const bf16* Bt, int K, int ctx_split, const SE e) {
    pg8::Gemm g{A, Bt, K, K}; pg8::TileSched S; if (CTX_SPLIT || !ctx_split) S.init(32, D, F.G, (int)blockIdx.x, 1, ctx_split, K, K, K); else S.init(36, D, F.G, (int)blockIdx.x, 0, 0, K, K, K);
    EpiDownWrap<SE> E{e, F.PEND()};
    pg8::gemm_phase<EpiDownWrap<SE>, pg8::TileSched, true, true>(F.lds, g, S, E);
}
__device__ __forceinline__ void cvt_item(const float* W, int K, int N, bf16* WT, int split, LAS float* scr, int item, int lane) {
    const int nblk = N / 32, kb = item / nblk, nb = item % nblk, k0 = 64 * kb, n0 = 32 * nb;
    int r0 = n0; if (split) { const int j = n0 < split ? n0 : n0 - split; r0 = (j >> 7) * 256 + (j & 127) + (n0 < split ? 0 : 128); }
#pragma unroll 8
    for (int i = 0; i < 32; ++i) { const int kk = 2 * i + (lane >> 5); scr[kk * 33 + (lane & 31)] = W[(size_t)(k0 + kk) * N + n0 + (lane & 31)]; }
    asm volatile("s_waitcnt lgkmcnt(0)" ::: "memory");
    const int c = lane & 7;
#pragma unroll
    for (int j = 0; j < 4; ++j) { const int n = (lane >> 3) + 8 * j; const LAS float* sp = scr + (8 * c) * 33 + n;
        u32x4 o; o.x = pk2(sp[0 * 33], sp[1 * 33]); o.y = pk2(sp[2 * 33], sp[3 * 33]); o.z = pk2(sp[4 * 33], sp[5 * 33]); o.w = pk2(sp[6 * 33], sp[7 * 33]);
        *(u32x4*)(WT + (size_t)(r0 + n) * K + k0 + 8 * c) = o; }
    asm volatile("s_waitcnt lgkmcnt(0)" ::: "memory");
}
__device__ __forceinline__ void ph_cvt_weights(const Frame& F0) {
    const Frame F = launder(F0);
    LAS float* scr = (LAS float*)(F.lds + F.wave * 16384);
    int it = F.gw;
#define CVT(Wp, K_, N_, dst, split) do { const int ni = ((K_) / 64) * ((N_) / 32); for (; it < ni; it += F.NGW) cvt_item((Wp), (K_), (N_), (dst), (split), scr, it, F.lane); it -= ni; } while (0)
#pragma unroll 1
    for (int m = 0; m < 8; ++m) CVT(F.in[IN_FFNWI] + (size_t)m * D * 2 * DFF, D, 2 * DFF, F.WT() + WT_FFNWI + (size_t)m * D * 2 * DFF, DFF);
#pragma unroll 1
    for (int m = 0; m < 8; ++m) CVT(F.in[IN_FFNWO] + (size_t)m * DFF * D, DFF, D, F.WT() + WT_FFNWO + (size_t)m * DFF * D, 0);
    CVT(F.in[IN_AWQKV], D, QKVW, F.WT() + WT_AWQKV, 0);
    CVT(F.in[IN_AWO], D, D, F.WT() + WT_AWO, 0);
    CVT(F.in[IN_S5WGLU], D, 2 * D, F.WT() + WT_GLU, D);
    CVT(F.in[IN_MWIN], D, MINW, F.WT() + WT_MWIN, 0);
    CVT(F.in[IN_MWGATE], D, 32, F.WT() + WT_MWIN + (size_t)MINW * D, 0);
    CVT(F.in[IN_MWOUT], D, D, F.WT() + WT_MWOUT, 0);
    CVT(F.in[IN_WWQKV], D, QKVW, F.WT() + WT_WWQKV, 0);
    CVT(F.in[IN_WWO], D, D, F.WT() + WT_WWO, 0);
#undef CVT
}

__device__ __forceinline__ void ph_qknorm_rope(const Frame& F0, const float* qkg) {
    const Frame F = launder(F0);
    const int lane = F.lane; const float g1q = qkg[lane] * 0.08838834764831845f, g2q = qkg[64 + lane] * 0.08838834764831845f, g1k = qkg[HD + lane], g2k = qkg[HD + 64 + lane];
    const float inv = exp2f(-(float)(lane & 31) * (13.287712379549449f / 32.0f));
    for (int r = F.gw; r < NR; r += F.NGW) {
        const int b = r / TPB, p = r - b * TPB;
        bf16* qb = F.Q() + (size_t)r * QW; bf16* kb = F.K() + (size_t)r * KVW;
        float x1[20], x2[20];
#pragma unroll
        for (int h = 0; h < 20; ++h) { const bf16* base = h < 16 ? qb + h * HD : kb + (h - 16) * HD; x1[h] = bf2f(base[lane]); x2[h] = bf2f(base[64 + lane]); }
        float cs = 1.f, sn = 0.f;
        if (p >= CTXL) { const int t = p - CTXL; const float pos = (lane < 32) ? (float)(t / GRID_W) : (float)(t % GRID_W); sincosf(pos * inv, &sn, &cs); }
#pragma unroll
        for (int h = 0; h < 20; ++h) {
            const float ss = wave_sum(x1[h] * x1[h] + x2[h] * x2[h]); const float rstd = 1.0f / sqrtf(ss * (1.0f / HD) + NORM_EPS);
            const float a1 = x1[h] * rstd * (h < 16 ? g1q : g1k), a2 = x2[h] * rstd * (h < 16 ? g2q : g2k);
            x1[h] = a1 * cs - a2 * sn; x2[h] = a2 * cs + a1 * sn; }
#pragma unroll
        for (int h = 0; h < 20; ++h) { bf16* base = h < 16 ? qb + h * HD : kb + (h - 16) * HD; base[lane] = (bf16)f2bf(x1[h]); base[64 + lane] = (bf16)f2bf(x2[h]); }
    }
}
template <bool WINDOW>
__device__ __forceinline__ void ph_attn_naive(const Frame& F0, const float* sink) {
    const Frame F = launder(F0);
    const int lane = F.lane;
    for (int it = F.gw; it < NR * NH; it += F.NGW) {
        const int r = it / NH, h = it % NH; const int b = r / TPB, p = r - b * TPB; const int kv = h / 4;
        if (WINDOW && p < CTXL) continue;
        const unsigned qw = *(const unsigned*)(F.Q() + (size_t)r * QW + h * HD + 2 * lane); const float q0 = bf2f(qw & 0xffffu), q1 = bf2f(qw >> 16);
        float m = -1e30f, l = 0.f, o0 = 0.f, o1 = 0.f;
        int lo2, hi2;
        if (p < CTXL) { lo2 = 0; hi2 = 0; } else if (WINDOW) { const int t = p - CTXL; lo2 = CTXL + (t - 128 < 0 ? 0 : t - 128); hi2 = CTXL + (t + 128 > SEQ - 1 ? SEQ - 1 : t + 128) + 1; } else { lo2 = CTXL; hi2 = TPB; }
        for (int seg = 0; seg < 2; ++seg) { const int lo = seg ? lo2 : 0, hi = seg ? hi2 : CTXL;
            for (int kp = lo; kp < hi; ++kp) {
                const size_t kr = (size_t)(b * TPB + kp) * KVW + kv * HD + 2 * lane;
                const unsigned kw = *(const unsigned*)(F.K() + kr), vw = *(const unsigned*)(F.V() + kr);
                const float s = wave_sum(q0 * bf2f(kw & 0xffffu) + q1 * bf2f(kw >> 16));
                const float mn = fmaxf(m, s); const float al = __expf(m - mn), pe = __expf(s - mn);
                l = l * al + pe; o0 = o0 * al + pe * bf2f(vw & 0xffffu); o1 = o1 * al + pe * bf2f(vw >> 16); m = mn;
            } }
        if (WINDOW) { const float sk = sink[h]; const float mn = fmaxf(m, sk); const float al = __expf(m - mn); l = l * al + __expf(sk - mn); o0 *= al; o1 *= al; }
        const float il = 1.0f / l;
        *(unsigned*)(F.O() + (size_t)r * QW + h * HD + 2 * lane) = pk2(o0 * il, o1 * il);
    }
}
namespace att {
using bf16x8 = __attribute__((ext_vector_type(8))) short;
using s16x4  = __attribute__((ext_vector_type(4))) short;
using f32x16 = __attribute__((ext_vector_type(16))) float;
using u32x4v = __attribute__((ext_vector_type(4))) unsigned;
constexpr int QBLK = 32, KVBLK = 64, LDQ = QW, LDK = KVW, LDO = QW, AD = 128;
#ifndef ATT_SDEPTH
#define ATT_SDEPTH 1
#endif
constexpr int SDEPTH = ATT_SDEPTH;
constexpr float THR = 8.f, C = 1.4426950408889634f;
constexpr size_t SHM_V = KVBLK * AD * 2, SHM_K = KVBLK * AD * 2, SHM_ATTN = 2 * SHM_V + 2 * SHM_K + 8 * 64 * 4;
#define KSWZ(row, colB) ((row) * 256 + ((colB) ^ (((row) & 7) << 4)))
#define SBAR() __builtin_amdgcn_sched_barrier(0)
__device__ __forceinline__ int crow(int r, int hi) { return (r & 3) + 8 * (r >> 2) + 4 * hi; }
__device__ __forceinline__ unsigned cvtpk(float lo, float hi) { return pk2(lo, hi); }
__device__ __forceinline__ void partialSM(f32x16& p0, f32x16& p1, float& m_reg, float& mn, float& alpha) {
  float pmax = p0[0]; for (int r = 1; r < 16; ++r) pmax = fmaxf(pmax, p0[r]); for (int r = 0; r < 16; ++r) pmax = fmaxf(pmax, p1[r]);
  { auto rr = __builtin_amdgcn_permlane32_swap(__float_as_uint(pmax), __float_as_uint(pmax), false, false);
    pmax = fmaxf(__uint_as_float(rr[0]), __uint_as_float(rr[1])); }
  if (__builtin_expect(__all(pmax - m_reg <= THR), 1)) { mn = m_reg; alpha = 1.f; }
  else { mn = fmaxf(m_reg, pmax); alpha = __builtin_amdgcn_exp2f((m_reg - mn) * C); m_reg = mn; }
  float mnC = -mn * C;
  for (int r = 0; r < 16; ++r) p0[r] = fmaf(p0[r], C, mnC); for (int r = 0; r < 16; ++r) p1[r] = fmaf(p1[r], C, mnC);
  for (int r = 0; r < 16; ++r) p0[r] = __builtin_amdgcn_exp2f(p0[r]);
}
__device__ __forceinline__ void finishSM(f32x16& p0, f32x16& p1, float alpha, float& l_reg, bf16x8& pa0, bf16x8& pa1, bf16x8& pa2, bf16x8& pa3) {
  for (int r = 0; r < 16; ++r) p1[r] = __builtin_amdgcn_exp2f(p1[r]);
  float ps = 0; for (int r = 0; r < 16; ++r) ps += p0[r]; for (int r = 0; r < 16; ++r) ps += p1[r];
  { auto rr = __builtin_amdgcn_permlane32_swap(__float_as_uint(ps), __float_as_uint(ps), false, false);
    ps = __uint_as_float(rr[0]) + __uint_as_float(rr[1]); }
  l_reg = l_reg * alpha + ps;
#define PK4(P, BASE, OUT) do { unsigned a0 = cvtpk(P[BASE + 0], P[BASE + 1]), a1 = cvtpk(P[BASE + 2], P[BASE + 3]);   \
    unsigned b0 = cvtpk(P[BASE + 4], P[BASE + 5]), b1 = cvtpk(P[BASE + 6], P[BASE + 7]);                              \
    auto r0 = __builtin_amdgcn_permlane32_swap(a0, b0, false, false); auto r1 = __builtin_amdgcn_permlane32_swap(a1, b1, false, false); \
    u32x4v w = {r0[0], r1[0], r0[1], r1[1]}; OUT = *reinterpret_cast<bf16x8*>(&w); } while (0)
  PK4(p0, 0, pa0); PK4(p0, 8, pa1); PK4(p1, 0, pa2); PK4(p1, 8, pa3);
#undef PK4
}
__device__ __forceinline__ void qkt(f32x16& p0, f32x16& p1, const bf16* Ks, const bf16x8* qr, int r32, int hi) {
  p0 = f32x16{}; p1 = f32x16{};
  for (int d0 = 0; d0 < 8; ++d0) { int cb = (d0 * 16 + hi * 8) * 2;
    bf16x8 b0 = *reinterpret_cast<const bf16x8*>((const char*)Ks + KSWZ(r32, cb));
    bf16x8 b1 = *reinterpret_cast<const bf16x8*>((const char*)Ks + KSWZ(32 + r32, cb));
    p0 = __builtin_amdgcn_mfma_f32_32x32x16_bf16(b0, qr[d0], p0, 0, 0, 0);
    p1 = __builtin_amdgcn_mfma_f32_32x32x16_bf16(b1, qr[d0], p1, 0, 0, 0); }
}
__device__ __forceinline__ void band_mask(f32x16& p0, f32x16& p1, int tq, int tk0, int hi) {
#pragma unroll
  for (int r = 0; r < 16; ++r) { const int d = tq - (tk0 + crow(r, hi)); if (d > 128 || d < -128) p0[r] = -1e30f; const int d1 = d - 32; if (d1 > 128 || d1 < -128) p1[r] = -1e30f; }
}
__device__ __forceinline__ int v_st(int k, int c) { const int kk = (k & ~0xC) | ((k & 4) << 1) | ((k & 8) >> 1); return ((kk >> 3) * 4 + (c >> 5)) * 512 + ((kk & 7) * 32 + (c & 31)) * 2; }
__device__ __forceinline__ int v_rd_base(int lane) { return ((lane & 3) << 3) | (((lane >> 2) & 3) << 6) | (((lane >> 4) & 1) << 5) | (((lane >> 5) & 1) << 8); }
constexpr int v_rd_off(int d0, int ks, int half) { return d0 * 512 + ks * 4096 + half * 2048; }
template <int OFF> __device__ __forceinline__ s16x4 tr_read(int vb) {
  s16x4 r; asm volatile("ds_read_b64_tr_b16 %0, %1 offset:%2" : "=&v"(r) : "v"(vb), "i"(OFF) : "memory"); return r;
}
template <int D0> __device__ __forceinline__ void pv_one(f32x16& od, int vb, bf16x8 pa0, bf16x8 pa1, bf16x8 pa2, bf16x8 pa3) {
  const s16x4 l0 = tr_read<v_rd_off(D0, 0, 0)>(vb), h0 = tr_read<v_rd_off(D0, 0, 1)>(vb), l1 = tr_read<v_rd_off(D0, 1, 0)>(vb), h1 = tr_read<v_rd_off(D0, 1, 1)>(vb);
  const s16x4 l2 = tr_read<v_rd_off(D0, 2, 0)>(vb), h2 = tr_read<v_rd_off(D0, 2, 1)>(vb), l3 = tr_read<v_rd_off(D0, 3, 0)>(vb), h3 = tr_read<v_rd_off(D0, 3, 1)>(vb);
  asm volatile("s_waitcnt lgkmcnt(0)" ::: "memory"); SBAR();
#define PK(L, H) (bf16x8){L[0], L[1], L[2], L[3], H[0], H[1], H[2], H[3]}
  od = __builtin_amdgcn_mfma_f32_32x32x16_bf16(pa0, PK(l0, h0), od, 0, 0, 0);
  od = __builtin_amdgcn_mfma_f32_32x32x16_bf16(pa1, PK(l1, h1), od, 0, 0, 0);
  od = __builtin_amdgcn_mfma_f32_32x32x16_bf16(pa2, PK(l2, h2), od, 0, 0, 0);
  od = __builtin_amdgcn_mfma_f32_32x32x16_bf16(pa3, PK(l3, h3), od, 0, 0, 0);
#undef PK
}
__device__ __forceinline__ void pv_d0(f32x16* o, int vb, bf16x8 pa0, bf16x8 pa1, bf16x8 pa2, bf16x8 pa3) {
  pv_one<0>(o[0], vb, pa0, pa1, pa2, pa3); pv_one<1>(o[1], vb, pa0, pa1, pa2, pa3); pv_one<2>(o[2], vb, pa0, pa1, pa2, pa3); pv_one<3>(o[3], vb, pa0, pa1, pa2, pa3);
}
template <bool WINDOW>
__device__ __forceinline__ void attn_body(int tid, const bf16* __restrict__ Qb, const bf16* __restrict__ Kh, const bf16* __restrict__ Vh, bf16* __restrict__ Ob, int NT, int kband, int tkb, int T0, float sink, char* lds) {
  const int wid = tid >> 6, lane = tid & 63, r32 = lane & 31, hi = lane >> 5;
  bf16* V_lds = (bf16*)lds; bf16* K_lds = (bf16*)(lds + 2 * SHM_V);
  float* ws = (float*)(lds + 2 * SHM_V + 2 * SHM_K) + wid * 64; float* li_l = ws; float* al_l = ws + 32;
  float m_reg = -1e30f, l_reg = 0; f32x16 o[4] = {}; bf16x8 qr[8];
  const bf16* Qw = Qb + (long)(wid * QBLK + r32) * LDQ + hi * 8;
#pragma unroll
  for (int d0 = 0; d0 < 8; ++d0) qr[d0] = *reinterpret_cast<const bf16x8*>(Qw + d0 * 16);
  const int sr = tid >> 4, sc = (tid & 15) * 8, vst0 = v_st(sr, sc), vst1 = v_st(32 + sr, sc);
  const int vb0 = (int)(uintptr_t)V_lds + v_rd_base(lane);
  const int tq = T0 + wid * QBLK + r32;
  struct { bf16x8 vs0, vs1, ks0, ks1; } sr_[SDEPTH];
#define KOFF(j) ((j) < 4 ? 64 * (j) : kband + 64 * ((j) - 4))
#define SLOAD(i, jt) do { const int k0_ = KOFF(jt); sr_[i].vs0 = *reinterpret_cast<const bf16x8*>(&Vh[(long)(k0_ + sr) * LDK + sc]); sr_[i].vs1 = *reinterpret_cast<const bf16x8*>(&Vh[(long)(k0_ + 32 + sr) * LDK + sc]); \
    sr_[i].ks0 = *reinterpret_cast<const bf16x8*>(&Kh[(long)(k0_ + sr) * LDK + sc]); sr_[i].ks1 = *reinterpret_cast<const bf16x8*>(&Kh[(long)(k0_ + 32 + sr) * LDK + sc]); } while (0)
#define SWRITE(b, i) do { *(bf16x8*)((char*)V_lds + (b) * SHM_V + vst0) = sr_[i].vs0;          \
    *(bf16x8*)((char*)V_lds + (b) * SHM_V + vst1) = sr_[i].vs1; int kc = sc * 2;               \
    *(bf16x8*)((char*)K_lds + (b) * SHM_K + KSWZ(sr, kc)) = sr_[i].ks0;                       \
    *(bf16x8*)((char*)K_lds + (b) * SHM_K + KSWZ(32 + sr, kc)) = sr_[i].ks1; } while (0)
#define SWAIT() do { if constexpr (SDEPTH == 2) asm volatile("s_waitcnt vmcnt(4)" ::: "memory"); else asm volatile("s_waitcnt vmcnt(0)" ::: "memory"); } while (0)
#define RESC(a) do { if (__any((a) < 1.f)) { if (hi == 0) al_l[r32] = (a); asm volatile("s_waitcnt lgkmcnt(0)" ::: "memory"); \
    for (int d = 0; d < 4; ++d) for (int r = 0; r < 16; ++r) o[d][r] *= al_l[crow(r, hi)]; } } while (0)
#define MASK(P0, P1, jt) do { if (WINDOW && (jt) >= 4) band_mask(P0, P1, tq, tkb + 64 * ((jt) - 4), hi); } while (0)
  f32x16 pA0, pA1, pB0, pB1; float mnA, mnB, alA, alB; bf16x8 pa0, pa1, pa2, pa3;
  constexpr int SE = 0, SO = SDEPTH - 1;
  SLOAD(SE, 0); asm volatile("s_waitcnt vmcnt(0)" ::: "memory"); SWRITE(0, SE); __syncthreads();
  qkt(pA0, pA1, K_lds, qr, r32, hi); partialSM(pA0, pA1, m_reg, mnA, alA);
  SLOAD(SO, 1); if constexpr (SDEPTH == 2) { if (2 < NT) SLOAD(SE, 2); }
  SWAIT(); SWRITE(1, SO); __syncthreads();
  for (int j = 1; j + 1 < NT; j += 2) {
    SBAR(); qkt(pB0, pB1, (bf16*)((char*)K_lds + SHM_K), qr, r32, hi); MASK(pB0, pB1, j);
    finishSM(pA0, pA1, alA, l_reg, pa0, pa1, pa2, pa3); SBAR();
    SLOAD(SO, j + SDEPTH); SBAR();
    pv_d0(o, vb0, pa0, pa1, pa2, pa3); partialSM(pB0, pB1, m_reg, mnB, alB);
    __syncthreads(); SWAIT(); SWRITE(0, SE);
    RESC(alB); __syncthreads();
    SBAR(); qkt(pA0, pA1, K_lds, qr, r32, hi); MASK(pA0, pA1, j + 1);
    finishSM(pB0, pB1, alB, l_reg, pa0, pa1, pa2, pa3); SBAR();
    if (SDEPTH == 1 || j + 3 < NT) SLOAD(SE, j + 1 + SDEPTH); SBAR();
    pv_d0(o, vb0 + (int)SHM_V, pa0, pa1, pa2, pa3); partialSM(pA0, pA1, m_reg, mnA, alA);
    __syncthreads(); SWAIT(); SWRITE(1, SO);
    RESC(alA); __syncthreads();
  }
  SBAR(); qkt(pB0, pB1, (bf16*)((char*)K_lds + SHM_K), qr, r32, hi); MASK(pB0, pB1, NT - 1);
  finishSM(pA0, pA1, alA, l_reg, pa0, pa1, pa2, pa3); SBAR();
  pv_d0(o, vb0, pa0, pa1, pa2, pa3); partialSM(pB0, pB1, m_reg, mnB, alB);
  __syncthreads(); RESC(alB);
  finishSM(pB0, pB1, alB, l_reg, pa0, pa1, pa2, pa3); SBAR();
  pv_d0(o, vb0 + (int)SHM_V, pa0, pa1, pa2, pa3);
  if (WINDOW) l_reg += __builtin_amdgcn_exp2f((sink - m_reg) * C);
  if (hi == 0) li_l[r32] = l_reg; asm volatile("s_waitcnt lgkmcnt(0)" ::: "memory");
  float rli[16];
#pragma unroll
  for (int r = 0; r < 16; ++r) rli[r] = __builtin_amdgcn_rcpf(li_l[crow(r, hi)]);
  bf16* Ow = Ob + (long)(wid * QBLK) * LDO;
#pragma unroll
  for (int r = 0; r < 16; ++r) { int orow = crow(r, hi);
    for (int d0 = 0; d0 < 4; ++d0) Ow[(long)orow * LDO + d0 * 32 + r32] = (bf16)f2bf(o[d0][r] * rli[r]); }
#undef KOFF
#undef SLOAD
#undef SWRITE
#undef SWAIT
#undef RESC
#undef MASK
}

constexpr int ML_QI = 0, ML_KI = 16384, ML_KV = 32768, ML_VV = 49152, ML_WV = 65536, ML_CI = 81920, ML_CIB = 24576, ML_SC = 132096;
__device__ __forceinline__ float shfl_up_l(float v, int d, int lane) { return __int_as_float(__builtin_amdgcn_ds_bpermute(((lane - d) & 63) << 2, __float_as_int(v))); }
__device__ __forceinline__ void mlstm_scalars(float ig, float fg, float& m_prev, float* sc, int lane) {
    const float logf = fminf(fg, 0.f) - log1pf(__expf(-fabsf(fg)));
    float bc = logf;
#pragma unroll
    for (int d = 1; d < 64; d <<= 1) { const float t = shfl_up_l(bc, d, lane); if (lane >= d) bc += t; }
    const float b_end = __int_as_float(__builtin_amdgcn_readlane(__float_as_int(bc), 63));
    const float beta = ig - bc; const float wl = b_end + beta;
    float mx = wl;
#pragma unroll
    for (int d = 1; d < 64; d <<= 1) { const float t = shfl_up_l(mx, d, lane); if (lane >= d) mx = fmaxf(mx, t); }
    const float mxall = __int_as_float(__builtin_amdgcn_readlane(__float_as_int(mx), 63));
    float pm = beta;
#pragma unroll
    for (int d = 1; d < 64; d <<= 1) { const float t = shfl_up_l(pm, d, lane); if (lane >= d) pm = fmaxf(pm, t); }
    const float m_new = fmaxf(b_end + m_prev, mxall);
    const float m_t = bc + fmaxf(pm, m_prev);
    sc[lane] = bc - m_t - 2.4260151319598084f;
    sc[64 + lane] = beta;
    sc[128 + lane] = 0.08838834764831845f * __expf(bc + m_prev - m_t);
    sc[192 + lane] = __expf(wl - m_new);
    sc[256 + lane] = __expf(-m_t);
    if (lane == 0) sc[320] = __expf(b_end + m_prev - m_new);
    m_prev = m_new;
}
__device__ __forceinline__ void ph_mlstm_body(int tid, const bf16* __restrict__ QKVO_, const float* __restrict__ gates, float* __restrict__ HD_, int b, int hh, int dr, int vq, char* lds) {
    const int wid = __builtin_amdgcn_readfirstlane(tid >> 6), lane = tid & 63;
    float* scal = (float*)(lds + ML_SC);
    for (int i = tid; i < 2 * ML_CIB / 16; i += 512) *(u32x4v*)(lds + ML_CI + i * 16) = (u32x4v){0u, 0u, 0u, 0u};
    float m_prev = 0.f;
    const int gcol = dr * 16 + hh;
    const size_t bq = (size_t)hh * MDQK, bk = (size_t)MQKW + hh * MDQK, bv = (size_t)2 * MQKW + hh * MDV + vq * 64;
#define ML_ROWBASE(c) (dr == 0 ? 64 * (c) : ((c) < 4 ? 255 - 64 * (c) : 2303 - 64 * ((c) - 4)))
    const int sg = dr == 0 ? 1 : -1;
    float ig_n = 0.f, fg_n = 0.f;
#define ML_GLOAD(c) do { const size_t r_ = (size_t)(b * TPB + ML_ROWBASE(c) + sg * lane); ig_n = gates[r_ * 32 + gcol]; fg_n = gates[r_ * 32 + gcol + 8]; } while (0)
    if (wid == 7) { ML_GLOAD(0); mlstm_scalars(ig_n, fg_n, m_prev, scal, lane); ML_GLOAD(1); }
    const int sr = tid >> 4, scq = (tid & 15) * 8, vr = tid >> 3, vc = (tid & 7) * 8;
    bf16x8 gq0, gq1, gk0, gk1, gv;
#define ML_LOAD(c) do { const int rb_ = b * TPB + ML_ROWBASE(c); const bf16* r0_ = QKVO_ + (size_t)(rb_ + sg * sr) * MINW; const bf16* r1_ = QKVO_ + (size_t)(rb_ + sg * (32 + sr)) * MINW; const bf16* rv_ = QKVO_ + (size_t)(rb_ + sg * vr) * MINW; \
    gq0 = *(const bf16x8*)(r0_ + bq + scq); gq1 = *(const bf16x8*)(r1_ + bq + scq); gk0 = *(const bf16x8*)(r0_ + bk + scq); gk1 = *(const bf16x8*)(r1_ + bk + scq); gv = *(const bf16x8*)(rv_ + bv + vc); } while (0)
    ML_LOAD(0);
    f32x16 acc0 = {}, acc1 = {}, acc2 = {};
    const int kt = wid - 4;
    const int vbK = (int)(uintptr_t)(lds + ML_KV) + v_rd_base(lane), vbV = (int)(uintptr_t)(lds + ML_VV) + v_rd_base(lane), vbW = (int)(uintptr_t)(lds + ML_WV) + v_rd_base(lane);
    __syncthreads();
    constexpr int NCH = TPB / 64;
#pragma unroll 1
    for (int c = 0; c < NCH; ++c) {
        int lane_c = lane; asm volatile("" : "+v"(lane_c));
        const int r32 = lane_c & 31, hi = lane_c >> 5;
        const float* sc = scal + (c & 1) * 384; float* scn = scal + ((c + 1) & 1) * 384;
        char* CIcur = lds + ML_CI + (c & 1) * ML_CIB; char* CInext = lds + ML_CI + ((c + 1) & 1) * ML_CIB;
        asm volatile("s_waitcnt vmcnt(0)" ::: "memory");
        *(bf16x8*)(lds + ML_QI + KSWZ(sr, scq * 2)) = gq0; *(bf16x8*)(lds + ML_QI + KSWZ(32 + sr, scq * 2)) = gq1;
        *(bf16x8*)(lds + ML_KI + KSWZ(sr, scq * 2)) = gk0; *(bf16x8*)(lds + ML_KI + KSWZ(32 + sr, scq * 2)) = gk1;
        *(bf16x8*)(lds + ML_KV + v_st(sr, scq)) = gk0; *(bf16x8*)(lds + ML_KV + v_st(32 + sr, scq)) = gk1;
        *(bf16x8*)(lds + ML_VV + v_st(vr, vc)) = gv;
        { const float w = sc[192 + vr]; u32x4v gw = *reinterpret_cast<u32x4v*>(&gv), o;
          o.x = cvtpk(w * bf2f(gw.x & 0xffffu), w * bf2f(gw.x >> 16)); o.y = cvtpk(w * bf2f(gw.y & 0xffffu), w * bf2f(gw.y >> 16)); o.z = cvtpk(w * bf2f(gw.z & 0xffffu), w * bf2f(gw.z >> 16)); o.w = cvtpk(w * bf2f(gw.w & 0xffffu), w * bf2f(gw.w >> 16));
          *(u32x4v*)(lds + ML_WV + v_st(vr, vc)) = o; }
        if (tid < 64) *(bf16*)(lds + ML_WV + v_st(tid, 64)) = (bf16)f2bf(sc[192 + tid]);
        __syncthreads();
        if (c + 1 < NCH) ML_LOAD(c + 1);
        f32x16 o_in = {}, o_x = {}; int tt = 0, vt = 0;
        if (wid < 4) {
            tt = wid >> 1; vt = wid & 1;
            bf16x8 qr[8];
#pragma unroll
            for (int d0 = 0; d0 < 8; ++d0) qr[d0] = *reinterpret_cast<const bf16x8*>(lds + ML_QI + KSWZ(32 * tt + r32, (d0 * 16 + hi * 8) * 2));
            f32x16 p0, p1; qkt(p0, p1, (const bf16*)(lds + ML_KI), qr, r32, hi);
            const int t = 32 * tt + r32; const float al = sc[t];
#pragma unroll
            for (int r = 0; r < 16; ++r) { const int s0 = crow(r, hi); const float e0 = __expf(al + sc[64 + s0]), e1 = __expf(al + sc[64 + 32 + s0]);
                p0[r] = s0 <= t ? p0[r] * e0 : 0.f; p1[r] = s0 + 32 <= t ? p1[r] * e1 : 0.f; }
            float ds = 0.f;
#pragma unroll
            for (int r = 0; r < 16; ++r) ds += p0[r] + p1[r];
            { auto rr = __builtin_amdgcn_permlane32_swap(__float_as_uint(ds), __float_as_uint(ds), false, false); ds = __uint_as_float(rr[0]) + __uint_as_float(rr[1]); }
            if (vt == 0 && hi == 0) scal[768 + t] = ds;
            bf16x8 pa0, pa1, pa2, pa3;
#define PK4(P, BASE, OUT) do { unsigned a0 = cvtpk(P[BASE + 0], P[BASE + 1]), a1 = cvtpk(P[BASE + 2], P[BASE + 3]);   \
    unsigned b0 = cvtpk(P[BASE + 4], P[BASE + 5]), b1 = cvtpk(P[BASE + 6], P[BASE + 7]);                              \
    auto r0 = __builtin_amdgcn_permlane32_swap(a0, b0, false, false); auto r1 = __builtin_amdgcn_permlane32_swap(a1, b1, false, false); \
    u32x4v w = {r0[0], r1[0], r0[1], r1[1]}; OUT = *reinterpret_cast<bf16x8*>(&w); } while (0)
            PK4(p0, 0, pa0); PK4(p0, 8, pa1); PK4(p1, 0, pa2); PK4(p1, 8, pa3);
#undef PK4
            if (vt == 0) pv_one<0>(o_in, vbV, pa0, pa1, pa2, pa3); else pv_one<1>(o_in, vbV, pa0, pa1, pa2, pa3);
#pragma unroll
            for (int d0 = 0; d0 < 8; ++d0) { const bf16x8 cf = *reinterpret_cast<const bf16x8*>(CIcur + KSWZ(32 * vt + r32, (d0 * 16 + hi * 8) * 2)); o_x = __builtin_amdgcn_mfma_f32_32x32x16_bf16(qr[d0], cf, o_x, 0, 0, 0); }
        } else {
            const float decay = sc[320];
#pragma unroll
            for (int r = 0; r < 16; ++r) { acc0[r] *= decay; acc1[r] *= decay; acc2[r] *= decay; }
#pragma unroll
            for (int ks = 0; ks < 4; ++ks) {
                s16x4 al_, ah_, b0l, b0h, b1l, b1h, b2l, b2h; const int ka = vbK + kt * 512 + ks * 4096, wa = vbW + ks * 4096;
                asm volatile("ds_read_b64_tr_b16 %0, %1" : "=&v"(al_) : "v"(ka) : "memory"); asm volatile("ds_read_b64_tr_b16 %0, %1 offset:2048" : "=&v"(ah_) : "v"(ka) : "memory");
                asm volatile("ds_read_b64_tr_b16 %0, %1" : "=&v"(b0l) : "v"(wa) : "memory"); asm volatile("ds_read_b64_tr_b16 %0, %1 offset:2048" : "=&v"(b0h) : "v"(wa) : "memory");
                asm volatile("ds_read_b64_tr_b16 %0, %1 offset:512" : "=&v"(b1l) : "v"(wa) : "memory"); asm volatile("ds_read_b64_tr_b16 %0, %1 offset:2560" : "=&v"(b1h) : "v"(wa) : "memory");
                asm volatile("ds_read_b64_tr_b16 %0, %1 offset:1024" : "=&v"(b2l) : "v"(wa) : "memory"); asm volatile("ds_read_b64_tr_b16 %0, %1 offset:3072" : "=&v"(b2h) : "v"(wa) : "memory");
                asm volatile("s_waitcnt lgkmcnt(0)" ::: "memory"); SBAR();
#define PK(L, H) (bf16x8){L[0], L[1], L[2], L[3], H[0], H[1], H[2], H[3]}
                const bf16x8 af = PK(al_, ah_);
                acc0 = __builtin_amdgcn_mfma_f32_32x32x16_bf16(af, PK(b0l, b0h), acc0, 0, 0, 0);
                acc1 = __builtin_amdgcn_mfma_f32_32x32x16_bf16(af, PK(b1l, b1h), acc1, 0, 0, 0);
                acc2 = __builtin_amdgcn_mfma_f32_32x32x16_bf16(af, PK(b2l, b2h), acc2, 0, 0, 0);
#undef PK
            }
#pragma unroll
            for (int q = 0; q < 4; ++q) { const int cb = (32 * kt + 8 * q + 4 * hi) * 2;
                u32x2 w0; w0.x = cvtpk(acc0[4 * q], acc0[4 * q + 1]); w0.y = cvtpk(acc0[4 * q + 2], acc0[4 * q + 3]); *(u32x2*)(CInext + KSWZ(r32, cb)) = w0;
                u32x2 w1; w1.x = cvtpk(acc1[4 * q], acc1[4 * q + 1]); w1.y = cvtpk(acc1[4 * q + 2], acc1[4 * q + 3]); *(u32x2*)(CInext + KSWZ(32 + r32, cb)) = w1;
                if (r32 == 0) { u32x2 w2; w2.x = cvtpk(acc2[4 * q], acc2[4 * q + 1]); w2.y = cvtpk(acc2[4 * q + 2], acc2[4 * q + 3]); *(u32x2*)(CInext + KSWZ(64, cb)) = w2; } }
            if (wid < 6) {
                const int t2 = wid - 4; f32x16 o_n = {};
#pragma unroll
                for (int d0 = 0; d0 < 8; ++d0) { const bf16x8 qf = *reinterpret_cast<const bf16x8*>(lds + ML_QI + KSWZ(32 * t2 + r32, (d0 * 16 + hi * 8) * 2));
                    const bf16x8 cf = *reinterpret_cast<const bf16x8*>(CIcur + KSWZ(64 + r32, (d0 * 16 + hi * 8) * 2)); o_n = __builtin_amdgcn_mfma_f32_32x32x16_bf16(qf, cf, o_n, 0, 0, 0); }
                if (r32 == 0) {
#pragma unroll
                    for (int r = 0; r < 16; ++r) scal[832 + 32 * t2 + crow(r, hi)] = o_n[r]; }
            }
            if (wid == 7 && c + 1 < NCH) { const float ig_c = ig_n, fg_c = fg_n; if (c + 2 < NCH) ML_GLOAD(c + 2); mlstm_scalars(ig_c, fg_c, m_prev, scn, lane); }
        }
        __syncthreads();
        if (wid < 4) {
            const int rb = b * TPB + ML_ROWBASE(c);
#pragma unroll
            for (int r = 0; r < 16; ++r) { const int t = 32 * tt + crow(r, hi); const float ai = sc[128 + t];
                const float dn = fmaxf(fabsf(scal[768 + t] + ai * scal[832 + t]), sc[256 + t]);
                HD_[(size_t)(rb + sg * t) * D + hh * MDV + vq * 64 + 32 * vt + r32] = (o_in[r] + ai * o_x[r]) / dn; }
        }
    }
#undef ML_LOAD
#undef ML_GLOAD
#undef ML_ROWBASE
    __syncthreads();
}

constexpr int S5_IMG = 8192;
__device__ __forceinline__ int s5_st(int k, int t) { const int k6 = k & 63; const int kk = (k6 & ~0xC) | ((k6 & 4) << 1) | ((k6 & 8) >> 1); return (k >> 6) * 4096 + (kk >> 3) * 512 + ((kk & 7) * 32 + t) * 2; }
__device__ __forceinline__ void s5_disc(const float* lre, const float* lim, float dt, int n, float& ar, float& ai, float& kr, float& ki) {
    const float lr = fminf(lre[n], -1e-4f), li = lim[n]; const float mag = expf(lr * dt); float sn, cs; sincosf(li * dt, &sn, &cs); ar = mag * cs; ai = mag * sn;
    const float den = lr * lr + li * li; kr = ((ar - 1.f) * lr + ai * li) / den; ki = (ai * lr - (ar - 1.f) * li) / den;
}
__device__ __forceinline__ void s5_task(int lane, const float* const* in, const bf16* __restrict__ Hb, float* __restrict__ out, int b, int g, int dr, char* img) {
    const int r32 = lane & 31, hi = lane >> 5; const size_t pg = (size_t)(dr * S5G + g);
    const float dt = expf(in[IN_S5LDT][pg]); const float* lre = in[IN_S5LRE] + pg * S5N; const float* lim = in[IN_S5LIM] + pg * S5N;
    float ar, ai, kr_o, ki_o, ar2, ai2, kr_p, ki_p;
    s5_disc(lre, lim, dt, lane, ar, ai, kr_o, ki_o);
    float kr0, ki0, kr1, ki1;
    s5_disc(lre, lim, dt, r32, ar2, ai2, kr0, ki0); s5_disc(lre, lim, dt, 32 + r32, ar2, ai2, kr1, ki1); (void)kr_o; (void)ki_o; (void)kr_p; (void)ki_p;
    bf16x8 Bf[4];
#pragma unroll
    for (int q = 0; q < 4; ++q) { const int n = (q & 1) * 32 + r32; const float kr = (q & 1) ? kr1 : kr0, ki = (q & 1) ? ki1 : ki0;
        const float* bre = in[IN_S5BRE] + (pg * S5N + n) * 16 + 8 * hi; const float* bim = in[IN_S5BIM] + (pg * S5N + n) * 16 + 8 * hi; u32x4v w;
        float v[8];
#pragma unroll
        for (int j = 0; j < 8; ++j) v[j] = (q < 2) ? (kr * bre[j] - ki * bim[j]) : (kr * bim[j] + ki * bre[j]);
        w.x = cvtpk(v[0], v[1]); w.y = cvtpk(v[2], v[3]); w.z = cvtpk(v[4], v[5]); w.w = cvtpk(v[6], v[7]); Bf[q] = *reinterpret_cast<bf16x8*>(&w); }
    bf16x8 Cf[8];
#pragma unroll
    for (int kb = 0; kb < 8; ++kb) { u32x4v w = {0u, 0u, 0u, 0u};
        if (r32 < 16) { const int k0 = 16 * kb + 8 * hi; const float* cp = (k0 < 64 ? in[IN_S5CRE] : in[IN_S5CIM]) + (pg * 16 + r32) * S5N + (k0 & 63); const float sgn = k0 < 64 ? 1.f : -1.f;
            w.x = cvtpk(sgn * cp[0], sgn * cp[1]); w.y = cvtpk(sgn * cp[2], sgn * cp[3]); w.z = cvtpk(sgn * cp[4], sgn * cp[5]); w.w = cvtpk(sgn * cp[6], sgn * cp[7]); }
        Cf[kb] = *reinterpret_cast<bf16x8*>(&w); }
    float xr = 0.f, xi = 0.f;
    const int vb = (int)(uintptr_t)img + v_rd_base(lane);
#define S5_ROW(s) (dr == 0 ? (s) : ((s) < CTXL ? CTXL - 1 - (s) : TPB - 1 - ((s) - CTXL)))
    bf16x8 uf = *reinterpret_cast<const bf16x8*>(Hb + ((size_t)b * TPB + S5_ROW(r32)) * D + 16 * g + 8 * hi);
#pragma unroll 1
    for (int blk = 0; blk < TPB / 32; ++blk) {
        const bf16x8 ucur = uf;
        if (blk + 1 < TPB / 32) uf = *reinterpret_cast<const bf16x8*>(Hb + ((size_t)b * TPB + S5_ROW(32 * (blk + 1) + r32)) * D + 16 * g + 8 * hi);
        f32x16 d0 = {}, d1 = {}, d2 = {}, d3 = {};
        d0 = __builtin_amdgcn_mfma_f32_32x32x16_bf16(ucur, Bf[0], d0, 0, 0, 0); d1 = __builtin_amdgcn_mfma_f32_32x32x16_bf16(ucur, Bf[1], d1, 0, 0, 0);
        d2 = __builtin_amdgcn_mfma_f32_32x32x16_bf16(ucur, Bf[2], d2, 0, 0, 0); d3 = __builtin_amdgcn_mfma_f32_32x32x16_bf16(ucur, Bf[3], d3, 0, 0, 0);
#pragma unroll
        for (int r = 0; r < 16; ++r) { auto s0 = __builtin_amdgcn_permlane32_swap(__float_as_uint(d0[r]), __float_as_uint(d1[r]), false, false); d0[r] = __uint_as_float(s0[0]); d1[r] = __uint_as_float(s0[1]);
            auto s1 = __builtin_amdgcn_permlane32_swap(__float_as_uint(d2[r]), __float_as_uint(d3[r]), false, false); d2[r] = __uint_as_float(s1[0]); d3[r] = __uint_as_float(s1[1]); }
        unsigned pre[16], pim[16]; float lr_ = 0.f, li_ = 0.f;
#pragma unroll
        for (int t = 0; t < 32; ++t) { const int odd = (t >> 2) & 1, tt = odd ? t - 4 : t, r = (tt & 3) + 4 * (tt >> 3);
            const float br = odd ? d1[r] : d0[r], bi = odd ? d3[r] : d2[r];
            const float nr = fmaf(ar, xr, fmaf(-ai, xi, br)), ni = fmaf(ar, xi, fmaf(ai, xr, bi)); xr = nr; xi = ni;
            if (t & 1) { pre[t >> 1] = cvtpk(lr_, xr); pim[t >> 1] = cvtpk(li_, xi); } else { lr_ = xr; li_ = xi; } }
#pragma unroll
        for (int j = 0; j < 4; ++j) { *(u32x4v*)(img + s5_st(lane, 8 * j)) = (u32x4v){pre[4 * j], pre[4 * j + 1], pre[4 * j + 2], pre[4 * j + 3]};
            *(u32x4v*)(img + s5_st(64 + lane, 8 * j)) = (u32x4v){pim[4 * j], pim[4 * j + 1], pim[4 * j + 2], pim[4 * j + 3]}; }
        asm volatile("s_waitcnt lgkmcnt(0)" ::: "memory");
        f32x16 y = {};
#define S5_TR(KB, L, H) const s16x4 L = tr_read<((KB) >> 2) * 4096 + ((KB) & 3) * 1024>(vb), H = tr_read<((KB) >> 2) * 4096 + ((KB) & 3) * 1024 + 512>(vb)
        S5_TR(0, l0, h0); S5_TR(1, l1, h1); S5_TR(2, l2, h2); S5_TR(3, l3, h3); S5_TR(4, l4, h4); S5_TR(5, l5, h5); S5_TR(6, l6, h6); S5_TR(7, l7, h7);
        asm volatile("s_waitcnt lgkmcnt(0)" ::: "memory"); SBAR();
#define S5_MM(KB, L, H) y = __builtin_amdgcn_mfma_f32_32x32x16_bf16((bf16x8){L[0], L[1], L[2], L[3], H[0], H[1], H[2], H[3]}, Cf[KB], y, 0, 0, 0)
        S5_MM(0, l0, h0); S5_MM(1, l1, h1); S5_MM(2, l2, h2); S5_MM(3, l3, h3); S5_MM(4, l4, h4); S5_MM(5, l5, h5); S5_MM(6, l6, h6); S5_MM(7, l7, h7);
#undef S5_TR
#undef S5_MM
        if (r32 < 16) {
#pragma unroll
            for (int r = 0; r < 16; ++r) out[((size_t)b * TPB + S5_ROW(32 * blk + crow(r, hi))) * D + 16 * g + r32] = y[r]; }
    }
#undef S5_ROW
}
#undef KSWZ
#undef SBAR
}

template <bool WINDOW>
__device__ __forceinline__ void ph_attn_fast(const Frame& F0, const float* sinkp) {
    const Frame F = launder(F0);
    const int bx = blockIdx.x; const int vcu = (F.G % 8 == 0) ? (bx % 8) * (F.G / 8) + bx / 8 : bx;
    const int nlat = NB * NH * 8, nslots = nlat / 2 + (WINDOW ? 0 : NB * NH);
    for (int slot = vcu; slot < nslots; slot += F.G) {
#pragma unroll 1
        for (int k = 0; k < 2; ++k) {
            int u = slot < nlat / 2 ? 2 * slot + k : nlat + (slot - nlat / 2);
            if (slot >= nlat / 2 && k == 1) continue;
            int b, h, qb;
            if (u < nlat) { const int grp = u / 32, w = u % 32; b = grp / NKV; h = (grp % NKV) * 4 + w / 8; qb = 1 + w % 8; } else { const int c = u - nlat; b = c / NH; h = c % NH; qb = 0; }
            const int kv = h / 4; const size_t row0 = (size_t)b * TPB + qb * 256;
            const bf16* Qb = F.Q() + row0 * QW + h * HD; const bf16* Kh = F.K() + (size_t)b * TPB * KVW + kv * HD; const bf16* Vh = F.V() + (size_t)b * TPB * KVW + kv * HD; bf16* Ob = F.O() + row0 * QW + h * HD;
            int NT, kband = CTXL, tkb = 0, T0 = 0; float sk = 0.f;
            if (WINDOW) { T0 = (qb - 1) * 256; const int ks = T0 - 128 < 0 ? 0 : T0 - 128, ke = T0 + 384 > SEQ ? SEQ : T0 + 384; NT = 4 + (ke - ks) / 64; kband = CTXL + ks; tkb = ks; sk = sinkp[h]; }
            else NT = qb == 0 ? 4 : TPB / 64;
            att::attn_body<WINDOW>(F.tid, Qb, Kh, Vh, Ob, NT, kband, tkb, T0, sk, (char*)(unsigned char*)F.lds);
            __syncthreads();
        }
    }
}

__device__ __forceinline__ void ph_s5_naive(const Frame& F0) {
    const Frame F = launder(F0);
    const int n = F.lane;
    for (int it = F.gw; it < NB * S5G * 2; it += F.NGW) {
        const int dr = it & 1, g = (it >> 1) % S5G, b = it / (2 * S5G);
        const size_t pg = (size_t)(dr * S5G + g);
        const float lr = fminf(F.in[IN_S5LRE][pg * S5N + n], -1e-4f), li = F.in[IN_S5LIM][pg * S5N + n], dt = expf(F.in[IN_S5LDT][pg]);
        const float mag = expf(lr * dt); float sn, cs; sincosf(li * dt, &sn, &cs); const float ar = mag * cs, ai = mag * sn;
        const float den = lr * lr + li * li; const float kr = ((ar - 1.f) * lr + ai * li) / den, ki = (ai * lr - (ar - 1.f) * li) / den;
        float bre[16], bim[16], cre[16], cim[16];
#pragma unroll
        for (int c = 0; c < 16; ++c) { const float br_ = F.in[IN_S5BRE][(pg * S5N + n) * 16 + c], bi_ = F.in[IN_S5BIM][(pg * S5N + n) * 16 + c];
            bre[c] = kr * br_ - ki * bi_; bim[c] = kr * bi_ + ki * br_;
            cre[c] = F.in[IN_S5CRE][(pg * 16 + c) * S5N + n]; cim[c] = F.in[IN_S5CIM][(pg * 16 + c) * S5N + n]; }
        float xr = 0.f, xi = 0.f;
        float* out = F.HDb() + (size_t)dr * NR * D;
        for (int s = 0; s < TPB; ++s) {
            int p; if (dr == 0) p = s; else p = s < CTXL ? CTXL - 1 - s : TPB - 1 - (s - CTXL);
            const size_t r = (size_t)b * TPB + p;
            const u32x4 u0 = *(const u32x4*)(F.H() + r * D + 16 * g), u1 = *(const u32x4*)(F.H() + r * D + 16 * g + 8);
            float u[16]; u[0] = bf2f(u0.x & 0xffffu); u[1] = bf2f(u0.x >> 16); u[2] = bf2f(u0.y & 0xffffu); u[3] = bf2f(u0.y >> 16); u[4] = bf2f(u0.z & 0xffffu); u[5] = bf2f(u0.z >> 16); u[6] = bf2f(u0.w & 0xffffu); u[7] = bf2f(u0.w >> 16);
            u[8] = bf2f(u1.x & 0xffffu); u[9] = bf2f(u1.x >> 16); u[10] = bf2f(u1.y & 0xffffu); u[11] = bf2f(u1.y >> 16); u[12] = bf2f(u1.z & 0xffffu); u[13] = bf2f(u1.z >> 16); u[14] = bf2f(u1.w & 0xffffu); u[15] = bf2f(u1.w >> 16);
            float br = 0.f, bi = 0.f;
#pragma unroll
            for (int c = 0; c < 16; ++c) { br += bre[c] * u[c]; bi += bim[c] * u[c]; }
            const float nr = ar * xr - ai * xi + br, ni = ar * xi + ai * xr + bi; xr = nr; xi = ni;
            float mine = 0.f;
#pragma unroll
            for (int c = 0; c < 16; ++c) { const float y = wave_sum(xr * cre[c] - xi * cim[c]); if (n == c) mine = y; }
            if (n < 16) out[r * D + 16 * g + n] = mine;
        }
    }
}
__device__ __forceinline__ void ph_s5_fast(const Frame& F0) {
    const Frame F = launder(F0);
    if (F.wave < 4) {
        for (int task = blockIdx.x * 4 + F.wave; task < NB * 2 * S5G; task += F.G * 4) {
            const int g = task % S5G, dr = (task / S5G) & 1, b = task / (2 * S5G);
            att::s5_task(F.lane, F.in, F.H(), F.HDb() + (size_t)dr * NR * D, b, g, dr, (char*)(unsigned char*)F.lds + F.wave * att::S5_IMG);
        }
    }
}
__device__ __forceinline__ void ph_s5_combine(const Frame& F0) {
    const Frame F = launder(F0);
    const size_t n4 = (size_t)NR * D / 4, stride = (size_t)F.G * NTHREADS; const f32x4* yf = (const f32x4*)F.HDb(); const f32x4* yb = (const f32x4*)(F.HDb() + (size_t)NR * D);
    for (size_t i0 = (size_t)blockIdx.x * NTHREADS + F.tid; i0 < n4; i0 += 4 * stride) {
        f32x4 dsk[4], f[4], bb[4]; u32x2 hw[4];
#pragma unroll
        for (int k = 0; k < 4; ++k) { const size_t i = i0 + k * stride; dsk[k] = ((const f32x4*)F.in[IN_S5D])[(int)(i % (D / 4))]; hw[k] = ((const u32x2*)F.H())[i]; f[k] = yf[i]; bb[k] = yb[i]; }
#pragma unroll
        for (int k = 0; k < 4; ++k) { const size_t i = i0 + k * stride; f32x4 h; h.x = bf2f(hw[k].x & 0xffffu); h.y = bf2f(hw[k].x >> 16); h.z = bf2f(hw[k].y & 0xffffu); h.w = bf2f(hw[k].y >> 16);
            const f32x4 y = dsk[k] * h + f[k] + bb[k];
            u32x2 w; w.x = pk2(gelu_tanh_f(y.x), gelu_tanh_f(y.y)); w.y = pk2(gelu_tanh_f(y.z), gelu_tanh_f(y.w)); ((u32x2*)F.O())[i] = w; }
    }
}
__device__ __forceinline__ void ph_mlstm_naive(const Frame& F0) {
    const Frame F = launder(F0);
    LAS float* sk = (LAS float*)F.lds; LAS float* sq = sk + 128; LAS float* sn = sq + 128; LAS float* spart = sn + 128; LAS float* snq = spart + 512;
    const int tid = F.tid, v = tid & 255, kh = tid >> 8;
    for (int it = blockIdx.x; it < NB * MH * 2; it += F.G) {
        const int dr = it & 1, hh = (it >> 1) % MH, b = it / (2 * MH);
        float C[64];
#pragma unroll
        for (int i = 0; i < 64; ++i) C[i] = 0.f;
        if (tid < 128) sn[tid] = 0.f;
        float m = 0.f;
        float* out = F.HDb() + (size_t)dr * NR * D;
        __syncthreads();
        for (int s = 0; s < TPB; ++s) {
            int p; if (dr == 0) p = s; else p = s < CTXL ? CTXL - 1 - s : TPB - 1 - (s - CTXL);
            const size_t r = (size_t)b * TPB + p; const bf16* row = F.QKVO() + r * MINW;
            const float ig = F.GATES()[r * 32 + dr * 16 + hh], fg = F.GATES()[r * 32 + dr * 16 + 8 + hh];
            const float logf = fminf(fg, 0.f) - log1pf(expf(-fabsf(fg)));
            const float mn = fmaxf(logf + m, ig); const float fp = expf(logf + m - mn), ip = expf(ig - mn); m = mn;
            const float vv = bf2f(row[2 * MQKW + hh * MDV + v]);
            if (tid < 128) { const float kk = bf2f(row[MQKW + hh * MDQK + tid]) * 0.08838834764831845f, qq = bf2f(row[hh * MDQK + tid]); sk[tid] = kk; sq[tid] = qq;
                const float nn = fp * sn[tid] + ip * kk; sn[tid] = nn; const float pq = wave_sum(nn * qq); if (F.lane == 0) snq[tid >> 6] = pq; }
            __syncthreads();
            float part = 0.f; const float iv = ip * vv;
#pragma unroll
            for (int i = 0; i < 64; ++i) { C[i] = fp * C[i] + iv * sk[kh * 64 + i]; part += C[i] * sq[kh * 64 + i]; }
            spart[kh * 256 + v] = part;
            __syncthreads();
            if (tid < 256) { const float num = spart[v] + spart[256 + v]; const float nq = snq[0] + snq[1]; const float dn = fmaxf(fabsf(nq), expf(-m)); out[r * D + hh * MDV + v] = num / dn; }
            __syncthreads();
        }
    }
}
__device__ __forceinline__ void ph_mlstm_fast(const Frame& F0) {
    const Frame F = launder(F0);
    for (int u = blockIdx.x; u < NB * MH * 2 * 4; u += F.G) {
        const int vq = u & 3, dr = (u >> 2) & 1, hh = (u >> 3) % MH, b = u / (8 * MH);
        att::ph_mlstm_body(F.tid, F.QKVO(), F.GATES(), F.HDb() + (size_t)dr * NR * D, b, hh, dr, vq, (char*)(unsigned char*)F.lds);
    }
}
__device__ __forceinline__ void ph_mlstm_readout(const Frame& F0) {
    const Frame F = launder(F0);
    const int lane = F.lane; const float* h0 = F.HDb(); const float* h1 = F.HDb() + (size_t)NR * D; const float* ng = F.in[IN_MNORMG];
    for (int r = F.gw; r < NR; r += F.NGW) {
        f32x4 a[MH], g[MH]; u32x2 ow[MH];
#pragma unroll
        for (int hh = 0; hh < MH; ++hh) { const size_t off = (size_t)r * D + hh * MDV + 4 * lane; a[hh] = *(const f32x4*)(h0 + off) + *(const f32x4*)(h1 + off); g[hh] = *(const f32x4*)(ng + hh * MDV + 4 * lane);
            ow[hh] = *(const u32x2*)(F.QKVO() + (size_t)r * MINW + 2 * MQKW + MVW + hh * MDV + 4 * lane); }
#pragma unroll
        for (int hh = 0; hh < MH; ++hh) {
            const float ss = wave_sum((a[hh].x * a[hh].x + a[hh].y * a[hh].y) + (a[hh].z * a[hh].z + a[hh].w * a[hh].w)); const float rstd = 1.0f / sqrtf(ss * (1.0f / MDV) + NORM_EPS);
            f32x4 y = a[hh] * rstd * g[hh]; y.x *= sigmoid_f(bf2f(ow[hh].x & 0xffffu)); y.y *= sigmoid_f(bf2f(ow[hh].x >> 16)); y.z *= sigmoid_f(bf2f(ow[hh].y & 0xffffu)); y.w *= sigmoid_f(bf2f(ow[hh].y >> 16));
            u32x2 w; w.x = pk2(y.x, y.y); w.y = pk2(y.z, y.w); *(u32x2*)(F.O() + (size_t)r * D + hh * MDV + 4 * lane) = w; }
    }
}

__global__ void __launch_bounds__(NTHREADS, 2) fwd(Args args) {
    extern __shared__ __attribute__((aligned(16))) unsigned char lds_raw[];
    Frame F; F.lds = (LAS unsigned char*)lds_raw; F.tid = threadIdx.x; F.lane = F.tid & 63; F.wave = __builtin_amdgcn_readfirstlane(F.tid >> 6); F.G = gridDim.x;
    F.gw = blockIdx.x * NWAVES + F.wave; F.NGW = F.G * NWAVES; F.in = args.in; F.out = args.out; F.ws = args.ws;
    unsigned char* ws = args.ws;
    volatile LAS unsigned* MISC = (volatile LAS unsigned*)(F.lds + MISC_OFF);
    if (F.tid < 32) MISC[F.tid] = 0u;
    __syncthreads();
    XcdBarrier bar; bar.bar = (unsigned*)(ws + WS_CTL) + CW_BAR; bar.x = 0; bar.st = nullptr;
#if !MK_PER_PHASE
    bar = xcd_barrier_post((unsigned*)(ws + WS_CTL) + CW_BAR, MISC + 8);
#endif
    const int lo = args.ph_lo, hi = args.ph_hi; int ph = 0;
#define RUN() (lo <= ph && ph < hi)
#if MK_PER_PHASE
#define SEAM() do { ++ph; } while (0)
#else
#define SEAM() do { if (lo <= ph && ph + 1 < hi) xcd_barrier(bar.bar, bar.x, bar.st); ++ph; } while (0)
#endif
#if FAST_GEMM
#define GEMM(DUAL, A, lda, Wf, ldw, Bt, M, N, Nbt, K, doff, E) gemm_fast<DUAL>(F, A, Bt, (M) / 256, 0, Nbt, K, E)
    if (RUN()) { ph_init(F); ph_mod(F); ph_cvt_weights(F); if (PROBE_DUP == 1) { ph_mod(F); ph_cvt_weights(F); } } SEAM();
#else
#define GEMM(DUAL, A, lda, Wf, ldw, Bt, M, N, Nbt, K, doff, E) gemm_naive<DUAL>(F, A, lda, Wf, ldw, M, N, K, doff, E)
    if (RUN()) { ph_init(F); ph_mod(F); } SEAM();
#endif
#pragma unroll 1
    for (int L = 0; L < DEPTH; ++L) {
#pragma unroll 1
        for (int half = 0; half < 2; ++half) {
            if (half == 1) {
                const float* pg1 = F.MOD() + ((size_t)(L * 5 + 4) * NMOD + 2) * D;
                if (RUN()) ph_norm<false>(F, L, 1, pg1, 0.5f);
                SEAM();
                const float* g5 = F.MOD() + ((size_t)(L * 5) * NMOD + 5) * D;
                if (L == 0 || L == 3) {
                    const float* wqkv = F.in[L == 0 ? IN_AWQKV : IN_WWQKV]; const float* qkg = F.in[L == 0 ? IN_AQKG : IN_WQKG]; const float* wo = F.in[L == 0 ? IN_AWO : IN_WWO];
                    const bf16* wqkv_t = F.WT() + (L == 0 ? WT_AWQKV : WT_WWQKV); const bf16* wo_t = F.WT() + (L == 0 ? WT_AWO : WT_WWO);
                    if (RUN()) { EpiQKV E{F.Q(), F.K(), F.V()}; GEMM(false, F.H(), D, wqkv, QKVW, wqkv_t, NR, QKVW, QKVW, D, 0, E); } SEAM();
                    if (RUN()) ph_qknorm_rope(F, qkg); SEAM();
#if FAST_ATTN
                    if (L == 0) { if (RUN()) { ph_attn_fast<false>(F, nullptr); if (PROBE_DUP == 3) { __syncthreads(); ph_attn_fast<false>(F, nullptr); } } } else { if (RUN()) { ph_attn_fast<true>(F, F.in[IN_WSINK]); if (PROBE_DUP == 3) { __syncthreads(); ph_attn_fast<true>(F, F.in[IN_WSINK]); } } }
#else
                    if (L == 0) { if (RUN()) ph_attn_naive<false>(F, nullptr); } else { if (RUN()) ph_attn_naive<true>(F, F.in[IN_WSINK]); }
#endif
                    SEAM();
                    if (RUN()) { EpiRmw<0> E{F.X(), g5, nullptr}; gemm_down(F, F.O(), wo_t, D, L == 3 ? 0 : 1, E); } SEAM();
                } else if (L == 1) {
#if FAST_S5
                    if (RUN()) { ph_s5_fast(F); if (PROBE_DUP == 4) { __syncthreads(); ph_s5_fast(F); } } SEAM();
#else
                    if (RUN()) ph_s5_naive(F); SEAM();
#endif
                    if (RUN()) ph_s5_combine(F); SEAM();
                    if (RUN()) { EpiRmw<3> E{F.X(), g5, nullptr}; GEMM(true, F.O(), D, F.in[IN_S5WGLU], 2 * D, F.WT() + WT_GLU, NR, D, 2 * D, D, D, E); } SEAM();
                } else {
                    if (RUN()) { EpiMlstmIn E{F.QKVO(), F.GATES(), F.in[IN_MBGATE]}; gemm_fast<false>(F, F.H(), F.WT() + WT_MWIN, 36, 0, MINW + 256, D, E); } SEAM();
#if FAST_MLSTM
                    if (RUN()) { ph_mlstm_fast(F); if (PROBE_DUP == 4) { __syncthreads(); ph_mlstm_fast(F); } } SEAM();
#else
                    if (RUN()) ph_mlstm_naive(F); SEAM();
#endif
                    if (RUN()) ph_mlstm_readout(F); SEAM();
                    if (RUN()) { EpiRmw<0> E{F.X(), g5, nullptr}; gemm_down(F, F.O(), F.WT() + WT_MWOUT, D, 1, E); } SEAM();
                }
            }
            const int j = half * 2;
            const float* pg0 = (half == 0 && L > 0) ? F.MOD() + ((size_t)((L - 1) * 5 + 4) * NMOD + 8) * D : nullptr;
            if (half == 1 && (L == 0 || L == 2)) pg0 = F.MOD() + ((size_t)(L * 5 + 4) * NMOD + 5) * D;
            if (RUN()) ph_norm<false>(F, L, j, pg0, half == 1 ? 1.0f : 0.5f); SEAM();
            const float* wi = F.in[IN_FFNWI] + (size_t)(L * 2 + half) * D * 2 * DFF; const float* wo = F.in[IN_FFNWO] + (size_t)(L * 2 + half) * DFF * D;
            const bf16* wi_t = F.WT() + WT_FFNWI + (size_t)(L * 2 + half) * D * 2 * DFF; const bf16* wo_t = F.WT() + WT_FFNWO + (size_t)(L * 2 + half) * DFF * D;
            const int lastff = (L == DEPTH - 1 && half == 1);
            if (RUN()) { EpiSwiglu E{F.HID()}; gemm_fast<true>(F, F.H(), wi_t, lastff ? 32 : 36, lastff, 2 * DFF, D, E); } SEAM();
            const float* gg = F.MOD() + ((size_t)(L * 5) * NMOD + 3 * j + 2) * D;
            if (lastff) { if (RUN()) { EpiRmw<2> E{F.X(), gg, F.out}; gemm_down(F, F.HID(), wo_t, DFF, 0, E); } }
            else { if (RUN()) { EpiRmw<1> E{F.X(), gg, nullptr}; gemm_down(F, F.HID(), wo_t, DFF, 1, E); } }
            SEAM();
        }
    }
#undef RUN
#undef SEAM
}

constexpr int N_PHASES = 1 + 4 * 6 + (1 + 4) * 2 + (1 + 3) + (1 + 4);

extern "C" void kernel_launch(void* const* d_in, const int* in_sizes, int n_in, void* d_out, int out_size, void* d_ws, size_t ws_size, hipStream_t stream) {
    static int grid = 0;
    if (grid == 0) {
        if (n_in != 30 || out_size != NB * SEQ * D || ws_size < WS_END) { fprintf(stderr, "kernel_launch: unexpected shapes n_in %d out %d ws %zu\n", n_in, out_size, ws_size); grid = -1; return; }
        int dev = 0, cus = 0;
        if (hipGetDevice(&dev) != hipSuccess || hipDeviceGetAttribute(&cus, hipDeviceAttributeMultiprocessorCount, dev) != hipSuccess) { grid = -1; return; }
        if (hipFuncSetAttribute((const void*)fwd, hipFuncAttributeMaxDynamicSharedMemorySize, LDS_BYTES) != hipSuccess) { fprintf(stderr, "kernel_launch: hipFuncSetAttribute failed\n"); grid = -1; return; }
        int per_cu = 0; (void)hipOccupancyMaxActiveBlocksPerMultiprocessor(&per_cu, (const void*)fwd, NTHREADS, LDS_BYTES); (void)hipGetLastError();
        grid = cus;
    }
    if (grid < 0) return;
    (void)hipMemsetAsync((char*)d_ws + WS_CTL, 0, CTL_BYTES, stream);
    Args a{};
    for (int i = 0; i < 30; ++i) a.in[i] = (const float*)d_in[i];
    a.out = (float*)d_out; a.ws = (unsigned char*)d_ws;
#if MK_PER_PHASE
    for (int p = 0; p < N_PHASES; ++p) { a.ph_lo = p; a.ph_hi = p + 1; hipLaunchKernelGGL(fwd, dim3(grid), dim3(NTHREADS), LDS_BYTES, stream, a); }
#else
    a.ph_lo = 0; a.ph_hi = N_PHASES; hipLaunchKernelGGL(fwd, dim3(grid), dim3(NTHREADS), LDS_BYTES, stream, a);
#endif
    const hipError_t le = hipPeekAtLastError();
    if (le != hipSuccess) fprintf(stderr, "kernel_launch: launch failed: %s\n", hipGetErrorName(le));
}
```

```cpp
#include <hip/hip_runtime.h>
#include <cstdio>
#include <cstdint>

#ifndef MK_PER_PHASE
#define MK_PER_PHASE 0
#endif

#ifndef FAST_MLSTM
#define FAST_MLSTM 1
#endif
#ifndef CTX_SPLIT
#define CTX_SPLIT 1
#endif
#ifndef PROBE_DUP
#define PROBE_DUP 0
#endif
#ifndef FAST_S5
#define FAST_S5 1
#endif
#ifndef FAST_ATTN
#define FAST_ATTN 1
#endif
#ifndef FAST_GEMM
#define FAST_GEMM 1
#endif

#define GAS __attribute__((address_space(1)))
#define LAS __attribute__((address_space(3)))
typedef unsigned short bf16;
typedef float f32x4 __attribute__((ext_vector_type(4)));
typedef float f32x2 __attribute__((ext_vector_type(2)));
typedef unsigned u32x4 __attribute__((ext_vector_type(4)));
typedef unsigned u32x2 __attribute__((ext_vector_type(2)));

constexpr int D = 2048, NB = 4, SEQ = 2048, CTXL = 256, TPB = SEQ + CTXL, NR = NB * TPB;
constexpr int DFF = 5632, NMOD = 9, DEPTH = 4, GRID_W = 64;
constexpr int NH = 16, NKV = 4, HD = 128, QW = 2048, KVW = 512, QKVW = 3072;
constexpr int S5G = 128, S5GS = 16, S5N = 64;
constexpr int MH = 8, MDQK = 128, MDV = 256, MQKW = 1024, MVW = 2048, MINW = 6144;
constexpr float NORM_EPS = 1e-6f, GATE_CAP = 15.0f;
constexpr int NWAVES = 8, NTHREADS = 512;

constexpr size_t MiB = 1u << 20;
constexpr size_t WS_CTL = 0, CTL_BYTES = 1 * MiB;
constexpr size_t WS_MOD = 1 * MiB;
constexpr size_t WS_X = 4 * MiB;
constexpr size_t WS_H = 76 * MiB;
constexpr size_t WS_HID = 112 * MiB;
constexpr size_t WS_Q = 212 * MiB;
constexpr size_t WS_K = 248 * MiB;
constexpr size_t WS_V = 257 * MiB;
constexpr size_t WS_O = 266 * MiB;
constexpr size_t WS_QKVO = 302 * MiB;
constexpr size_t WS_GATES = 410 * MiB;
constexpr size_t WS_HD = 412 * MiB;
constexpr size_t WS_WT = 556 * MiB;
constexpr size_t WT_FFNWI = 0, WT_FFNWO = WT_FFNWI + (size_t)8 * D * 2 * DFF, WT_AWQKV = WT_FFNWO + (size_t)8 * DFF * D, WT_AWO = WT_AWQKV + (size_t)D * QKVW, WT_GLU = WT_AWO + (size_t)D * D,
                 WT_MWIN = WT_GLU + (size_t)D * 2 * D, WT_MWOUT = WT_MWIN + (size_t)D * (MINW + 256), WT_WWQKV = WT_MWOUT + (size_t)D * D, WT_WWO = WT_WWQKV + (size_t)D * QKVW, WT_ELEMS = WT_WWO + (size_t)D * D;
constexpr size_t WS_PEND = 1176 * MiB;
static_assert(WS_WT + WT_ELEMS * 2 <= WS_PEND, "ws map");
constexpr size_t WS_END = WS_PEND + 32 * MiB;

constexpr int CW_BAR = 4096;

__device__ __forceinline__ float bf2f(unsigned v) { return __uint_as_float(v << 16); }
typedef __bf16 bf16x2_t __attribute__((ext_vector_type(2)));
__device__ __forceinline__ unsigned pk2(float lo, float hi) { const f32x2 v = {lo, hi}; const bf16x2_t r = __builtin_convertvector(v, bf16x2_t); return __builtin_bit_cast(unsigned, r); }
__device__ __forceinline__ unsigned f2bf(float f) { return pk2(f, 0.f) & 0xffffu; }
template <int X> __device__ __forceinline__ float swz_xor(float v) { return __int_as_float(__builtin_amdgcn_ds_swizzle(__float_as_int(v), (X << 10) | 0x1f)); }
__device__ __forceinline__ float xor32(float v) { auto rr = __builtin_amdgcn_permlane32_swap(__float_as_uint(v), __float_as_uint(v), false, false); return __uint_as_float(rr[0]) + __uint_as_float(rr[1]) - v; }
__device__ __forceinline__ float wave_sum(float v) {
    v += swz_xor<1>(v); v += swz_xor<2>(v); v += swz_xor<4>(v); v += swz_xor<8>(v); v += swz_xor<16>(v);
    { auto rr = __builtin_amdgcn_permlane32_swap(__float_as_uint(v), __float_as_uint(v), false, false); v = __uint_as_float(rr[0]) + __uint_as_float(rr[1]); }
    return v;
}
__device__ __forceinline__ float sigmoid_f(float v) { return __builtin_amdgcn_rcpf(1.0f + __builtin_amdgcn_exp2f(v * -1.4426950408889634f)); }
__device__ __forceinline__ float silu_f(float v) { return v * sigmoid_f(v); }
__device__ __forceinline__ float gelu_tanh_f(float x) { const float u = 0.7978845608028654f * (x + 0.044715f * x * x * x); return 0.5f * x * (1.0f + tanhf(u)); }
__device__ __forceinline__ int row_ms(int r) { const int b = r / TPB; const int p = r - b * TPB; return p < CTXL ? 4 : b; }

#define XB_TMO      128
#define XB_XCNT(j)  (256  + 64 * (j))
#define XB_XSUB(j)  (1280 + 64 * (j))
#define XB_XGEN(j)  (2304 + 64 * (j))
#define XB_TOP      3328
#define XB_TOPGEN   3392
#define XCD_BAR_WORDS 3456
#define XB_SPIN_CAP (1u << 22)
__device__ __forceinline__ unsigned xb_ld(unsigned* p)              { return __hip_atomic_load(p, __ATOMIC_RELAXED, __HIP_MEMORY_SCOPE_AGENT); }
__device__ __forceinline__ unsigned xb_add(unsigned* p, unsigned v) { return __hip_atomic_fetch_add(p, v, __ATOMIC_RELAXED, __HIP_MEMORY_SCOPE_AGENT); }
__device__ __forceinline__ unsigned xb_xcc_id() { return (unsigned)__builtin_amdgcn_s_getreg((3 << 11) | 20) & 0xFu; }
#define XB_SPIN(cond, bar) do { unsigned _sp = 0; while (cond) { __builtin_amdgcn_s_sleep(1); \
    if ((++_sp & 255u) == 0u) { if (xb_ld(&(bar)[XB_TMO])) break; if (_sp > XB_SPIN_CAP) { atomicAdd(&(bar)[XB_TMO], 1u); break; } } } } while (0)
struct XcdBarrier { unsigned* bar; unsigned x; volatile LAS unsigned* st; };
__device__ __forceinline__ XcdBarrier xcd_barrier_post(unsigned* bar, volatile LAS unsigned* st) {
    XcdBarrier b; b.bar = bar; b.x = xb_xcc_id(); b.st = st;
    if (threadIdx.x == 0) (void)xb_add(&bar[XB_XCNT(b.x)], 1u);
    return b;
}
__device__ __forceinline__ void xcd_barrier_complete(unsigned* bar, unsigned x, unsigned& nloc, unsigned& nx) {
    const unsigned G = gridDim.x * gridDim.y * gridDim.z;
    unsigned sum, cnt, mine, sp = 0u;
    for (;;) {
        sum = 0u; cnt = 0u; mine = 0u;
#pragma unroll
        for (unsigned j = 0; j < 16; ++j) { const unsigned c = xb_ld(&bar[XB_XCNT(j)]); sum += c; cnt += (c > 0u) ? 1u : 0u; mine = (j == x) ? c : mine; }
        if (sum == G) break;
        __builtin_amdgcn_s_sleep(1);
        if ((++sp & 255u) == 0u) { if (xb_ld(&bar[XB_TMO])) break; if (sp > XB_SPIN_CAP) { atomicAdd(&bar[XB_TMO], 1u); break; } }
    }
    nloc = mine > 0u ? mine : 1u; nx = cnt > 0u ? cnt : 1u;
}
__device__ __noinline__ void xcd_barrier(unsigned* bar_, unsigned x_, volatile LAS unsigned* st_) {
    XcdBarrier b; b.bar = bar_; b.x = x_; b.st = st_;
    asm volatile("s_waitcnt vmcnt(0)" ::: "memory");
    __syncthreads();
    if (threadIdx.x == 0) {
        unsigned* bar = b.bar;
        __builtin_amdgcn_s_waitcnt(0);
        unsigned nloc = b.st[0], nx = b.st[1];
        if (nloc == 0u) { xcd_barrier_complete(bar, b.x, nloc, nx); b.st[0] = nloc; b.st[1] = nx; }
        const unsigned old = xb_add(&bar[XB_XSUB(b.x)], 1u);
        const unsigned gen = old / nloc;
        if (old + 1u == (gen + 1u) * nloc) {
            __builtin_amdgcn_fence(__ATOMIC_RELEASE, "agent");
            asm volatile("s_waitcnt vmcnt(0)" ::: "memory");
            const unsigned og = xb_add(&bar[XB_TOP], 1u);
            const unsigned tg = og / nx;
            if (og + 1u == (tg + 1u) * nx) xb_add(&bar[XB_TOPGEN], 1u);
            else XB_SPIN(xb_ld(&bar[XB_TOPGEN]) == tg, bar);
            __builtin_amdgcn_fence(__ATOMIC_ACQUIRE, "agent");
            xb_add(&bar[XB_XGEN(b.x)], 1u);
            asm volatile("s_waitcnt vmcnt(0)" ::: "memory");
        } else {
            XB_SPIN(xb_ld(&bar[XB_XGEN(b.x)]) == gen, bar);
            __builtin_amdgcn_fence(__ATOMIC_ACQUIRE, "agent");
            asm volatile("s_waitcnt vmcnt(0)" ::: "memory");
        }
    }
    __syncthreads();
}

constexpr int LDS_BYTES = 147456;
constexpr int MISC_OFF = 131072 + 320;
struct Args { const float* in[30]; float* out; unsigned char* ws; int ph_lo, ph_hi; };
struct Frame {
    LAS unsigned char* lds; int tid, lane, wave, G, gw, NGW;
    const float* const* in; float* out; unsigned char* ws;
    __device__ __forceinline__ float* MOD() const { return (float*)(ws + WS_MOD); }
    __device__ __forceinline__ float* X() const { return (float*)(ws + WS_X); }
    __device__ __forceinline__ bf16* H() const { return (bf16*)(ws + WS_H); }
    __device__ __forceinline__ bf16* HID() const { return (bf16*)(ws + WS_HID); }
    __device__ __forceinline__ bf16* Q() const { return (bf16*)(ws + WS_Q); }
    __device__ __forceinline__ bf16* K() const { return (bf16*)(ws + WS_K); }
    __device__ __forceinline__ bf16* V() const { return (bf16*)(ws + WS_V); }
    __device__ __forceinline__ bf16* O() const { return (bf16*)(ws + WS_O); }
    __device__ __forceinline__ bf16* QKVO() const { return (bf16*)(ws + WS_QKVO); }
    __device__ __forceinline__ float* GATES() const { return (float*)(ws + WS_GATES); }
    __device__ __forceinline__ float* HDb() const { return (float*)(ws + WS_HD); }
    __device__ __forceinline__ bf16* WT() const { return (bf16*)(ws + WS_WT); }
    __device__ __forceinline__ float* PEND() const { return (float*)(ws + WS_PEND); }
};
__device__ __forceinline__ Frame launder(const Frame& F0) {
    Frame F = F0; asm volatile("" : "+v"(F.tid));
    { unsigned lo = (unsigned)(uintptr_t)F0.ws, hi = (unsigned)((uintptr_t)F0.ws >> 32); asm volatile("" : "+v"(lo), "+v"(hi));
      F.ws = (unsigned char*)(((uintptr_t)(unsigned)__builtin_amdgcn_readfirstlane(hi) << 32) | (uintptr_t)(unsigned)__builtin_amdgcn_readfirstlane(lo)); }
    F.lane = F.tid & 63; F.wave = __builtin_amdgcn_readfirstlane(F.tid >> 6); F.gw = blockIdx.x * NWAVES + F.wave; return F;
}
enum { IN_X = 0, IN_C, IN_CTX, IN_CCTX, IN_MODW, IN_MODB, IN_NORMG, IN_FFNWI, IN_FFNWO, IN_AWQKV, IN_AQKG, IN_AWO,
       IN_S5LRE, IN_S5LIM, IN_S5LDT, IN_S5BRE, IN_S5BIM, IN_S5CRE, IN_S5CIM, IN_S5D, IN_S5WGLU,
       IN_MWIN, IN_MWGATE, IN_MBGATE, IN_MNORMG, IN_MWOUT, IN_WWQKV, IN_WQKG, IN_WSINK, IN_WWO };

__device__ __forceinline__ const float* modp(const Frame& F, int L, int ms, int j) { return F.MOD() + ((size_t)(L * 5 + ms) * NMOD + j) * D; }

__device__ __forceinline__ void ph_init(const Frame& F0) {
    const Frame F = launder(F0);
    const f32x4* xin = (const f32x4*)F.in[IN_X]; const f32x4* cin = (const f32x4*)F.in[IN_CTX]; f32x4* X = (f32x4*)F.X();
    const size_t n4 = (size_t)NR * D / 4, stride = (size_t)F.G * NTHREADS;
    for (size_t i0 = (size_t)blockIdx.x * NTHREADS + F.tid; i0 < n4; i0 += 4 * stride) {
        f32x4 v[4];
#pragma unroll
        for (int k = 0; k < 4; ++k) { const size_t i = i0 + k * stride; const int r = (int)(i / (D / 4)), c4 = (int)(i % (D / 4)); const int b = r / TPB, p = r - b * TPB;
            v[k] = p < CTXL ? cin[((size_t)b * CTXL + p) * (D / 4) + c4] : xin[((size_t)b * SEQ + (p - CTXL)) * (D / 4) + c4]; }
#pragma unroll
        for (int k = 0; k < 4; ++k) X[i0 + k * stride] = v[k];
    }
}
__device__ __forceinline__ void ph_mod(const Frame& F0) {
    const Frame F = launder(F0);
    LAS float* sc = (LAS float*)F.lds;
    for (int i = F.tid; i < 5 * D; i += NTHREADS) { const int ms = i / D, k = i % D; const float v = ms < 4 ? F.in[IN_C][ms * D + k] : F.in[IN_CCTX][k]; sc[i] = silu_f(v); }
    __syncthreads();
    const int NC = NMOD * D;
    for (int idx = blockIdx.x * NTHREADS + F.tid; idx < DEPTH * NC; idx += F.G * NTHREADS) {
        const int L = idx / NC, col = idx % NC; const float* w = F.in[IN_MODW] + (size_t)L * D * NC + col;
        float a0 = 0, a1 = 0, a2 = 0, a3 = 0, a4 = 0;
#pragma unroll 8
        for (int k = 0; k < D; ++k) { const float wv = w[(size_t)k * NC]; a0 += sc[k] * wv; a1 += sc[D + k] * wv; a2 += sc[2 * D + k] * wv; a3 += sc[3 * D + k] * wv; a4 += sc[4 * D + k] * wv; }
        const float bb = F.in[IN_MODB][(size_t)L * NC + col];
        float* o = F.MOD() + (size_t)L * 5 * NC + col;
        o[0] = a0 + bb; o[NC] = a1 + bb; o[2 * NC] = a2 + bb; o[3 * NC] = a3 + bb; o[4 * NC] = a4 + bb;
    }
    __syncthreads();
}
template <bool GATES>
__device__ __forceinline__ void ph_norm(const Frame& F0, int L, int j, const float* pend_gate, float pcoef, bool from_inputs = false) {
    const Frame F = launder(F0);
    const float* ng = F.in[IN_NORMG] + (size_t)(L * 3 + j) * D;
    if (!CTX_SPLIT) pend_gate = nullptr;
    for (int r = F.gw; r < NR; r += F.NGW) {
        const int ms = row_ms(r);
        const f32x4* xr = (const f32x4*)(F.X() + (size_t)r * D) + F.lane;
        if (from_inputs) { const int b = r / TPB, p = r - b * TPB; xr = (const f32x4*)(p < CTXL ? F.in[IN_CTX] + ((size_t)b * CTXL + p) * D : F.in[IN_X] + ((size_t)b * SEQ + (p - CTXL)) * D) + F.lane; }
        const f32x4* g4 = (const f32x4*)ng + F.lane; const f32x4* sh4 = (const f32x4*)modp(F, L, ms, 3 * j) + F.lane; const f32x4* sc4 = (const f32x4*)modp(F, L, ms, 3 * j + 1) + F.lane;
        f32x4 v[8], gg[8], shv[8], scv[8]; float ss = 0.f;
#pragma unroll
        for (int q = 0; q < 8; ++q) { v[q] = xr[64 * q]; gg[q] = g4[64 * q]; shv[q] = sh4[64 * q]; scv[q] = sc4[64 * q]; }
        if (pend_gate != nullptr && ms == 4) {
            const int b = r / TPB, cr = b * CTXL + (r - b * TPB); const f32x4* pg4 = (const f32x4*)pend_gate + F.lane; const f32x4* p4 = (const f32x4*)(F.PEND() + (size_t)cr * D) + F.lane;
            f32x4* xw = (f32x4*)(F.X() + (size_t)r * D) + F.lane;
            f32x4 ps[8];
#pragma unroll
            for (int q = 0; q < 8; ++q) ps[q] = ((p4[64 * q] + p4[64 * q + (size_t)NB * CTXL * D / 4]) + (p4[64 * q + (size_t)2 * NB * CTXL * D / 4] + p4[64 * q + (size_t)3 * NB * CTXL * D / 4])) * pg4[64 * q];
#pragma unroll
            for (int q = 0; q < 8; ++q) { v[q] = v[q] + pcoef * ps[q]; xw[64 * q] = v[q]; }
        }
        if (from_inputs) { f32x4* xw = (f32x4*)(F.X() + (size_t)r * D) + F.lane;
#pragma unroll
            for (int q = 0; q < 8; ++q) xw[64 * q] = v[q]; }
#pragma unroll
        for (int q = 0; q < 8; ++q) ss += (v[q].x * v[q].x + v[q].y * v[q].y) + (v[q].z * v[q].z + v[q].w * v[q].w);
        const float rstd = 1.0f / sqrtf(wave_sum(ss) * (1.0f / D) + NORM_EPS);
        u32x2* o = (u32x2*)(F.H() + (size_t)r * D) + F.lane;
#pragma unroll
        for (int q = 0; q < 8; ++q) { v[q] = (v[q] * rstd) * gg[q] * (scv[q] + 1.0f) + shv[q];
            u32x2 w; w.x = pk2(v[q].x, v[q].y); w.y = pk2(v[q].z, v[q].w); o[64 * q] = w; }
        if constexpr (GATES) {
            LAS float* hrow = (LAS float*)F.lds + F.wave * D;
#pragma unroll
            for (int q = 0; q < 8; ++q) *(LAS f32x4*)(hrow + (F.lane + 64 * q) * 4) = v[q];
            const int t = F.lane & 31, hf = F.lane >> 5; const float* wg = F.in[IN_MWGATE] + t; float acc = 0.f;
#pragma unroll 8
            for (int d = hf * 1024; d < hf * 1024 + 1024; ++d) acc += hrow[d] * wg[(size_t)d * 32];
            { auto rr = __builtin_amdgcn_permlane32_swap(__float_as_uint(acc), __float_as_uint(acc), false, false); acc = __uint_as_float(rr[0]) + __uint_as_float(rr[1]); }
            if (F.lane < 32) { const float g = acc + F.in[IN_MBGATE][t]; F.GATES()[(size_t)r * 32 + t] = GATE_CAP * tanhf(g / GATE_CAP); }
        }
    }
}

struct EpiSwiglu { bf16* HID;
    __device__ __forceinline__ void operator()(int r, int c, f32x4 a, f32x4 g) const {
        u32x2 w; w.x = pk2(silu_f(g.x) * a.x, silu_f(g.y) * a.y); w.y = pk2(silu_f(g.z) * a.z, silu_f(g.w) * a.w);
        *(u32x2*)(HID + (size_t)r * DFF + c) = w; } };
template <int HALF> struct EpiResid { float* X; const float* gate;
    __device__ __forceinline__ void operator()(int r, int c, f32x4 a, f32x4) const {
        const int ms = row_ms(r); const f32x4 g = *(const f32x4*)(gate + (size_t)ms * NMOD * D + c);
        f32x4* xp = (f32x4*)(X + (size_t)r * D + c); *xp = *xp + (HALF ? 0.5f : 1.0f) * (g * a); } };
struct EpiFinal { const float* X; const float* gate; float* out;
    __device__ __forceinline__ void operator()(int r, int c, f32x4 a, f32x4) const {
        const int b = r / TPB, p = r - b * TPB; if (p < CTXL) return;
        const f32x4 g = *(const f32x4*)(gate + (size_t)b * NMOD * D + c);
        *(f32x4*)(out + ((size_t)b * SEQ + (p - CTXL)) * D + c) = *(const f32x4*)(X + (size_t)r * D + c) + 0.5f * (g * a); } };
struct EpiGluResid { float* X; const float* gate;
    __device__ __forceinline__ void operator()(int r, int c, f32x4 a, f32x4 g) const {
        const int ms = row_ms(r); const f32x4 gt = *(const f32x4*)(gate + (size_t)ms * NMOD * D + c);
        f32x4* xp = (f32x4*)(X + (size_t)r * D + c); f32x4 s; s.x = sigmoid_f(g.x); s.y = sigmoid_f(g.y); s.z = sigmoid_f(g.z); s.w = sigmoid_f(g.w);
        *xp = *xp + gt * a * s; } };
struct EpiQKV { bf16 *Q, *K, *V;
    __device__ __forceinline__ void operator()(int r, int c, f32x4 a, f32x4) const {
        u32x2 w; w.x = pk2(a.x, a.y); w.y = pk2(a.z, a.w);
        bf16* p = c < QW ? Q + (size_t)r * QW + c : (c < QW + KVW ? K + (size_t)r * KVW + (c - QW) : V + (size_t)r * KVW + (c - QW - KVW));
        *(u32x2*)p = w; } };
struct EpiMlstmIn { bf16* O; float* G; const float* bg;
    __device__ __forceinline__ void operator()(int r, int c, f32x4 a, f32x4) const {
        if (c < MINW) { u32x2 w; w.x = pk2(a.x, a.y); w.y = pk2(a.z, a.w); *(u32x2*)(O + (size_t)r * MINW + c) = w; }
        else if (c < MINW + 32) { const f32x4 b = *(const f32x4*)(bg + (c - MINW)); f32x4 g;
            g.x = GATE_CAP * tanhf((a.x + b.x) * (1.0f / GATE_CAP)); g.y = GATE_CAP * tanhf((a.y + b.y) * (1.0f / GATE_CAP)); g.z = GATE_CAP * tanhf((a.z + b.z) * (1.0f / GATE_CAP)); g.w = GATE_CAP * tanhf((a.w + b.w) * (1.0f / GATE_CAP));
            *(f32x4*)(G + (size_t)r * 32 + (c - MINW)) = g; }
    } };
struct EpiBf16 { bf16* O; int ld;
    __device__ __forceinline__ void operator()(int r, int c, f32x4 a, f32x4) const { u32x2 w; w.x = pk2(a.x, a.y); w.y = pk2(a.z, a.w); *(u32x2*)(O + (size_t)r * ld + c) = w; } };

template <bool DUAL, class Epi>
__device__ __forceinline__ void gemm_naive(const Frame& F0, const bf16* A, int lda, const float* W, int ldw, int M, int N, int K, int dual_off, const Epi E) {
    const Frame F = launder(F0);
    constexpr int BM = 128, BN = 128, BK = 16;
    LAS float* As = (LAS float*)F.lds;
    LAS float* Bs = As + BK * (BM + 4);
    LAS float* B2 = Bs + BK * BN;
    const int ty = F.tid >> 5, tx = F.tid & 31;
    const int ntm = M / BM, ntn = N / BN, nt = ntm * ntn;
    for (int t = blockIdx.x; t < nt; t += F.G) {
        const int tm = t / ntn, tn = t % ntn; const int m0 = tm * BM, n0 = tn * BN;
        f32x4 acc[8], acc2[8];
#pragma unroll
        for (int i = 0; i < 8; ++i) { acc[i] = (f32x4){0.f, 0.f, 0.f, 0.f}; acc2[i] = (f32x4){0.f, 0.f, 0.f, 0.f}; }
        for (int k0 = 0; k0 < K; k0 += BK) {
            { const int row = F.tid >> 2, kq = (F.tid & 3) * 4; const u32x2 w = *(const u32x2*)(A + (size_t)(m0 + row) * lda + k0 + kq);
              As[(kq + 0) * (BM + 4) + row] = bf2f(w.x & 0xffffu); As[(kq + 1) * (BM + 4) + row] = bf2f(w.x >> 16); As[(kq + 2) * (BM + 4) + row] = bf2f(w.y & 0xffffu); As[(kq + 3) * (BM + 4) + row] = bf2f(w.y >> 16); }
            { const int kk = F.tid >> 5, c4 = (F.tid & 31) * 4; *(LAS f32x4*)(Bs + kk * BN + c4) = *(const f32x4*)(W + (size_t)(k0 + kk) * ldw + n0 + c4);
              if constexpr (DUAL) *(LAS f32x4*)(B2 + kk * BN + c4) = *(const f32x4*)(W + (size_t)(k0 + kk) * ldw + dual_off + n0 + c4); }
            __syncthreads();
#pragma unroll
            for (int kk = 0; kk < BK; ++kk) {
                const f32x4 a0 = *(LAS f32x4*)(As + kk * (BM + 4) + ty * 8), a1 = *(LAS f32x4*)(As + kk * (BM + 4) + ty * 8 + 4);
                const f32x4 b = *(LAS f32x4*)(Bs + kk * BN + tx * 4);
                acc[0] += a0.x * b; acc[1] += a0.y * b; acc[2] += a0.z * b; acc[3] += a0.w * b; acc[4] += a1.x * b; acc[5] += a1.y * b; acc[6] += a1.z * b; acc[7] += a1.w * b;
                if constexpr (DUAL) { const f32x4 b2 = *(LAS f32x4*)(B2 + kk * BN + tx * 4);
                    acc2[0] += a0.x * b2; acc2[1] += a0.y * b2; acc2[2] += a0.z * b2; acc2[3] += a0.w * b2; acc2[4] += a1.x * b2; acc2[5] += a1.y * b2; acc2[6] += a1.z * b2; acc2[7] += a1.w * b2; }
            }
            __syncthreads();
        }
#pragma unroll
        for (int i = 0; i < 8; ++i) E(m0 + ty * 8 + i, n0 + tx * 4, acc[i], acc2[i]);
    }
}

namespace pg8 {
#define PG8_LAS __attribute__((address_space(3)))
typedef unsigned short bf16_t;
typedef short bf16x8 __attribute__((ext_vector_type(8)));
typedef float f32x4 __attribute__((ext_vector_type(4)));
typedef unsigned u32x4 __attribute__((ext_vector_type(4)));
constexpr int BM = 256, BK = 64, HALF = 128, HTB = HALF * BK * 2  , STAGE_BYTES = 8 * HTB, NXCD = 8, WGM = 8;

__host__ __device__ __forceinline__ int lds_byte(int r, int c) { const int st = (r >> 4) * 2 + (c >> 5), rr = r & 15, cc = c & 31, ob = rr * 64 + cc * 2; return st * 1024 + (ob ^ (((ob >> 9) & 1) << 5)); }
__host__ __device__ __forceinline__ void stage_rc(int b, int& R, int& C) { const int st = b / 1024, sb = b % 1024, swz = sb ^ (((sb >> 9) & 1) << 5); R = (st >> 1) * 16 + swz / 64; C = (st & 1) * 32 + (swz % 64) / 2; }
__host__ __device__ __forceinline__ int perm32(int rho) { const int n = rho >> 4, i = rho & 15; return 8 * (i >> 2) + 4 * n + (i & 3); }

struct Unit { int pm, pn, ks; };
struct Gemm { const bf16_t* A; const bf16_t* Bt; int lda, ldb; };

struct StaticOrder {
    int nM, nN, nwg, G, c;
    __host__ __device__ void init(int M, int N, int G_, int c_) { nM = M / BM; nN = N / BM; nwg = nM * nN; G = G_; c = c_; }
    __host__ __device__ bool next(int i, Unit& u) const {
        const long L = (long)i * G + c; if (L >= nwg) { u.pm = 0; u.pn = 0; return false; }
        int wgid = (int)L; { const int q = nwg / NXCD, r = nwg % NXCD, xcd = wgid % NXCD, off = wgid / NXCD; wgid = (xcd < r ? xcd * (q + 1) : r * (q + 1) + (xcd - r) * q) + off; }
        const int nig = WGM * nN, gid = wgid / nig, fm = gid * WGM, gsz = (nM - fm) < WGM ? (nM - fm) : WGM;
        u.pm = fm + ((wgid % nig) % gsz); u.pn = (wgid % nig) / gsz; return true;
    }
    __device__ __forceinline__ void a_ready(const Unit&) const {}
    __device__ __forceinline__ void done(const Unit&) const {}
};
struct TileSched {
    StaticOrder so; int lat, ctx_split, lda, ldb, ntK;
    __device__ __forceinline__ void init(int nMlog, int Nbt, int G, int c, int lat_, int ctx_split_, int lda_, int ldb_, int K) { so.init(nMlog * BM, Nbt, G, c); lat = lat_; ctx_split = ctx_split_; lda = lda_; ldb = ldb_; ntK = K / BK; }
    __device__ __forceinline__ bool next(int i, Unit& u) const {
        Unit t; t.pm = 0; t.pn = 0; t.ks = -1; const bool main = so.next(i, t);
        int pm = lat ? t.pm + t.pm / 8 + 1 : t.pm, pn = t.pn, ks = -1; bool ok = main;
        if (!main && ctx_split) { const long e = (long)i * so.G + so.c - so.nwg; ok = (e >= 0 && e < 128); const int tile = (int)e >> 2; ks = (int)e & 3; pm = 9 * (tile >> 3); pn = tile & 7; }
        u.pm = pm; u.pn = pn; u.ks = ks; return ok;
    }
    __device__ __forceinline__ int k0(const Unit& u) const { return u.ks <= 0 ? 0 : (ntK >> 2) * u.ks; }
    __device__ __forceinline__ int nt(const Unit& u) const { return u.ks < 0 ? ntK : (ntK >> 2); }
    __device__ __forceinline__ size_t a_off(const Unit& u) const { return ((size_t)u.pm * BM * lda + (size_t)k0(u) * BK) * 2; }
    __device__ __forceinline__ size_t b_off(const Unit& u) const { return ((size_t)u.pn * BM * ldb + (size_t)k0(u) * BK) * 2; }
    __device__ __forceinline__ void a_ready(const Unit&) const {}
    __device__ __forceinline__ void done(const Unit&) const {}
};
template <class Epi, class Sched, bool ALIGN_EPI = false, bool SP2 = false>
__device__ __forceinline__ void gemm_phase(PG8_LAS unsigned char* lds, const Gemm g, const Sched& S, const Epi& E) {
    int tid_ = threadIdx.x; asm volatile("" : "+v"(tid_));
    const int tid = tid_, wid = __builtin_amdgcn_readfirstlane(tid >> 6), lane = tid & 63, wr = wid >> 2, wc = wid & 3, fr = lane & 15, fq = lane >> 4;
    unsigned voffA[2], voffB[2];
#pragma unroll
    for (int i = 0; i < 2; ++i) { int R, C; stage_rc(tid * 16 + i * 8192, R, C); const int Rb = Epi::PERM ? ((R & ~31) + perm32(R & 31)) : R;
        voffA[i] = (unsigned)(R * g.lda + C) * 2u; voffB[i] = (unsigned)(Rb * g.ldb + C) * 2u; }
    const size_t kstep = (size_t)(BK * 2);
    const size_t hstepA = (size_t)HALF * g.lda * 2, hstepB = (size_t)HALF * g.ldb * 2;
    const unsigned ldsw = (unsigned)wid * 1024u;
    const int aoff = lds_byte(wr * 64 + fr, fq * 8), boff = lds_byte(wc * 32 + fr, fq * 8);
#define PG8_SA(b, h) (((b) * 2 + (h)) * HTB)
#define PG8_SB(b, h) ((4 + (b) * 2 + (h)) * HTB)
#define PG8_STAGE(bufoff, gbase, voff) do { _Pragma("unroll") for (int _i = 0; _i < 2; ++_i) \
        __builtin_amdgcn_global_load_lds((const unsigned*)((const char*)(gbase) + (voff)[_i]), (PG8_LAS unsigned*)(lds + (bufoff) + ldsw + _i * 8192), 16, 0, 0); } while (0)
#define PG8_LDA(dst, b, h) do { _Pragma("unroll") for (int m = 0; m < 4; ++m) _Pragma("unroll") for (int k = 0; k < 2; ++k) dst[m][k] = *(const PG8_LAS bf16x8*)(lds + PG8_SA(b, h) + aoff + m * 2048 + k * 1024); } while (0)
#define PG8_LDB(dst, b, h) do { _Pragma("unroll") for (int n = 0; n < 2; ++n) _Pragma("unroll") for (int k = 0; k < 2; ++k) dst[n][k] = *(const PG8_LAS bf16x8*)(lds + PG8_SB(b, h) + boff + n * 2048 + k * 1024); } while (0)
#define PG8_MMA(ai, bj, At, Bt) do { __builtin_amdgcn_s_setprio(1); _Pragma("unroll") for (int m = 0; m < 4; ++m) _Pragma("unroll") for (int n = 0; n < 2; ++n) _Pragma("unroll") for (int k = 0; k < 2; ++k) \
        acc[ai][bj][m][n] = __builtin_amdgcn_mfma_f32_16x16x32_bf16(Bt[n][k], At[m][k], acc[ai][bj][m][n], 0, 0, 0); __builtin_amdgcn_s_setprio(0); } while (0)
#define PG8_WAIT_V(n) asm volatile("s_waitcnt vmcnt(" #n ")" ::: "memory")
#define PG8_WAIT_L(n) asm volatile("s_waitcnt lgkmcnt(" #n ")" ::: "memory")
#define PG8_BAR __builtin_amdgcn_s_barrier()
#define PG8_SCHED __builtin_amdgcn_sched_barrier(0)
    Unit cur, nxt; int ui = 0;
    if (!S.next(0, cur)) return;
    f32x4 acc[2][2][4][2];
#pragma unroll
    for (int a = 0; a < 2; ++a)
#pragma unroll
        for (int b = 0; b < 2; ++b)
#pragma unroll
            for (int m = 0; m < 4; ++m)
#pragma unroll
                for (int n = 0; n < 2; ++n) acc[a][b][m][n] = (f32x4){0.f, 0.f, 0.f, 0.f};
    bf16x8 At[4][2], B0[2][2], B1[2][2];
    const char* cA = (const char*)g.A + S.a_off(cur); const char* cB = (const char*)g.Bt + S.b_off(cur);
    S.a_ready(cur);
    if constexpr (SP2) {
        PG8_STAGE(PG8_SB(0, 0), cB, voffB); PG8_STAGE(PG8_SB(0, 1), cB + hstepB, voffB); PG8_STAGE(PG8_SA(0, 0), cA, voffA); PG8_STAGE(PG8_SA(0, 1), cA + hstepA, voffA);
        if (wr == 1) PG8_BAR;
        PG8_WAIT_V(2); PG8_BAR;
        PG8_STAGE(PG8_SB(1, 0), cB + kstep, voffB); PG8_STAGE(PG8_SA(1, 0), cA + kstep, voffA); PG8_STAGE(PG8_SB(1, 1), cB + hstepB + kstep, voffB);
        PG8_WAIT_V(6); PG8_BAR;
    } else {
        PG8_STAGE(PG8_SB(0, 0), cB, voffB); PG8_STAGE(PG8_SA(0, 0), cA, voffA); PG8_STAGE(PG8_SB(0, 1), cB + hstepB, voffB); PG8_STAGE(PG8_SA(0, 1), cA + hstepA, voffA);
        if (wr == 1) PG8_BAR;
        PG8_WAIT_V(4); PG8_BAR;
        PG8_STAGE(PG8_SB(1, 0), cB + kstep, voffB); PG8_STAGE(PG8_SA(1, 0), cA + kstep, voffA); PG8_STAGE(PG8_SB(1, 1), cB + hstepB + kstep, voffB);
        PG8_WAIT_V(6); PG8_BAR;
    }
    for (;;) {
        const bool has_next = S.next(ui + 1, nxt);
        const char* nA = has_next ? (const char*)g.A + S.a_off(nxt) : cA; const char* nB = has_next ? (const char*)g.Bt + S.b_off(nxt) : cB;
        const int nt = S.nt(cur);
        for (int t = 0; t < nt; t += 2) {
            const bool last = (t == nt - 2);
            const char* a1 = cA + (size_t)(t + 1) * kstep;
            const char* a2 = last ? nA : cA + (size_t)(t + 2) * kstep; const char* b2 = last ? nB : cB + (size_t)(t + 2) * kstep;
            const char* a3 = a2 + kstep; const char* b3 = b2 + kstep;
            if (last && has_next) S.a_ready(nxt);
            if constexpr (SP2) {
            PG8_LDB(B0, 0, 0); PG8_LDB(B1, 0, 1); PG8_SCHED; PG8_LDA(At, 0, 0); PG8_STAGE(PG8_SA(1, 1), a1 + hstepA, voffA);
            PG8_WAIT_V(8); PG8_WAIT_L(0); PG8_BAR; PG8_MMA(0, 0, At, B0); PG8_MMA(0, 1, At, B1); PG8_BAR; PG8_SCHED;
            PG8_LDA(At, 0, 1); PG8_STAGE(PG8_SB(0, 0), b2, voffB); PG8_STAGE(PG8_SB(0, 1), b2 + hstepB, voffB); PG8_STAGE(PG8_SA(0, 0), a2, voffA);
            PG8_WAIT_V(8); PG8_WAIT_L(0); PG8_BAR; PG8_MMA(1, 0, At, B0); PG8_MMA(1, 1, At, B1); PG8_BAR; PG8_SCHED;
            PG8_LDB(B0, 1, 0); PG8_LDB(B1, 1, 1); PG8_SCHED; PG8_LDA(At, 1, 0); PG8_STAGE(PG8_SA(0, 1), a2 + hstepA, voffA);
            PG8_WAIT_V(8); PG8_WAIT_L(0); PG8_BAR; PG8_MMA(0, 0, At, B0); PG8_MMA(0, 1, At, B1); PG8_BAR; PG8_SCHED;
            PG8_LDA(At, 1, 1); PG8_STAGE(PG8_SB(1, 0), b3, voffB); PG8_STAGE(PG8_SB(1, 1), b3 + hstepB, voffB); PG8_STAGE(PG8_SA(1, 0), a3, voffA);
            PG8_WAIT_V(8); PG8_WAIT_L(0); PG8_BAR; PG8_MMA(1, 0, At, B0); PG8_MMA(1, 1, At, B1); PG8_BAR; PG8_SCHED;
            } else {
            PG8_LDB(B0, 0, 0); PG8_SCHED; PG8_LDA(At, 0, 0); PG8_STAGE(PG8_SA(1, 1), a1 + hstepA, voffA);
            PG8_WAIT_L(8); PG8_BAR; PG8_WAIT_L(0); PG8_MMA(0, 0, At, B0); PG8_BAR; PG8_SCHED;
            PG8_LDB(B1, 0, 1); PG8_STAGE(PG8_SB(0, 0), b2, voffB);
            PG8_BAR; PG8_WAIT_L(0); PG8_MMA(0, 1, At, B1); PG8_BAR;
            PG8_LDA(At, 0, 1); PG8_STAGE(PG8_SA(0, 0), a2, voffA);
            PG8_BAR; PG8_WAIT_L(0); PG8_MMA(1, 0, At, B0); PG8_BAR; PG8_SCHED;
            PG8_STAGE(PG8_SB(0, 1), b2 + hstepB, voffB);
            PG8_WAIT_V(6); PG8_BAR; PG8_MMA(1, 1, At, B1); PG8_BAR;
            PG8_LDB(B0, 1, 0); PG8_SCHED; PG8_LDA(At, 1, 0); PG8_STAGE(PG8_SA(0, 1), a2 + hstepA, voffA);
            PG8_WAIT_L(8); PG8_BAR; PG8_WAIT_L(0); PG8_MMA(0, 0, At, B0); PG8_BAR; PG8_SCHED;
            PG8_LDB(B1, 1, 1); PG8_STAGE(PG8_SB(1, 0), b3, voffB);
            PG8_BAR; PG8_WAIT_L(0); PG8_MMA(0, 1, At, B1); PG8_BAR;
            PG8_LDA(At, 1, 1); PG8_STAGE(PG8_SA(1, 0), a3, voffA);
            PG8_BAR; PG8_WAIT_L(0); PG8_MMA(1, 0, At, B0); PG8_BAR; PG8_SCHED;
            PG8_STAGE(PG8_SB(1, 1), b3 + hstepB, voffB);
            PG8_WAIT_V(6); PG8_BAR; PG8_MMA(1, 1, At, B1); PG8_BAR;
            }
        }
        if constexpr (ALIGN_EPI) { if (wr == 0) PG8_BAR; }
        if constexpr (!Epi::AFTER_DRAIN) { E(acc, cur, wr, wc, fr, fq); S.done(cur); }
        if (!has_next) break;
#pragma unroll
        for (int a = 0; a < 2; ++a)
#pragma unroll
            for (int b = 0; b < 2; ++b)
#pragma unroll
                for (int m = 0; m < 4; ++m)
#pragma unroll
                    for (int n = 0; n < 2; ++n) acc[a][b][m][n] = (f32x4){0.f, 0.f, 0.f, 0.f};
        cur = nxt; cA = nA; cB = nB; ++ui;
        if constexpr (ALIGN_EPI) { if (wr == 1) PG8_BAR; }
    }
    PG8_WAIT_V(0);
    if constexpr (!ALIGN_EPI) { if (wr == 0) PG8_BAR; }
    PG8_BAR;
    if constexpr (Epi::AFTER_DRAIN) { E.fused(acc, cur, wr, wc, fr, fq, lds, wid, lane); S.done(cur); }
#undef PG8_SA
#undef PG8_SB
#undef PG8_STAGE
#undef PG8_LDA
#undef PG8_LDB
#undef PG8_MMA
#undef PG8_WAIT_V
#undef PG8_WAIT_L
#undef PG8_BAR
#undef PG8_SCHED
}
}

template <int KIND> struct EpiRmw { static constexpr bool RMW = true; float* X; const float* gate; float* out; };
template <int KIND, bool DUAL>
__device__ __forceinline__ void rmw_tile(const EpiRmw<KIND>& e, const pg8::f32x4 (&acc)[2][2][4][2], const pg8::Unit& u, int wr, int wc, int fr, int fq) {
    constexpr int NC = DUAL ? 2 : 4;
    const int b = u.pm / 9, ms = (u.pm - 9 * b) == 0 ? 4 : b;
    int col[NC]; f32x4 gv[NC];
#pragma unroll
    for (int k = 0; k < NC; ++k) { col[k] = DUAL ? u.pn * 128 + wc * 32 + k * 16 + 4 * fq : u.pn * 256 + (k >> 1) * 128 + wc * 32 + (k & 1) * 16 + 4 * fq;
        gv[k] = *(const f32x4*)(e.gate + (size_t)ms * NMOD * D + col[k]); if (KIND == 1 || KIND == 2) gv[k] = gv[k] * 0.5f; }
#pragma unroll
    for (int ai = 0; ai < 2; ++ai)
#pragma unroll
        for (int mp = 0; mp < 2; ++mp) {
            f32x4 x[2][NC];
#pragma unroll
            for (int mi = 0; mi < 2; ++mi) { const int r = u.pm * 256 + ai * 128 + wr * 64 + (2 * mp + mi) * 16 + fr;
#pragma unroll
                for (int k = 0; k < NC; ++k) x[mi][k] = *(const f32x4*)(e.X + (size_t)r * D + col[k]); }
#pragma unroll
            for (int mi = 0; mi < 2; ++mi) { const int m = 2 * mp + mi, rl = ai * 128 + wr * 64 + m * 16 + fr, r = u.pm * 256 + rl;
                float* dst = KIND == 2 ? e.out + ((size_t)b * SEQ + (size_t)(u.pm - 9 * b - 1) * 256 + rl) * D : e.X + (size_t)r * D;
#pragma unroll
                for (int k = 0; k < NC; ++k) { f32x4 a;
                    if constexpr (DUAL) { const f32x4 aa = acc[ai][0][m][k], gg = acc[ai][1][m][k]; a.x = aa.x * sigmoid_f(gg.x); a.y = aa.y * sigmoid_f(gg.y); a.z = aa.z * sigmoid_f(gg.z); a.w = aa.w * sigmoid_f(gg.w); }
                    else a = acc[ai][k >> 1][m][k & 1];
                    *(f32x4*)(dst + col[k]) = x[mi][k] + gv[k] * a; } }
            asm volatile("" ::: "memory");
        }
}
template <class T> struct is_rmw { static constexpr bool value = false; static constexpr int kind = -1; };
template <int KIND> struct is_rmw<EpiRmw<KIND>> { static constexpr bool value = true; static constexpr int kind = KIND; };

template <bool DUAL, class SE> struct EpiWrap {
    static constexpr bool PERM = false, AFTER_DRAIN = false;
    SE e;
    __device__ __forceinline__ void operator()(const pg8::f32x4 (&acc)[2][2][4][2], const pg8::Unit& u, int wr, int wc, int fr, int fq) const {
        if constexpr (is_rmw<SE>::value) { rmw_tile<is_rmw<SE>::kind, DUAL>(e, acc, u, wr, wc, fr, fq); return; } else {
#pragma unroll
        for (int ai = 0; ai < 2; ++ai)
#pragma unroll
            for (int m = 0; m < 4; ++m) { const int r = u.pm * 256 + ai * 128 + wr * 64 + m * 16 + fr;
                if constexpr (DUAL) {
#pragma unroll
                    for (int n = 0; n < 2; ++n) e(r, u.pn * 128 + wc * 32 + n * 16 + 4 * fq, acc[ai][0][m][n], acc[ai][1][m][n]);
                } else {
#pragma unroll
                    for (int bj = 0; bj < 2; ++bj)
#pragma unroll
                        for (int n = 0; n < 2; ++n) e(r, u.pn * 256 + bj * 128 + wc * 32 + n * 16 + 4 * fq, acc[ai][bj][m][n], acc[ai][bj][m][n]);
                }
                asm volatile("" ::: "memory"); }
        }
    }
};
template <bool DUAL, class SE>
__device__ __forceinline__ void gemm_fast(const Frame& F, const bf16* A, const bf16* Bt, int nMlog, int lat, int Nbt, int K, const SE e) {
    pg8::Gemm g{A, Bt, K, K}; pg8::TileSched S; S.init(nMlog, Nbt, F.G, (int)blockIdx.x, lat, 0, K, K, K);
    EpiWrap<DUAL, SE> E{e};
    pg8::gemm_phase<EpiWrap<DUAL, SE>, pg8::TileSched, true, true>(F.lds, g, S, E);
}
template <class SE> struct EpiDownWrap {
    static constexpr bool PERM = false, AFTER_DRAIN = false;
    SE e; float* P;
    __device__ __forceinline__ void operator()(const pg8::f32x4 (&acc)[2][2][4][2], const pg8::Unit& u, int wr, int wc, int fr, int fq) const {
        if (u.ks < 0) { rmw_tile<is_rmw<SE>::kind, false>(e, acc, u, wr, wc, fr, fq); return; }
#pragma unroll
        for (int ai = 0; ai < 2; ++ai)
#pragma unroll
            for (int m = 0; m < 4; ++m) { const int rl = ai * 128 + wr * 64 + m * 16 + fr, r = u.pm * 256 + rl;
                if (u.ks < 0) { (void)r; } else { float* pr = P + ((size_t)u.ks * (NB * CTXL) + (u.pm / 9) * 256 + rl) * D + u.pn * 256 + wc * 32 + 4 * fq;
#pragma unroll
                    for (int bj = 0; bj < 2; ++bj)
#pragma unroll
                        for (int n = 0; n < 2; ++n) *(f32x4*)(pr + bj * 128 + n * 16) = acc[ai][bj][m][n];
                }
                asm volatile("" ::: "memory"); }
    }
};
template <class SE>
__device__ __forceinline__ void gemm_down(const Frame& F, const bf16* A, const bf16* Bt, int K, int ctx_split, const SE e) {
    pg8::Gemm g{A, Bt, K, K}; pg8::TileSched S; if (CTX_SPLIT || !ctx_split) S.init(32, D, F.G, (int)blockIdx.x, 1, ctx_split, K, K, K); else S.init(36, D, F.G, (int)blockIdx.x, 0, 0, K, K, K);
    EpiDownWrap<SE> E{e, F.PEND()};
    pg8::gemm_phase<EpiDownWrap<SE>, pg8::TileSched, true, true>(F.lds, g, S, E);
}
__device__ __forceinline__ void cvt_item(const float* W, int K, int N, bf16* WT, int split, LAS float* scr, int item, int lane) {
    const int nblk = N / 32, kb = item / nblk, nb = item % nblk, k0 = 64 * kb, n0 = 32 * nb;
    int r0 = n0; if (split) { const int j = n0 < split ? n0 : n0 - split; r0 = (j >> 7) * 256 + (j & 127) + (n0 < split ? 0 : 128); }
#pragma unroll 8
    for (int i = 0; i < 32; ++i) { const int kk = 2 * i + (lane >> 5); scr[kk * 33 + (lane & 31)] = W[(size_t)(k0 + kk) * N + n0 + (lane & 31)]; }
    asm volatile("s_waitcnt lgkmcnt(0)" ::: "memory");
    const int c = lane & 7;
#pragma unroll
    for (int j = 0; j < 4; ++j) { const int n = (lane >> 3) + 8 * j; const LAS float* sp = scr + (8 * c) * 33 + n;
        u32x4 o; o.x = pk2(sp[0 * 33], sp[1 * 33]); o.y = pk2(sp[2 * 33], sp[3 * 33]); o.z = pk2(sp[4 * 33], sp[5 * 33]); o.w = pk2(sp[6 * 33], sp[7 * 33]);
        *(u32x4*)(WT + (size_t)(r0 + n) * K + k0 + 8 * c) = o; }
    asm volatile("s_waitcnt lgkmcnt(0)" ::: "memory");
}
__device__ __forceinline__ void ph_cvt_weights(const Frame& F0) {
    const Frame F = launder(F0);
    LAS float* scr = (LAS float*)(F.lds + F.wave * 16384);
    int it = F.gw;
#define CVT(Wp, K_, N_, dst, split) do { const int ni = ((K_) / 64) * ((N_) / 32); for (; it < ni; it += F.NGW) cvt_item((Wp), (K_), (N_), (dst), (split), scr, it, F.lane); it -= ni; } while (0)
#pragma unroll 1
    for (int m = 0; m < 8; ++m) CVT(F.in[IN_FFNWI] + (size_t)m * D * 2 * DFF, D, 2 * DFF, F.WT() + WT_FFNWI + (size_t)m * D * 2 * DFF, DFF);
#pragma unroll 1
    for (int m = 0; m < 8; ++m) CVT(F.in[IN_FFNWO] + (size_t)m * DFF * D, DFF, D, F.WT() + WT_FFNWO + (size_t)m * DFF * D, 0);
    CVT(F.in[IN_AWQKV], D, QKVW, F.WT() + WT_AWQKV, 0);
    CVT(F.in[IN_AWO], D, D, F.WT() + WT_AWO, 0);
    CVT(F.in[IN_S5WGLU], D, 2 * D, F.WT() + WT_GLU, D);
    CVT(F.in[IN_MWIN], D, MINW, F.WT() + WT_MWIN, 0);
    CVT(F.in[IN_MWGATE], D, 32, F.WT() + WT_MWIN + (size_t)MINW * D, 0);
    CVT(F.in[IN_MWOUT], D, D, F.WT() + WT_MWOUT, 0);
    CVT(F.in[IN_WWQKV], D, QKVW, F.WT() + WT_WWQKV, 0);
    CVT(F.in[IN_WWO], D, D, F.WT() + WT_WWO, 0);
#undef CVT
}

__device__ __forceinline__ void ph_qknorm_rope(const Frame& F0, const float* qkg) {
    const Frame F = launder(F0);
    const int lane = F.lane; const float g1q = qkg[lane] * 0.08838834764831845f, g2q = qkg[64 + lane] * 0.08838834764831845f, g1k = qkg[HD + lane], g2k = qkg[HD + 64 + lane];
    const float inv = exp2f(-(float)(lane & 31) * (13.287712379549449f / 32.0f));
    for (int r = F.gw; r < NR; r += F.NGW) {
        const int b = r / TPB, p = r - b * TPB;
        bf16* qb = F.Q() + (size_t)r * QW; bf16* kb = F.K() + (size_t)r * KVW;
        float x1[20], x2[20];
#pragma unroll
        for (int h = 0; h < 20; ++h) { const bf16* base = h < 16 ? qb + h * HD : kb + (h - 16) * HD; x1[h] = bf2f(base[lane]); x2[h] = bf2f(base[64 + lane]); }
        float cs = 1.f, sn = 0.f;
        if (p >= CTXL) { const int t = p - CTXL; const float pos = (lane < 32) ? (float)(t / GRID_W) : (float)(t % GRID_W); sincosf(pos * inv, &sn, &cs); }
#pragma unroll
        for (int h = 0; h < 20; ++h) {
            const float ss = wave_sum(x1[h] * x1[h] + x2[h] * x2[h]); const float rstd = 1.0f / sqrtf(ss * (1.0f / HD) + NORM_EPS);
            const float a1 = x1[h] * rstd * (h < 16 ? g1q : g1k), a2 = x2[h] * rstd * (h < 16 ? g2q : g2k);
            x1[h] = a1 * cs - a2 * sn; x2[h] = a2 * cs + a1 * sn; }
#pragma unroll
        for (int h = 0; h < 20; ++h) { bf16* base = h < 16 ? qb + h * HD : kb + (h - 16) * HD; base[lane] = (bf16)f2bf(x1[h]); base[64 + lane] = (bf16)f2bf(x2[h]); }
    }
}
template <bool WINDOW>
__device__ __forceinline__ void ph_attn_naive(const Frame& F0, const float* sink) {
    const Frame F = launder(F0);
    const int lane = F.lane;
    for (int it = F.gw; it < NR * NH; it += F.NGW) {
        const int r = it / NH, h = it % NH; const int b = r / TPB, p = r - b * TPB; const int kv = h / 4;
        if (WINDOW && p < CTXL) continue;
        const unsigned qw = *(const unsigned*)(F.Q() + (size_t)r * QW + h * HD + 2 * lane); const float q0 = bf2f(qw & 0xffffu), q1 = bf2f(qw >> 16);
        float m = -1e30f, l = 0.f, o0 = 0.f, o1 = 0.f;
        int lo2, hi2;
        if (p < CTXL) { lo2 = 0; hi2 = 0; } else if (WINDOW) { const int t = p - CTXL; lo2 = CTXL + (t - 128 < 0 ? 0 : t - 128); hi2 = CTXL + (t + 128 > SEQ - 1 ? SEQ - 1 : t + 128) + 1; } else { lo2 = CTXL; hi2 = TPB; }
        for (int seg = 0; seg < 2; ++seg) { const int lo = seg ? lo2 : 0, hi = seg ? hi2 : CTXL;
            for (int kp = lo; kp < hi; ++kp) {
                const size_t kr = (size_t)(b * TPB + kp) * KVW + kv * HD + 2 * lane;
                const unsigned kw = *(const unsigned*)(F.K() + kr), vw = *(const unsigned*)(F.V() + kr);
                const float s = wave_sum(q0 * bf2f(kw & 0xffffu) + q1 * bf2f(kw >> 16));
                const float mn = fmaxf(m, s); const float al = __expf(m - mn), pe = __expf(s - mn);
                l = l * al + pe; o0 = o0 * al + pe * bf2f(vw & 0xffffu); o1 = o1 * al + pe * bf2f(vw >> 16); m = mn;
            } }
        if (WINDOW) { const float sk = sink[h]; const float mn = fmaxf(m, sk); const float al = __expf(m - mn); l = l * al + __expf(sk - mn); o0 *= al; o1 *= al; }
        const float il = 1.0f / l;
        *(unsigned*)(F.O() + (size_t)r * QW + h * HD + 2 * lane) = pk2(o0 * il, o1 * il);
    }
}
namespace att {
using bf16x8 = __attribute__((ext_vector_type(8))) short;
using s16x4  = __attribute__((ext_vector_type(4))) short;
using f32x16 = __attribute__((ext_vector_type(16))) float;
using u32x4v = __attribute__((ext_vector_type(4))) unsigned;
constexpr int QBLK = 32, KVBLK = 64, LDQ = QW, LDK = KVW, LDO = QW, AD = 128;
#ifndef ATT_SDEPTH
#define ATT_SDEPTH 1
#endif
constexpr int SDEPTH = ATT_SDEPTH;
constexpr float THR = 8.f, C = 1.4426950408889634f;
constexpr size_t SHM_V = KVBLK * AD * 2, SHM_K = KVBLK * AD * 2, SHM_ATTN = 2 * SHM_V + 2 * SHM_K + 8 * 64 * 4;
#define KSWZ(row, colB) ((row) * 256 + ((colB) ^ (((row) & 7) << 4)))
#define SBAR() __builtin_amdgcn_sched_barrier(0)
__device__ __forceinline__ int crow(int r, int hi) { return (r & 3) + 8 * (r >> 2) + 4 * hi; }
__device__ __forceinline__ unsigned cvtpk(float lo, float hi) { return pk2(lo, hi); }
__device__ __forceinline__ void partialSM(f32x16& p0, f32x16& p1, float& m_reg, float& mn, float& alpha) {
  float pmax = p0[0]; for (int r = 1; r < 16; ++r) pmax = fmaxf(pmax, p0[r]); for (int r = 0; r < 16; ++r) pmax = fmaxf(pmax, p1[r]);
  { auto rr = __builtin_amdgcn_permlane32_swap(__float_as_uint(pmax), __float_as_uint(pmax), false, false);
    pmax = fmaxf(__uint_as_float(rr[0]), __uint_as_float(rr[1])); }
  if (__builtin_expect(__all(pmax - m_reg <= THR), 1)) { mn = m_reg; alpha = 1.f; }
  else { mn = fmaxf(m_reg, pmax); alpha = __builtin_amdgcn_exp2f((m_reg - mn) * C); m_reg = mn; }
  float mnC = -mn * C;
  for (int r = 0; r < 16; ++r) p0[r] = fmaf(p0[r], C, mnC); for (int r = 0; r < 16; ++r) p1[r] = fmaf(p1[r], C, mnC);
  for (int r = 0; r < 16; ++r) p0[r] = __builtin_amdgcn_exp2f(p0[r]);
}
__device__ __forceinline__ void finishSM(f32x16& p0, f32x16& p1, float alpha, float& l_reg, bf16x8& pa0, bf16x8& pa1, bf16x8& pa2, bf16x8& pa3) {
  for (int r = 0; r < 16; ++r) p1[r] = __builtin_amdgcn_exp2f(p1[r]);
  float ps = 0; for (int r = 0; r < 16; ++r) ps += p0[r]; for (int r = 0; r < 16; ++r) ps += p1[r];
  { auto rr = __builtin_amdgcn_permlane32_swap(__float_as_uint(ps), __float_as_uint(ps), false, false);
    ps = __uint_as_float(rr[0]) + __uint_as_float(rr[1]); }
  l_reg = l_reg * alpha + ps;
#define PK4(P, BASE, OUT) do { unsigned a0 = cvtpk(P[BASE + 0], P[BASE + 1]), a1 = cvtpk(P[BASE + 2], P[BASE + 3]);   \
    unsigned b0 = cvtpk(P[BASE + 4], P[BASE + 5]), b1 = cvtpk(P[BASE + 6], P[BASE + 7]);                              \
    auto r0 = __builtin_amdgcn_permlane32_swap(a0, b0, false, false); auto r1 = __builtin_amdgcn_permlane32_swap(a1, b1, false, false); \
    u32x4v w = {r0[0], r1[0], r0[1], r1[1]}; OUT = *reinterpret_cast<bf16x8*>(&w); } while (0)
  PK4(p0, 0, pa0); PK4(p0, 8, pa1); PK4(p1, 0, pa2); PK4(p1, 8, pa3);
#undef PK4
}
__device__ __forceinline__ void qkt(f32x16& p0, f32x16& p1, const bf16* Ks, const bf16x8* qr, int r32, int hi) {
  p0 = f32x16{}; p1 = f32x16{};
  for (int d0 = 0; d0 < 8; ++d0) { int cb = (d0 * 16 + hi * 8) * 2;
    bf16x8 b0 = *reinterpret_cast<const bf16x8*>((const char*)Ks + KSWZ(r32, cb));
    bf16x8 b1 = *reinterpret_cast<const bf16x8*>((const char*)Ks + KSWZ(32 + r32, cb));
    p0 = __builtin_amdgcn_mfma_f32_32x32x16_bf16(b0, qr[d0], p0, 0, 0, 0);
    p1 = __builtin_amdgcn_mfma_f32_32x32x16_bf16(b1, qr[d0], p1, 0, 0, 0); }
}
__device__ __forceinline__ void band_mask(f32x16& p0, f32x16& p1, int tq, int tk0, int hi) {
#pragma unroll
  for (int r = 0; r < 16; ++r) { const int d = tq - (tk0 + crow(r, hi)); if (d > 128 || d < -128) p0[r] = -1e30f; const int d1 = d - 32; if (d1 > 128 || d1 < -128) p1[r] = -1e30f; }
}
__device__ __forceinline__ int v_st(int k, int c) { const int kk = (k & ~0xC) | ((k & 4) << 1) | ((k & 8) >> 1); return ((kk >> 3) * 4 + (c >> 5)) * 512 + ((kk & 7) * 32 + (c & 31)) * 2; }
__device__ __forceinline__ int v_rd_base(int lane) { return ((lane & 3) << 3) | (((lane >> 2) & 3) << 6) | (((lane >> 4) & 1) << 5) | (((lane >> 5) & 1) << 8); }
constexpr int v_rd_off(int d0, int ks, int half) { return d0 * 512 + ks * 4096 + half * 2048; }
template <int OFF> __device__ __forceinline__ s16x4 tr_read(int vb) {
  s16x4 r; asm volatile("ds_read_b64_tr_b16 %0, %1 offset:%2" : "=&v"(r) : "v"(vb), "i"(OFF) : "memory"); return r;
}
template <int D0> __device__ __forceinline__ void pv_one(f32x16& od, int vb, bf16x8 pa0, bf16x8 pa1, bf16x8 pa2, bf16x8 pa3) {
  const s16x4 l0 = tr_read<v_rd_off(D0, 0, 0)>(vb), h0 = tr_read<v_rd_off(D0, 0, 1)>(vb), l1 = tr_read<v_rd_off(D0, 1, 0)>(vb), h1 = tr_read<v_rd_off(D0, 1, 1)>(vb);
  const s16x4 l2 = tr_read<v_rd_off(D0, 2, 0)>(vb), h2 = tr_read<v_rd_off(D0, 2, 1)>(vb), l3 = tr_read<v_rd_off(D0, 3, 0)>(vb), h3 = tr_read<v_rd_off(D0, 3, 1)>(vb);
  asm volatile("s_waitcnt lgkmcnt(0)" ::: "memory"); SBAR();
#define PK(L, H) (bf16x8){L[0], L[1], L[2], L[3], H[0], H[1], H[2], H[3]}
  od = __builtin_amdgcn_mfma_f32_32x32x16_bf16(pa0, PK(l0, h0), od, 0, 0, 0);
  od = __builtin_amdgcn_mfma_f32_32x32x16_bf16(pa1, PK(l1, h1), od, 0, 0, 0);
  od = __builtin_amdgcn_mfma_f32_32x32x16_bf16(pa2, PK(l2, h2), od, 0, 0, 0);
  od = __builtin_amdgcn_mfma_f32_32x32x16_bf16(pa3, PK(l3, h3), od, 0, 0, 0);
#undef PK
}
__device__ __forceinline__ void pv_d0(f32x16* o, int vb, bf16x8 pa0, bf16x8 pa1, bf16x8 pa2, bf16x8 pa3) {
  pv_one<0>(o[0], vb, pa0, pa1, pa2, pa3); pv_one<1>(o[1], vb, pa0, pa1, pa2, pa3); pv_one<2>(o[2], vb, pa0, pa1, pa2, pa3); pv_one<3>(o[3], vb, pa0, pa1, pa2, pa3);
}
template <bool WINDOW>
__device__ __forceinline__ void attn_body(int tid, const bf16* __restrict__ Qb, const bf16* __restrict__ Kh, const bf16* __restrict__ Vh, bf16* __restrict__ Ob, int NT, int kband, int tkb, int T0, float sink, char* lds) {
  const int wid = tid >> 6, lane = tid & 63, r32 = lane & 31, hi = lane >> 5;
  bf16* V_lds = (bf16*)lds; bf16* K_lds = (bf16*)(lds + 2 * SHM_V);
  float* ws = (float*)(lds + 2 * SHM_V + 2 * SHM_K) + wid * 64; float* li_l = ws; float* al_l = ws + 32;
  float m_reg = -1e30f, l_reg = 0; f32x16 o[4] = {}; bf16x8 qr[8];
  const bf16* Qw = Qb + (long)(wid * QBLK + r32) * LDQ + hi * 8;
#pragma unroll
  for (int d0 = 0; d0 < 8; ++d0) qr[d0] = *reinterpret_cast<const bf16x8*>(Qw + d0 * 16);
  const int sr = tid >> 4, sc = (tid & 15) * 8, vst0 = v_st(sr, sc), vst1 = v_st(32 + sr, sc);
  const int vb0 = (int)(uintptr_t)V_lds + v_rd_base(lane);
  const int tq = T0 + wid * QBLK + r32;
  struct { bf16x8 vs0, vs1, ks0, ks1; } sr_[SDEPTH];
#define KOFF(j) ((j) < 4 ? 64 * (j) : kband + 64 * ((j) - 4))
#define SLOAD(i, jt) do { const int k0_ = KOFF(jt); sr_[i].vs0 = *reinterpret_cast<const bf16x8*>(&Vh[(long)(k0_ + sr) * LDK + sc]); sr_[i].vs1 = *reinterpret_cast<const bf16x8*>(&Vh[(long)(k0_ + 32 + sr) * LDK + sc]); \
    sr_[i].ks0 = *reinterpret_cast<const bf16x8*>(&Kh[(long)(k0_ + sr) * LDK + sc]); sr_[i].ks1 = *reinterpret_cast<const bf16x8*>(&Kh[(long)(k0_ + 32 + sr) * LDK + sc]); } while (0)
#define SWRITE(b, i) do { *(bf16x8*)((char*)V_lds + (b) * SHM_V + vst0) = sr_[i].vs0;          \
    *(bf16x8*)((char*)V_lds + (b) * SHM_V + vst1) = sr_[i].vs1; int kc = sc * 2;               \
    *(bf16x8*)((char*)K_lds + (b) * SHM_K + KSWZ(sr, kc)) = sr_[i].ks0;                       \
    *(bf16x8*)((char*)K_lds + (b) * SHM_K + KSWZ(32 + sr, kc)) = sr_[i].ks1; } while (0)
#define SWAIT() do { if constexpr (SDEPTH == 2) asm volatile("s_waitcnt vmcnt(4)" ::: "memory"); else asm volatile("s_waitcnt vmcnt(0)" ::: "memory"); } while (0)
#define RESC(a) do { if (__any((a) < 1.f)) { if (hi == 0) al_l[r32] = (a); asm volatile("s_waitcnt lgkmcnt(0)" ::: "memory"); \
    for (int d = 0; d < 4; ++d) for (int r = 0; r < 16; ++r) o[d][r] *= al_l[crow(r, hi)]; } } while (0)
#define MASK(P0, P1, jt) do { if (WINDOW && (jt) >= 4) band_mask(P0, P1, tq, tkb + 64 * ((jt) - 4), hi); } while (0)
  f32x16 pA0, pA1, pB0, pB1; float mnA, mnB, alA, alB; bf16x8 pa0, pa1, pa2, pa3;
  constexpr int SE = 0, SO = SDEPTH - 1;
  SLOAD(SE, 0); asm volatile("s_waitcnt vmcnt(0)" ::: "memory"); SWRITE(0, SE); __syncthreads();
  qkt(pA0, pA1, K_lds, qr, r32, hi); partialSM(pA0, pA1, m_reg, mnA, alA);
  SLOAD(SO, 1); if constexpr (SDEPTH == 2) { if (2 < NT) SLOAD(SE, 2); }
  SWAIT(); SWRITE(1, SO); __syncthreads();
  for (int j = 1; j + 1 < NT; j += 2) {
    SBAR(); qkt(pB0, pB1, (bf16*)((char*)K_lds + SHM_K), qr, r32, hi); MASK(pB0, pB1, j);
    finishSM(pA0, pA1, alA, l_reg, pa0, pa1, pa2, pa3); SBAR();
    SLOAD(SO, j + SDEPTH); SBAR();
    pv_d0(o, vb0, pa0, pa1, pa2, pa3); partialSM(pB0, pB1, m_reg, mnB, alB);
    __syncthreads(); SWAIT(); SWRITE(0, SE);
    RESC(alB); __syncthreads();
    SBAR(); qkt(pA0, pA1, K_lds, qr, r32, hi); MASK(pA0, pA1, j + 1);
    finishSM(pB0, pB1, alB, l_reg, pa0, pa1, pa2, pa3); SBAR();
    if (SDEPTH == 1 || j + 3 < NT) SLOAD(SE, j + 1 + SDEPTH); SBAR();
    pv_d0(o, vb0 + (int)SHM_V, pa0, pa1, pa2, pa3); partialSM(pA0, pA1, m_reg, mnA, alA);
    __syncthreads(); SWAIT(); SWRITE(1, SO);
    RESC(alA); __syncthreads();
  }
  SBAR(); qkt(pB0, pB1, (bf16*)((char*)K_lds + SHM_K), qr, r32, hi); MASK(pB0, pB1, NT - 1);
  finishSM(pA0, pA1, alA, l_reg, pa0, pa1, pa2, pa3); SBAR();
  pv_d0(o, vb0, pa0, pa1, pa2, pa3); partialSM(pB0, pB1, m_reg, mnB, alB);
  __syncthreads(); RESC(alB);
  finishSM(pB0, pB1, alB, l_reg, pa0, pa1, pa2, pa3); SBAR();
  pv_d0(o, vb0 + (int)SHM_V, pa0, pa1, pa2, pa3);
  if (WINDOW) l_reg += __builtin_amdgcn_exp2f((sink - m_reg) * C);
  if (hi == 0) li_l[r32] = l_reg; asm volatile("s_waitcnt lgkmcnt(0)" ::: "memory");
  float rli[16];
#pragma unroll
  for (int r = 0; r < 16; ++r) rli[r] = __builtin_amdgcn_rcpf(li_l[crow(r, hi)]);
  bf16* Ow = Ob + (long)(wid * QBLK) * LDO;
#pragma unroll
  for (int r = 0; r < 16; ++r) { int orow = crow(r, hi);
    for (int d0 = 0; d0 < 4; ++d0) Ow[(long)orow * LDO + d0 * 32 + r32] = (bf16)f2bf(o[d0][r] * rli[r]); }
#undef KOFF
#undef SLOAD
#undef SWRITE
#undef SWAIT
#undef RESC
#undef MASK
}

constexpr int ML_QI = 0, ML_KI = 16384, ML_KV = 32768, ML_VV = 49152, ML_WV = 65536, ML_CI = 81920, ML_CIB = 24576, ML_SC = 132096;
__device__ __forceinline__ float shfl_up_l(float v, int d, int lane) { return __int_as_float(__builtin_amdgcn_ds_bpermute(((lane - d) & 63) << 2, __float_as_int(v))); }
__device__ __forceinline__ void mlstm_scalars(float ig, float fg, float& m_prev, float* sc, int lane) {
    const float logf = fminf(fg, 0.f) - log1pf(__expf(-fabsf(fg)));
    float bc = logf;
#pragma unroll
    for (int d = 1; d < 64; d <<= 1) { const float t = shfl_up_l(bc, d, lane); if (lane >= d) bc += t; }
    const float b_end = __int_as_float(__builtin_amdgcn_readlane(__float_as_int(bc), 63));
    const float beta = ig - bc; const float wl = b_end + beta;
    float mx = wl;
#pragma unroll
    for (int d = 1; d < 64; d <<= 1) { const float t = shfl_up_l(mx, d, lane); if (lane >= d) mx = fmaxf(mx, t); }
    const float mxall = __int_as_float(__builtin_amdgcn_readlane(__float_as_int(mx), 63));
    float pm = beta;
#pragma unroll
    for (int d = 1; d < 64; d <<= 1) { const float t = shfl_up_l(pm, d, lane); if (lane >= d) pm = fmaxf(pm, t); }
    const float m_new = fmaxf(b_end + m_prev, mxall);
    const float m_t = bc + fmaxf(pm, m_prev);
    sc[lane] = bc - m_t - 2.4260151319598084f;
    sc[64 + lane] = beta;
    sc[128 + lane] = 0.08838834764831845f * __expf(bc + m_prev - m_t);
    sc[192 + lane] = __expf(wl - m_new);
    sc[256 + lane] = __expf(-m_t);
    if (lane == 0) sc[320] = __expf(b_end + m_prev - m_new);
    m_prev = m_new;
}
__device__ __forceinline__ void ph_mlstm_body(int tid, const bf16* __restrict__ QKVO_, const float* __restrict__ gates, float* __restrict__ HD_, int b, int hh, int dr, int vq, char* lds) {
    const int wid = __builtin_amdgcn_readfirstlane(tid >> 6), lane = tid & 63;
    float* scal = (float*)(lds + ML_SC);
    for (int i = tid; i < 2 * ML_CIB / 16; i += 512) *(u32x4v*)(lds + ML_CI + i * 16) = (u32x4v){0u, 0u, 0u, 0u};
    float m_prev = 0.f;
    const int gcol = dr * 16 + hh;
    const size_t bq = (size_t)hh * MDQK, bk = (size_t)MQKW + hh * MDQK, bv = (size_t)2 * MQKW + hh * MDV + vq * 64;
#define ML_ROWBASE(c) (dr == 0 ? 64 * (c) : ((c) < 4 ? 255 - 64 * (c) : 2303 - 64 * ((c) - 4)))
    const int sg = dr == 0 ? 1 : -1;
    float ig_n = 0.f, fg_n = 0.f;
#define ML_GLOAD(c) do { const size_t r_ = (size_t)(b * TPB + ML_ROWBASE(c) + sg * lane); ig_n = gates[r_ * 32 + gcol]; fg_n = gates[r_ * 32 + gcol + 8]; } while (0)
    if (wid == 7) { ML_GLOAD(0); mlstm_scalars(ig_n, fg_n, m_prev, scal, lane); ML_GLOAD(1); }
    const int sr = tid >> 4, scq = (tid & 15) * 8, vr = tid >> 3, vc = (tid & 7) * 8;
    bf16x8 gq0, gq1, gk0, gk1, gv;
#define ML_LOAD(c) do { const int rb_ = b * TPB + ML_ROWBASE(c); const bf16* r0_ = QKVO_ + (size_t)(rb_ + sg * sr) * MINW; const bf16* r1_ = QKVO_ + (size_t)(rb_ + sg * (32 + sr)) * MINW; const bf16* rv_ = QKVO_ + (size_t)(rb_ + sg * vr) * MINW; \
    gq0 = *(const bf16x8*)(r0_ + bq + scq); gq1 = *(const bf16x8*)(r1_ + bq + scq); gk0 = *(const bf16x8*)(r0_ + bk + scq); gk1 = *(const bf16x8*)(r1_ + bk + scq); gv = *(const bf16x8*)(rv_ + bv + vc); } while (0)
    ML_LOAD(0);
    f32x16 acc0 = {}, acc1 = {}, acc2 = {};
    const int kt = wid - 4;
    const int vbK = (int)(uintptr_t)(lds + ML_KV) + v_rd_base(lane), vbV = (int)(uintptr_t)(lds + ML_VV) + v_rd_base(lane), vbW = (int)(uintptr_t)(lds + ML_WV) + v_rd_base(lane);
    __syncthreads();
    constexpr int NCH = TPB / 64;
#pragma unroll 1
    for (int c = 0; c < NCH; ++c) {
        int lane_c = lane; asm volatile("" : "+v"(lane_c));
        const int r32 = lane_c & 31, hi = lane_c >> 5;
        const float* sc = scal + (c & 1) * 384; float* scn = scal + ((c + 1) & 1) * 384;
        char* CIcur = lds + ML_CI + (c & 1) * ML_CIB; char* CInext = lds + ML_CI + ((c + 1) & 1) * ML_CIB;
        asm volatile("s_waitcnt vmcnt(0)" ::: "memory");
        *(bf16x8*)(lds + ML_QI + KSWZ(sr, scq * 2)) = gq0; *(bf16x8*)(lds + ML_QI + KSWZ(32 + sr, scq * 2)) = gq1;
        *(bf16x8*)(lds + ML_KI + KSWZ(sr, scq * 2)) = gk0; *(bf16x8*)(lds + ML_KI + KSWZ(32 + sr, scq * 2)) = gk1;
        *(bf16x8*)(lds + ML_KV + v_st(sr, scq)) = gk0; *(bf16x8*)(lds + ML_KV + v_st(32 + sr, scq)) = gk1;
        *(bf16x8*)(lds + ML_VV + v_st(vr, vc)) = gv;
        { const float w = sc[192 + vr]; u32x4v gw = *reinterpret_cast<u32x4v*>(&gv), o;
          o.x = cvtpk(w * bf2f(gw.x & 0xffffu), w * bf2f(gw.x >> 16)); o.y = cvtpk(w * bf2f(gw.y & 0xffffu), w * bf2f(gw.y >> 16)); o.z = cvtpk(w * bf2f(gw.z & 0xffffu), w * bf2f(gw.z >> 16)); o.w = cvtpk(w * bf2f(gw.w & 0xffffu), w * bf2f(gw.w >> 16));
          *(u32x4v*)(lds + ML_WV + v_st(vr, vc)) = o; }
        if (tid < 64) *(bf16*)(lds + ML_WV + v_st(tid, 64)) = (bf16)f2bf(sc[192 + tid]);
        __syncthreads();
        if (c + 1 < NCH) ML_LOAD(c + 1);
        f32x16 o_in = {}, o_x = {}; int tt = 0, vt = 0;
        if (wid < 4) {
            tt = wid >> 1; vt = wid & 1;
            bf16x8 qr[8];
#pragma unroll
            for (int d0 = 0; d0 < 8; ++d0) qr[d0] = *reinterpret_cast<const bf16x8*>(lds + ML_QI + KSWZ(32 * tt + r32, (d0 * 16 + hi * 8) * 2));
            f32x16 p0, p1; qkt(p0, p1, (const bf16*)(lds + ML_KI), qr, r32, hi);
            const int t = 32 * tt + r32; const float al = sc[t];
#pragma unroll
            for (int r = 0; r < 16; ++r) { const int s0 = crow(r, hi); const float e0 = __expf(al + sc[64 + s0]), e1 = __expf(al + sc[64 + 32 + s0]);
                p0[r] = s0 <= t ? p0[r] * e0 : 0.f; p1[r] = s0 + 32 <= t ? p1[r] * e1 : 0.f; }
            float ds = 0.f;
#pragma unroll
            for (int r = 0; r < 16; ++r) ds += p0[r] + p1[r];
            { auto rr = __builtin_amdgcn_permlane32_swap(__float_as_uint(ds), __float_as_uint(ds), false, false); ds = __uint_as_float(rr[0]) + __uint_as_float(rr[1]); }
            if (vt == 0 && hi == 0) scal[768 + t] = ds;
            bf16x8 pa0, pa1, pa2, pa3;
#define PK4(P, BASE, OUT) do { unsigned a0 = cvtpk(P[BASE + 0], P[BASE + 1]), a1 = cvtpk(P[BASE + 2], P[BASE + 3]);   \
    unsigned b0 = cvtpk(P[BASE + 4], P[BASE + 5]), b1 = cvtpk(P[BASE + 6], P[BASE + 7]);                              \
    auto r0 = __builtin_amdgcn_permlane32_swap(a0, b0, false, false); auto r1 = __builtin_amdgcn_permlane32_swap(a1, b1, false, false); \
    u32x4v w = {r0[0], r1[0], r0[1], r1[1]}; OUT = *reinterpret_cast<bf16x8*>(&w); } while (0)
            PK4(p0, 0, pa0); PK4(p0, 8, pa1); PK4(p1, 0, pa2); PK4(p1, 8, pa3);
#undef PK4
            if (vt == 0) pv_one<0>(o_in, vbV, pa0, pa1, pa2, pa3); else pv_one<1>(o_in, vbV, pa0, pa1, pa2, pa3);
#pragma unroll
            for (int d0 = 0; d0 < 8; ++d0) { const bf16x8 cf = *reinterpret_cast<const bf16x8*>(CIcur + KSWZ(32 * vt + r32, (d0 * 16 + hi * 8) * 2)); o_x = __builtin_amdgcn_mfma_f32_32x32x16_bf16(qr[d0], cf, o_x, 0, 0, 0); }
        } else {
            const float decay = sc[320];
#pragma unroll
            for (int r = 0; r < 16; ++r) { acc0[r] *= decay; acc1[r] *= decay; acc2[r] *= decay; }
#pragma unroll
            for (int ks = 0; ks < 4; ++ks) {
                s16x4 al_, ah_, b0l, b0h, b1l, b1h, b2l, b2h; const int ka = vbK + kt * 512 + ks * 4096, wa = vbW + ks * 4096;
                asm volatile("ds_read_b64_tr_b16 %0, %1" : "=&v"(al_) : "v"(ka) : "memory"); asm volatile("ds_read_b64_tr_b16 %0, %1 offset:2048" : "=&v"(ah_) : "v"(ka) : "memory");
                asm volatile("ds_read_b64_tr_b16 %0, %1" : "=&v"(b0l) : "v"(wa) : "memory"); asm volatile("ds_read_b64_tr_b16 %0, %1 offset:2048" : "=&v"(b0h) : "v"(wa) : "memory");
                asm volatile("ds_read_b64_tr_b16 %0, %1 offset:512" : "=&v"(b1l) : "v"(wa) : "memory"); asm volatile("ds_read_b64_tr_b16 %0, %1 offset:2560" : "=&v"(b1h) : "v"(wa) : "memory");
                asm volatile("ds_read_b64_tr_b16 %0, %1 offset:1024" : "=&v"(b2l) : "v"(wa) : "memory"); asm volatile("ds_read_b64_tr_b16 %0, %1 offset:3072" : "=&v"(b2h) : "v"(wa) : "memory");
                asm volatile("s_waitcnt lgkmcnt(0)" ::: "memory"); SBAR();
#define PK(L, H) (bf16x8){L[0], L[1], L[2], L[3], H[0], H[1], H[2], H[3]}
                const bf16x8 af = PK(al_, ah_);
                acc0 = __builtin_amdgcn_mfma_f32_32x32x16_bf16(af, PK(b0l, b0h), acc0, 0, 0, 0);
                acc1 = __builtin_amdgcn_mfma_f32_32x32x16_bf16(af, PK(b1l, b1h), acc1, 0, 0, 0);
                acc2 = __builtin_amdgcn_mfma_f32_32x32x16_bf16(af, PK(b2l, b2h), acc2, 0, 0, 0);
#undef PK
            }
#pragma unroll
            for (int q = 0; q < 4; ++q) { const int cb = (32 * kt + 8 * q + 4 * hi) * 2;
                u32x2 w0; w0.x = cvtpk(acc0[4 * q], acc0[4 * q + 1]); w0.y = cvtpk(acc0[4 * q + 2], acc0[4 * q + 3]); *(u32x2*)(CInext + KSWZ(r32, cb)) = w0;
                u32x2 w1; w1.x = cvtpk(acc1[4 * q], acc1[4 * q + 1]); w1.y = cvtpk(acc1[4 * q + 2], acc1[4 * q + 3]); *(u32x2*)(CInext + KSWZ(32 + r32, cb)) = w1;
                if (r32 == 0) { u32x2 w2; w2.x = cvtpk(acc2[4 * q], acc2[4 * q + 1]); w2.y = cvtpk(acc2[4 * q + 2], acc2[4 * q + 3]); *(u32x2*)(CInext + KSWZ(64, cb)) = w2; } }
            if (wid < 6) {
                const int t2 = wid - 4; f32x16 o_n = {};
#pragma unroll
                for (int d0 = 0; d0 < 8; ++d0) { const bf16x8 qf = *reinterpret_cast<const bf16x8*>(lds + ML_QI + KSWZ(32 * t2 + r32, (d0 * 16 + hi * 8) * 2));
                    const bf16x8 cf = *reinterpret_cast<const bf16x8*>(CIcur + KSWZ(64 + r32, (d0 * 16 + hi * 8) * 2)); o_n = __builtin_amdgcn_mfma_f32_32x32x16_bf16(qf, cf, o_n, 0, 0, 0); }
                if (r32 == 0) {
#pragma unroll
                    for (int r = 0; r < 16; ++r) scal[832 + 32 * t2 + crow(r, hi)] = o_n[r]; }
            }
            if (wid == 7 && c + 1 < NCH) { const float ig_c = ig_n, fg_c = fg_n; if (c + 2 < NCH) ML_GLOAD(c + 2); mlstm_scalars(ig_c, fg_c, m_prev, scn, lane); }
        }
        __syncthreads();
        if (wid < 4) {
            const int rb = b * TPB + ML_ROWBASE(c);
#pragma unroll
            for (int r = 0; r < 16; ++r) { const int t = 32 * tt + crow(r, hi); const float ai = sc[128 + t];
                const float dn = fmaxf(fabsf(scal[768 + t] + ai * scal[832 + t]), sc[256 + t]);
                HD_[(size_t)(rb + sg * t) * D + hh * MDV + vq * 64 + 32 * vt + r32] = (o_in[r] + ai * o_x[r]) / dn; }
        }
    }
#undef ML_LOAD
#undef ML_GLOAD
#undef ML_ROWBASE
    __syncthreads();
}

constexpr int S5_IMG = 8192;
__device__ __forceinline__ int s5_st(int k, int t) { const int k6 = k & 63; const int kk = (k6 & ~0xC) | ((k6 & 4) << 1) | ((k6 & 8) >> 1); return (k >> 6) * 4096 + (kk >> 3) * 512 + ((kk & 7) * 32 + t) * 2; }
__device__ __forceinline__ void s5_disc(const float* lre, const float* lim, float dt, int n, float& ar, float& ai, float& kr, float& ki) {
    const float lr = fminf(lre[n], -1e-4f), li = lim[n]; const float mag = expf(lr * dt); float sn, cs; sincosf(li * dt, &sn, &cs); ar = mag * cs; ai = mag * sn;
    const float den = lr * lr + li * li; kr = ((ar - 1.f) * lr + ai * li) / den; ki = (ai * lr - (ar - 1.f) * li) / den;
}
__device__ __forceinline__ void s5_task(int lane, const float* const* in, const bf16* __restrict__ Hb, float* __restrict__ out, int b, int g, int dr, char* img) {
    const int r32 = lane & 31, hi = lane >> 5; const size_t pg = (size_t)(dr * S5G + g);
    const float dt = expf(in[IN_S5LDT][pg]); const float* lre = in[IN_S5LRE] + pg * S5N; const float* lim = in[IN_S5LIM] + pg * S5N;
    float ar, ai, kr_o, ki_o, ar2, ai2, kr_p, ki_p;
    s5_disc(lre, lim, dt, lane, ar, ai, kr_o, ki_o);
    float kr0, ki0, kr1, ki1;
    s5_disc(lre, lim, dt, r32, ar2, ai2, kr0, ki0); s5_disc(lre, lim, dt, 32 + r32, ar2, ai2, kr1, ki1); (void)kr_o; (void)ki_o; (void)kr_p; (void)ki_p;
    bf16x8 Bf[4];
#pragma unroll
    for (int q = 0; q < 4; ++q) { const int n = (q & 1) * 32 + r32; const float kr = (q & 1) ? kr1 : kr0, ki = (q & 1) ? ki1 : ki0;
        const float* bre = in[IN_S5BRE] + (pg * S5N + n) * 16 + 8 * hi; const float* bim = in[IN_S5BIM] + (pg * S5N + n) * 16 + 8 * hi; u32x4v w;
        float v[8];
#pragma unroll
        for (int j = 0; j < 8; ++j) v[j] = (q < 2) ? (kr * bre[j] - ki * bim[j]) : (kr * bim[j] + ki * bre[j]);
        w.x = cvtpk(v[0], v[1]); w.y = cvtpk(v[2], v[3]); w.z = cvtpk(v[4], v[5]); w.w = cvtpk(v[6], v[7]); Bf[q] = *reinterpret_cast<bf16x8*>(&w); }
    bf16x8 Cf[8];
#pragma unroll
    for (int kb = 0; kb < 8; ++kb) { u32x4v w = {0u, 0u, 0u, 0u};
        if (r32 < 16) { const int k0 = 16 * kb + 8 * hi; const float* cp = (k0 < 64 ? in[IN_S5CRE] : in[IN_S5CIM]) + (pg * 16 + r32) * S5N + (k0 & 63); const float sgn = k0 < 64 ? 1.f : -1.f;
            w.x = cvtpk(sgn * cp[0], sgn * cp[1]); w.y = cvtpk(sgn * cp[2], sgn * cp[3]); w.z = cvtpk(sgn * cp[4], sgn * cp[5]); w.w = cvtpk(sgn * cp[6], sgn * cp[7]); }
        Cf[kb] = *reinterpret_cast<bf16x8*>(&w); }
    float xr = 0.f, xi = 0.f;
    const int vb = (int)(uintptr_t)img + v_rd_base(lane);
#define S5_ROW(s) (dr == 0 ? (s) : ((s) < CTXL ? CTXL - 1 - (s) : TPB - 1 - ((s) - CTXL)))
    bf16x8 uf = *reinterpret_cast<const bf16x8*>(Hb + ((size_t)b * TPB + S5_ROW(r32)) * D + 16 * g + 8 * hi);
#pragma unroll 1
    for (int blk = 0; blk < TPB / 32; ++blk) {
        const bf16x8 ucur = uf;
        if (blk + 1 < TPB / 32) uf = *reinterpret_cast<const bf16x8*>(Hb + ((size_t)b * TPB + S5_ROW(32 * (blk + 1) + r32)) * D + 16 * g + 8 * hi);
        f32x16 d0 = {}, d1 = {}, d2 = {}, d3 = {};
        d0 = __builtin_amdgcn_mfma_f32_32x32x16_bf16(ucur, Bf[0], d0, 0, 0, 0); d1 = __builtin_amdgcn_mfma_f32_32x32x16_bf16(ucur, Bf[1], d1, 0, 0, 0);
        d2 = __builtin_amdgcn_mfma_f32_32x32x16_bf16(ucur, Bf[2], d2, 0, 0, 0); d3 = __builtin_amdgcn_mfma_f32_32x32x16_bf16(ucur, Bf[3], d3, 0, 0, 0);
#pragma unroll
        for (int r = 0; r < 16; ++r) { auto s0 = __builtin_amdgcn_permlane32_swap(__float_as_uint(d0[r]), __float_as_uint(d1[r]), false, false); d0[r] = __uint_as_float(s0[0]); d1[r] = __uint_as_float(s0[1]);
            auto s1 = __builtin_amdgcn_permlane32_swap(__float_as_uint(d2[r]), __float_as_uint(d3[r]), false, false); d2[r] = __uint_as_float(s1[0]); d3[r] = __uint_as_float(s1[1]); }
        unsigned pre[16], pim[16]; float lr_ = 0.f, li_ = 0.f;
#pragma unroll
        for (int t = 0; t < 32; ++t) { const int odd = (t >> 2) & 1, tt = odd ? t - 4 : t, r = (tt & 3) + 4 * (tt >> 3);
            const float br = odd ? d1[r] : d0[r], bi = odd ? d3[r] : d2[r];
            const float nr = fmaf(ar, xr, fmaf(-ai, xi, br)), ni = fmaf(ar, xi, fmaf(ai, xr, bi)); xr = nr; xi = ni;
            if (t & 1) { pre[t >> 1] = cvtpk(lr_, xr); pim[t >> 1] = cvtpk(li_, xi); } else { lr_ = xr; li_ = xi; } }
#pragma unroll
        for (int j = 0; j < 4; ++j) { *(u32x4v*)(img + s5_st(lane, 8 * j)) = (u32x4v){pre[4 * j], pre[4 * j + 1], pre[4 * j + 2], pre[4 * j + 3]};
            *(u32x4v*)(img + s5_st(64 + lane, 8 * j)) = (u32x4v){pim[4 * j], pim[4 * j + 1], pim[4 * j + 2], pim[4 * j + 3]}; }
        asm volatile("s_waitcnt lgkmcnt(0)" ::: "memory");
        f32x16 y = {};
#define S5_TR(KB, L, H) const s16x4 L = tr_read<((KB) >> 2) * 4096 + ((KB) & 3) * 1024>(vb), H = tr_read<((KB) >> 2) * 4096 + ((KB) & 3) * 1024 + 512>(vb)
        S5_TR(0, l0, h0); S5_TR(1, l1, h1); S5_TR(2, l2, h2); S5_TR(3, l3, h3); S5_TR(4, l4, h4); S5_TR(5, l5, h5); S5_TR(6, l6, h6); S5_TR(7, l7, h7);
        asm volatile("s_waitcnt lgkmcnt(0)" ::: "memory"); SBAR();
#define S5_MM(KB, L, H) y = __builtin_amdgcn_mfma_f32_32x32x16_bf16((bf16x8){L[0], L[1], L[2], L[3], H[0], H[1], H[2], H[3]}, Cf[KB], y, 0, 0, 0)
        S5_MM(0, l0, h0); S5_MM(1, l1, h1); S5_MM(2, l2, h2); S5_MM(3, l3, h3); S5_MM(4, l4, h4); S5_MM(5, l5, h5); S5_MM(6, l6, h6); S5_MM(7, l7, h7);
#undef S5_TR
#undef S5_MM
        if (r32 < 16) {
#pragma unroll
            for (int r = 0; r < 16; ++r) out[((size_t)b * TPB + S5_ROW(32 * blk + crow(r, hi))) * D + 16 * g + r32] = y[r]; }
    }
#undef S5_ROW
}
#undef KSWZ
#undef SBAR
}

template <bool WINDOW>
__device__ __forceinline__ void ph_attn_fast(const Frame& F0, const float* sinkp) {
    const Frame F = launder(F0);
    const int bx = blockIdx.x; const int vcu = (F.G % 8 == 0) ? (bx % 8) * (F.G / 8) + bx / 8 : bx;
    const int nlat = NB * NH * 8, nslots = nlat / 2 + (WINDOW ? 0 : NB * NH);
    for (int slot = vcu; slot < nslots; slot += F.G) {
#pragma unroll 1
        for (int k = 0; k < 2; ++k) {
            int u = slot < nlat / 2 ? 2 * slot + k : nlat + (slot - nlat / 2);
            if (slot >= nlat / 2 && k == 1) continue;
            int b, h, qb;
            if (u < nlat) { const int grp = u / 32, w = u % 32; b = grp / NKV; h = (grp % NKV) * 4 + w / 8; qb = 1 + w % 8; } else { const int c = u - nlat; b = c / NH; h = c % NH; qb = 0; }
            const int kv = h / 4; const size_t row0 = (size_t)b * TPB + qb * 256;
            const bf16* Qb = F.Q() + row0 * QW + h * HD; const bf16* Kh = F.K() + (size_t)b * TPB * KVW + kv * HD; const bf16* Vh = F.V() + (size_t)b * TPB * KVW + kv * HD; bf16* Ob = F.O() + row0 * QW + h * HD;
            int NT, kband = CTXL, tkb = 0, T0 = 0; float sk = 0.f;
            if (WINDOW) { T0 = (qb - 1) * 256; const int ks = T0 - 128 < 0 ? 0 : T0 - 128, ke = T0 + 384 > SEQ ? SEQ : T0 + 384; NT = 4 + (ke - ks) / 64; kband = CTXL + ks; tkb = ks; sk = sinkp[h]; }
            else NT = qb == 0 ? 4 : TPB / 64;
            att::attn_body<WINDOW>(F.tid, Qb, Kh, Vh, Ob, NT, kband, tkb, T0, sk, (char*)(unsigned char*)F.lds);
            __syncthreads();
        }
    }
}

__device__ __forceinline__ void ph_s5_naive(const Frame& F0) {
    const Frame F = launder(F0);
    const int n = F.lane;
    for (int it = F.gw; it < NB * S5G * 2; it += F.NGW) {
        const int dr = it & 1, g = (it >> 1) % S5G, b = it / (2 * S5G);
        const size_t pg = (size_t)(dr * S5G + g);
        const float lr = fminf(F.in[IN_S5LRE][pg * S5N + n], -1e-4f), li = F.in[IN_S5LIM][pg * S5N + n], dt = expf(F.in[IN_S5LDT][pg]);
        const float mag = expf(lr * dt); float sn, cs; sincosf(li * dt, &sn, &cs); const float ar = mag * cs, ai = mag * sn;
        const float den = lr * lr + li * li; const float kr = ((ar - 1.f) * lr + ai * li) / den, ki = (ai * lr - (ar - 1.f) * li) / den;
        float bre[16], bim[16], cre[16], cim[16];
#pragma unroll
        for (int c = 0; c < 16; ++c) { const float br_ = F.in[IN_S5BRE][(pg * S5N + n) * 16 + c], bi_ = F.in[IN_S5BIM][(pg * S5N + n) * 16 + c];
            bre[c] = kr * br_ - ki * bi_; bim[c] = kr * bi_ + ki * br_;
            cre[c] = F.in[IN_S5CRE][(pg * 16 + c) * S5N + n]; cim[c] = F.in[IN_S5CIM][(pg * 16 + c) * S5N + n]; }
        float xr = 0.f, xi = 0.f;
        float* out = F.HDb() + (size_t)dr * NR * D;
        for (int s = 0; s < TPB; ++s) {
            int p; if (dr == 0) p = s; else p = s < CTXL ? CTXL - 1 - s : TPB - 1 - (s - CTXL);
            const size_t r = (size_t)b * TPB + p;
            const u32x4 u0 = *(const u32x4*)(F.H() + r * D + 16 * g), u1 = *(const u32x4*)(F.H() + r * D + 16 * g + 8);
            float u[16]; u[0] = bf2f(u0.x & 0xffffu); u[1] = bf2f(u0.x >> 16); u[2] = bf2f(u0.y & 0xffffu); u[3] = bf2f(u0.y >> 16); u[4] = bf2f(u0.z & 0xffffu); u[5] = bf2f(u0.z >> 16); u[6] = bf2f(u0.w & 0xffffu); u[7] = bf2f(u0.w >> 16);
            u[8] = bf2f(u1.x & 0xffffu); u[9] = bf2f(u1.x >> 16); u[10] = bf2f(u1.y & 0xffffu); u[11] = bf2f(u1.y >> 16); u[12] = bf2f(u1.z & 0xffffu); u[13] = bf2f(u1.z >> 16); u[14] = bf2f(u1.w & 0xffffu); u[15] = bf2f(u1.w >> 16);
            float br = 0.f, bi = 0.f;
#pragma unroll
            for (int c = 0; c < 16; ++c) { br += bre[c] * u[c]; bi += bim[c] * u[c]; }
            const float nr = ar * xr - ai * xi + br, ni = ar * xi + ai * xr + bi; xr = nr; xi = ni;
            float mine = 0.f;
#pragma unroll
            for (int c = 0; c < 16; ++c) { const float y = wave_sum(xr * cre[c] - xi * cim[c]); if (n == c) mine = y; }
            if (n < 16) out[r * D + 16 * g + n] = mine;
        }
    }
}
__device__ __forceinline__ void ph_s5_fast(const Frame& F0) {
    const Frame F = launder(F0);
    if (F.wave < 4) {
        for (int task = blockIdx.x * 4 + F.wave; task < NB * 2 * S5G; task += F.G * 4) {
            const int g = task % S5G, dr = (task / S5G) & 1, b = task / (2 * S5G);
            att::s5_task(F.lane, F.in, F.H(), F.HDb() + (size_t)dr * NR * D, b, g, dr, (char*)(unsigned char*)F.lds + F.wave * att::S5_IMG);
        }
    }
}
__device__ __forceinline__ void ph_s5_combine(const Frame& F0) {
    const Frame F = launder(F0);
    const size_t n4 = (size_t)NR * D / 4, stride = (size_t)F.G * NTHREADS; const f32x4* yf = (const f32x4*)F.HDb(); const f32x4* yb = (const f32x4*)(F.HDb() + (size_t)NR * D);
    for (size_t i0 = (size_t)blockIdx.x * NTHREADS + F.tid; i0 < n4; i0 += 4 * stride) {
        f32x4 dsk[4], f[4], bb[4]; u32x2 hw[4];
#pragma unroll
        for (int k = 0; k < 4; ++k) { const size_t i = i0 + k * stride; dsk[k] = ((const f32x4*)F.in[IN_S5D])[(int)(i % (D / 4))]; hw[k] = ((const u32x2*)F.H())[i]; f[k] = yf[i]; bb[k] = yb[i]; }
#pragma unroll
        for (int k = 0; k < 4; ++k) { const size_t i = i0 + k * stride; f32x4 h; h.x = bf2f(hw[k].x & 0xffffu); h.y = bf2f(hw[k].x >> 16); h.z = bf2f(hw[k].y & 0xffffu); h.w = bf2f(hw[k].y >> 16);
            const f32x4 y = dsk[k] * h + f[k] + bb[k];
            u32x2 w; w.x = pk2(gelu_tanh_f(y.x), gelu_tanh_f(y.y)); w.y = pk2(gelu_tanh_f(y.z), gelu_tanh_f(y.w)); ((u32x2*)F.O())[i] = w; }
    }
}
__device__ __forceinline__ void ph_mlstm_naive(const Frame& F0) {
    const Frame F = launder(F0);
    LAS float* sk = (LAS float*)F.lds; LAS float* sq = sk + 128; LAS float* sn = sq + 128; LAS float* spart = sn + 128; LAS float* snq = spart + 512;
    const int tid = F.tid, v = tid & 255, kh = tid >> 8;
    for (int it = blockIdx.x; it < NB * MH * 2; it += F.G) {
        const int dr = it & 1, hh = (it >> 1) % MH, b = it / (2 * MH);
        float C[64];
#pragma unroll
        for (int i = 0; i < 64; ++i) C[i] = 0.f;
        if (tid < 128) sn[tid] = 0.f;
        float m = 0.f;
        float* out = F.HDb() + (size_t)dr * NR * D;
        __syncthreads();
        for (int s = 0; s < TPB; ++s) {
            int p; if (dr == 0) p = s; else p = s < CTXL ? CTXL - 1 - s : TPB - 1 - (s - CTXL);
            const size_t r = (size_t)b * TPB + p; const bf16* row = F.QKVO() + r * MINW;
            const float ig = F.GATES()[r * 32 + dr * 16 + hh], fg = F.GATES()[r * 32 + dr * 16 + 8 + hh];
            const float logf = fminf(fg, 0.f) - log1pf(expf(-fabsf(fg)));
            const float mn = fmaxf(logf + m, ig); const float fp = expf(logf + m - mn), ip = expf(ig - mn); m = mn;
            const float vv = bf2f(row[2 * MQKW + hh * MDV + v]);
            if (tid < 128) { const float kk = bf2f(row[MQKW + hh * MDQK + tid]) * 0.08838834764831845f, qq = bf2f(row[hh * MDQK + tid]); sk[tid] = kk; sq[tid] = qq;
                const float nn = fp * sn[tid] + ip * kk; sn[tid] = nn; const float pq = wave_sum(nn * qq); if (F.lane == 0) snq[tid >> 6] = pq; }
            __syncthreads();
            float part = 0.f; const float iv = ip * vv;
#pragma unroll
            for (int i = 0; i < 64; ++i) { C[i] = fp * C[i] + iv * sk[kh * 64 + i]; part += C[i] * sq[kh * 64 + i]; }
            spart[kh * 256 + v] = part;
            __syncthreads();
            if (tid < 256) { const float num = spart[v] + spart[256 + v]; const float nq = snq[0] + snq[1]; const float dn = fmaxf(fabsf(nq), expf(-m)); out[r * D + hh * MDV + v] = num / dn; }
            __syncthreads();
        }
    }
}
__device__ __forceinline__ void ph_mlstm_fast(const Frame& F0) {
    const Frame F = launder(F0);
    for (int u = blockIdx.x; u < NB * MH * 2 * 4; u += F.G) {
        const int vq = u & 3, dr = (u >> 2) & 1, hh = (u >> 3) % MH, b = u / (8 * MH);
        att::ph_mlstm_body(F.tid, F.QKVO(), F.GATES(), F.HDb() + (size_t)dr * NR * D, b, hh, dr, vq, (char*)(unsigned char*)F.lds);
    }
}
__device__ __forceinline__ void ph_mlstm_readout(const Frame& F0) {
    const Frame F = launder(F0);
    const int lane = F.lane; const float* h0 = F.HDb(); const float* h1 = F.HDb() + (size_t)NR * D; const float* ng = F.in[IN_MNORMG];
    for (int r = F.gw; r < NR; r += F.NGW) {
        f32x4 a[MH], g[MH]; u32x2 ow[MH];
#pragma unroll
        for (int hh = 0; hh < MH; ++hh) { const size_t off = (size_t)r * D + hh * MDV + 4 * lane; a[hh] = *(const f32x4*)(h0 + off) + *(const f32x4*)(h1 + off); g[hh] = *(const f32x4*)(ng + hh * MDV + 4 * lane);
            ow[hh] = *(const u32x2*)(F.QKVO() + (size_t)r * MINW + 2 * MQKW + MVW + hh * MDV + 4 * lane); }
#pragma unroll
        for (int hh = 0; hh < MH; ++hh) {
            const float ss = wave_sum((a[hh].x * a[hh].x + a[hh].y * a[hh].y) + (a[hh].z * a[hh].z + a[hh].w * a[hh].w)); const float rstd = 1.0f / sqrtf(ss * (1.0f / MDV) + NORM_EPS);
            f32x4 y = a[hh] * rstd * g[hh]; y.x *= sigmoid_f(bf2f(ow[hh].x & 0xffffu)); y.y *= sigmoid_f(bf2f(ow[hh].x >> 16)); y.z *= sigmoid_f(bf2f(ow[hh].y & 0xffffu)); y.w *= sigmoid_f(bf2f(ow[hh].y >> 16));
            u32x2 w; w.x = pk2(y.x, y.y); w.y = pk2(y.z, y.w); *(u32x2*)(F.O() + (size_t)r * D + hh * MDV + 4 * lane) = w; }
    }
}

__global__ void __launch_bounds__(NTHREADS, 2) fwd(Args args) {
    extern __shared__ __attribute__((aligned(16))) unsigned char lds_raw[];
    Frame F; F.lds = (LAS unsigned char*)lds_raw; F.tid = threadIdx.x; F.lane = F.tid & 63; F.wave = __builtin_amdgcn_readfirstlane(F.tid >> 6); F.G = gridDim.x;
    F.gw = blockIdx.x * NWAVES + F.wave; F.NGW = F.G * NWAVES; F.in = args.in; F.out = args.out; F.ws = args.ws;
    unsigned char* ws = args.ws;
    volatile LAS unsigned* MISC = (volatile LAS unsigned*)(F.lds + MISC_OFF);
    if (F.tid < 32) MISC[F.tid] = 0u;
    __syncthreads();
    XcdBarrier bar; bar.bar = (unsigned*)(ws + WS_CTL) + CW_BAR; bar.x = 0; bar.st = nullptr;
#if !MK_PER_PHASE
    bar = xcd_barrier_post((unsigned*)(ws + WS_CTL) + CW_BAR, MISC + 8);
#endif
    const int lo = args.ph_lo, hi = args.ph_hi; int ph = 0;
#define RUN() (lo <= ph && ph < hi)
#if MK_PER_PHASE
#define SEAM() do { ++ph; } while (0)
#else
#define SEAM() do { if (lo <= ph && ph + 1 < hi) xcd_barrier(bar.bar, bar.x, bar.st); ++ph; } while (0)
#endif
#if FAST_GEMM
#define GEMM(DUAL, A, lda, Wf, ldw, Bt, M, N, Nbt, K, doff, E) gemm_fast<DUAL>(F, A, Bt, (M) / 256, 0, Nbt, K, E)
    if (RUN()) { ph_mod(F); ph_cvt_weights(F); } SEAM();
#else
#define GEMM(DUAL, A, lda, Wf, ldw, Bt, M, N, Nbt, K, doff, E) gemm_naive<DUAL>(F, A, lda, Wf, ldw, M, N, K, doff, E)
    if (RUN()) { ph_init(F); ph_mod(F); } SEAM();
#endif
#pragma unroll 1
    for (int L = 0; L < DEPTH; ++L) {
#pragma unroll 1
        for (int half = 0; half < 2; ++half) {
            if (half == 1) {
                const float* pg1 = F.MOD() + ((size_t)(L * 5 + 4) * NMOD + 2) * D;
                if (RUN()) ph_norm<false>(F, L, 1, pg1, 0.5f);
                SEAM();
                const float* g5 = F.MOD() + ((size_t)(L * 5) * NMOD + 5) * D;
                if (L == 0 || L == 3) {
                    const float* wqkv = F.in[L == 0 ? IN_AWQKV : IN_WWQKV]; const float* qkg = F.in[L == 0 ? IN_AQKG : IN_WQKG]; const float* wo = F.in[L == 0 ? IN_AWO : IN_WWO];
                    const bf16* wqkv_t = F.WT() + (L == 0 ? WT_AWQKV : WT_WWQKV); const bf16* wo_t = F.WT() + (L == 0 ? WT_AWO : WT_WWO);
                    if (RUN()) { EpiQKV E{F.Q(), F.K(), F.V()}; GEMM(false, F.H(), D, wqkv, QKVW, wqkv_t, NR, QKVW, QKVW, D, 0, E); } SEAM();
                    if (RUN()) ph_qknorm_rope(F, qkg); SEAM();
#if FAST_ATTN
                    if (L == 0) { if (RUN()) { ph_attn_fast<false>(F, nullptr); if (PROBE_DUP == 3) { __syncthreads(); ph_attn_fast<false>(F, nullptr); } } } else { if (RUN()) { ph_attn_fast<true>(F, F.in[IN_WSINK]); if (PROBE_DUP == 3) { __syncthreads(); ph_attn_fast<true>(F, F.in[IN_WSINK]); } } }
#else
                    if (L == 0) { if (RUN()) ph_attn_naive<false>(F, nullptr); } else { if (RUN()) ph_attn_naive<true>(F, F.in[IN_WSINK]); }
#endif
                    SEAM();
                    if (RUN()) { EpiRmw<0> E{F.X(), g5, nullptr}; gemm_down(F, F.O(), wo_t, D, L == 3 ? 0 : 1, E); } SEAM();
                } else if (L == 1) {
#if FAST_S5
                    if (RUN()) { ph_s5_fast(F); if (PROBE_DUP == 4) { __syncthreads(); ph_s5_fast(F); } } SEAM();
#else
                    if (RUN()) ph_s5_naive(F); SEAM();
#endif
                    if (RUN()) ph_s5_combine(F); SEAM();
                    if (RUN()) { EpiRmw<3> E{F.X(), g5, nullptr}; GEMM(true, F.O(), D, F.in[IN_S5WGLU], 2 * D, F.WT() + WT_GLU, NR, D, 2 * D, D, D, E); } SEAM();
                } else {
                    if (RUN()) { EpiMlstmIn E{F.QKVO(), F.GATES(), F.in[IN_MBGATE]}; gemm_fast<false>(F, F.H(), F.WT() + WT_MWIN, 36, 0, MINW + 256, D, E); } SEAM();
#if FAST_MLSTM
                    if (RUN()) { ph_mlstm_fast(F); if (PROBE_DUP == 4) { __syncthreads(); ph_mlstm_fast(F); } } SEAM();
#else
                    if (RUN()) ph_mlstm_naive(F); SEAM();
#endif
                    if (RUN()) ph_mlstm_readout(F); SEAM();
                    if (RUN()) { EpiRmw<0> E{F.X(), g5, nullptr}; gemm_down(F, F.O(), F.WT() + WT_MWOUT, D, 1, E); } SEAM();
                }
            }
            const int j = half * 2;
            const float* pg0 = (half == 0 && L > 0) ? F.MOD() + ((size_t)((L - 1) * 5 + 4) * NMOD + 8) * D : nullptr;
            if (half == 1 && (L == 0 || L == 2)) pg0 = F.MOD() + ((size_t)(L * 5 + 4) * NMOD + 5) * D;
            if (RUN()) ph_norm<false>(F, L, j, pg0, half == 1 ? 1.0f : 0.5f, L == 0 && half == 0); SEAM();
            const float* wi = F.in[IN_FFNWI] + (size_t)(L * 2 + half) * D * 2 * DFF; const float* wo = F.in[IN_FFNWO] + (size_t)(L * 2 + half) * DFF * D;
            const bf16* wi_t = F.WT() + WT_FFNWI + (size_t)(L * 2 + half) * D * 2 * DFF; const bf16* wo_t = F.WT() + WT_FFNWO + (size_t)(L * 2 + half) * DFF * D;
            const int lastff = (L == DEPTH - 1 && half == 1);
            if (RUN()) { EpiSwiglu E{F.HID()}; gemm_fast<true>(F, F.H(), wi_t, lastff ? 32 : 36, lastff, 2 * DFF, D, E); } SEAM();
            const float* gg = F.MOD() + ((size_t)(L * 5) * NMOD + 3 * j + 2) * D;
            if (lastff) { if (RUN()) { EpiRmw<2> E{F.X(), gg, F.out}; gemm_down(F, F.HID(), wo_t, DFF, 0, E); } }
            else { if (RUN()) { EpiRmw<1> E{F.X(), gg, nullptr}; gemm_down(F, F.HID(), wo_t, DFF, 1, E); } }
            SEAM();
        }
    }
#undef RUN
#undef SEAM
}

constexpr int N_PHASES = 1 + 4 * 6 + (1 + 4) * 2 + (1 + 3) + (1 + 4);

extern "C" void kernel_launch(void* const* d_in, const int* in_sizes, int n_in, void* d_out, int out_size, void* d_ws, size_t ws_size, hipStream_t stream) {
    static int grid = 0;
    if (grid == 0) {
        if (n_in != 30 || out_size != NB * SEQ * D || ws_size < WS_END) { fprintf(stderr, "kernel_launch: unexpected shapes n_in %d out %d ws %zu\n", n_in, out_size, ws_size); grid = -1; return; }
        int dev = 0, cus = 0;
        if (hipGetDevice(&dev) != hipSuccess || hipDeviceGetAttribute(&cus, hipDeviceAttributeMultiprocessorCount, dev) != hipSuccess) { grid = -1; return; }
        if (hipFuncSetAttribute((const void*)fwd, hipFuncAttributeMaxDynamicSharedMemorySize, LDS_BYTES) != hipSuccess) { fprintf(stderr, "kernel_launch: hipFuncSetAttribute failed\n"); grid = -1; return; }
        int per_cu = 0; (void)hipOccupancyMaxActiveBlocksPerMultiprocessor(&per_cu, (const void*)fwd, NTHREADS, LDS_BYTES); (void)hipGetLastError();
        grid = cus;
    }
    if (grid < 0) return;
    (void)hipMemsetAsync((char*)d_ws + WS_CTL, 0, CTL_BYTES, stream);
    Args a{};
    for (int i = 0; i < 30; ++i) a.in[i] = (const float*)d_in[i];
    a.out = (float*)d_out; a.ws = (unsigned char*)d_ws;
#if MK_PER_PHASE
    for (int p = 0; p < N_PHASES; ++p) { a.ph_lo = p; a.ph_hi = p + 1; hipLaunchKernelGGL(fwd, dim3(grid), dim3(NTHREADS), LDS_BYTES, stream, a); }
#else
    a.ph_lo = 0; a.ph_hi = N_PHASES; hipLaunchKernelGGL(fwd, dim3(grid), dim3(NTHREADS), LDS_BYTES, stream, a);
#endif
    const hipError_t le = hipPeekAtLastError();
    if (le != hipSuccess) fprintf(stderr, "kernel_launch: launch failed: %s\n", hipGetErrorName(le));
}
```

```cpp
#include <hip/hip_runtime.h>
#include <cstdio>
#include <cstdint>

#ifndef MK_PER_PHASE
#define MK_PER_PHASE 0
#endif

#ifndef FAST_MLSTM
#define FAST_MLSTM 1
#endif
#ifndef CTX_SPLIT
#define CTX_SPLIT 1
#endif
#ifndef PROBE_DUP
#define PROBE_DUP 0
#endif
#ifndef FAST_S5
#define FAST_S5 1
#endif
#ifndef FAST_ATTN
#define FAST_ATTN 1
#endif
#ifndef FAST_GEMM
#define FAST_GEMM 1
#endif

#define GAS __attribute__((address_space(1)))
#define LAS __attribute__((address_space(3)))
typedef unsigned short bf16;
typedef float f32x4 __attribute__((ext_vector_type(4)));
typedef float f32x2 __attribute__((ext_vector_type(2)));
typedef unsigned u32x4 __attribute__((ext_vector_type(4)));
typedef unsigned u32x2 __attribute__((ext_vector_type(2)));

constexpr int D = 2048, NB = 4, SEQ = 2048, CTXL = 256, TPB = SEQ + CTXL, NR = NB * TPB;
constexpr int DFF = 5632, NMOD = 9, DEPTH = 4, GRID_W = 64;
constexpr int NH = 16, NKV = 4, HD = 128, QW = 2048, KVW = 512, QKVW = 3072;
constexpr int S5G = 128, S5GS = 16, S5N = 64;
constexpr int MH = 8, MDQK = 128, MDV = 256, MQKW = 1024, MVW = 2048, MINW = 6144;
constexpr float NORM_EPS = 1e-6f, GATE_CAP = 15.0f;
constexpr int NWAVES = 8, NTHREADS = 512;

constexpr size_t MiB = 1u << 20;
constexpr size_t WS_CTL = 0, CTL_BYTES = 1 * MiB;
constexpr size_t WS_MOD = 1 * MiB;
constexpr size_t WS_X = 4 * MiB;
constexpr size_t WS_H = 76 * MiB;
constexpr size_t WS_HID = 112 * MiB;
constexpr size_t WS_Q = 212 * MiB;
constexpr size_t WS_K = 248 * MiB;
constexpr size_t WS_V = 257 * MiB;
constexpr size_t WS_O = 266 * MiB;
constexpr size_t WS_QKVO = 302 * MiB;
constexpr size_t WS_GATES = 410 * MiB;
constexpr size_t WS_HD = 412 * MiB;
constexpr size_t WS_WT = 556 * MiB;
constexpr size_t WT_FFNWI = 0, WT_FFNWO = WT_FFNWI + (size_t)8 * D * 2 * DFF, WT_AWQKV = WT_FFNWO + (size_t)8 * DFF * D, WT_AWO = WT_AWQKV + (size_t)D * QKVW, WT_GLU = WT_AWO + (size_t)D * D,
                 WT_MWIN = WT_GLU + (size_t)D * 2 * D, WT_MWOUT = WT_MWIN + (size_t)D * (MINW + 256), WT_WWQKV = WT_MWOUT + (size_t)D * D, WT_WWO = WT_WWQKV + (size_t)D * QKVW, WT_ELEMS = WT_WWO + (size_t)D * D;
constexpr size_t WS_PEND = 1176 * MiB;
static_assert(WS_WT + WT_ELEMS * 2 <= WS_PEND, "ws map");
constexpr size_t WS_END = WS_PEND + 32 * MiB;

constexpr int CW_BAR = 4096;

__device__ __forceinline__ float bf2f(unsigned v) { return __uint_as_float(v << 16); }
typedef __bf16 bf16x2_t __attribute__((ext_vector_type(2)));
__device__ __forceinline__ unsigned pk2(float lo, float hi) { const f32x2 v = {lo, hi}; const bf16x2_t r = __builtin_convertvector(v, bf16x2_t); return __builtin_bit_cast(unsigned, r); }
__device__ __forceinline__ unsigned f2bf(float f) { return pk2(f, 0.f) & 0xffffu; }
template <int X> __device__ __forceinline__ float swz_xor(float v) { return __int_as_float(__builtin_amdgcn_ds_swizzle(__float_as_int(v), (X << 10) | 0x1f)); }
__device__ __forceinline__ float xor32(float v) { auto rr = __builtin_amdgcn_permlane32_swap(__float_as_uint(v), __float_as_uint(v), false, false); return __uint_as_float(rr[0]) + __uint_as_float(rr[1]) - v; }
__device__ __forceinline__ float wave_sum(float v) {
    v += swz_xor<1>(v); v += swz_xor<2>(v); v += swz_xor<4>(v); v += swz_xor<8>(v); v += swz_xor<16>(v);
    { auto rr = __builtin_amdgcn_permlane32_swap(__float_as_uint(v), __float_as_uint(v), false, false); v = __uint_as_float(rr[0]) + __uint_as_float(rr[1]); }
    return v;
}
__device__ __forceinline__ float sigmoid_f(float v) { return __builtin_amdgcn_rcpf(1.0f + __builtin_amdgcn_exp2f(v * -1.4426950408889634f)); }
__device__ __forceinline__ float silu_f(float v) { return v * sigmoid_f(v); }
__device__ __forceinline__ float gelu_tanh_f(float x) { const float u = 0.7978845608028654f * (x + 0.044715f * x * x * x); return 0.5f * x * (1.0f + tanhf(u)); }
__device__ __forceinline__ int row_ms(int r) { const int b = r / TPB; const int p = r - b * TPB; return p < CTXL ? 4 : b; }

#define XB_TMO      128
#define XB_XCNT(j)  (256  + 64 * (j))
#define XB_XSUB(j)  (1280 + 64 * (j))
#define XB_XGEN(j)  (2304 + 64 * (j))
#define XB_TOP      3328
#define XB_TOPGEN   3392
#define XCD_BAR_WORDS 3456
#define XB_SPIN_CAP (1u << 22)
__device__ __forceinline__ unsigned xb_ld(unsigned* p)              { return __hip_atomic_load(p, __ATOMIC_RELAXED, __HIP_MEMORY_SCOPE_AGENT); }
__device__ __forceinline__ unsigned xb_add(unsigned* p, unsigned v) { return __hip_atomic_fetch_add(p, v, __ATOMIC_RELAXED, __HIP_MEMORY_SCOPE_AGENT); }
__device__ __forceinline__ unsigned xb_xcc_id() { return (unsigned)__builtin_amdgcn_s_getreg((3 << 11) | 20) & 0xFu; }
#define XB_SPIN(cond, bar) do { unsigned _sp = 0; while (cond) { __builtin_amdgcn_s_sleep(1); \
    if ((++_sp & 255u) == 0u) { if (xb_ld(&(bar)[XB_TMO])) break; if (_sp > XB_SPIN_CAP) { atomicAdd(&(bar)[XB_TMO], 1u); break; } } } } while (0)
struct XcdBarrier { unsigned* bar; unsigned x; volatile LAS unsigned* st; };
__device__ __forceinline__ XcdBarrier xcd_barrier_post(unsigned* bar, volatile LAS unsigned* st) {
    XcdBarrier b; b.bar = bar; b.x = xb_xcc_id(); b.st = st;
    if (threadIdx.x == 0) (void)xb_add(&bar[XB_XCNT(b.x)], 1u);
    return b;
}
__device__ __forceinline__ void xcd_barrier_complete(unsigned* bar, unsigned x, unsigned& nloc, unsigned& nx) {
    const unsigned G = gridDim.x * gridDim.y * gridDim.z;
    unsigned sum, cnt, mine, sp = 0u;
    for (;;) {
        sum = 0u; cnt = 0u; mine = 0u;
#pragma unroll
        for (unsigned j = 0; j < 16; ++j) { const unsigned c = xb_ld(&bar[XB_XCNT(j)]); sum += c; cnt += (c > 0u) ? 1u : 0u; mine = (j == x) ? c : mine; }
        if (sum == G) break;
        __builtin_amdgcn_s_sleep(1);
        if ((++sp & 255u) == 0u) { if (xb_ld(&bar[XB_TMO])) break; if (sp > XB_SPIN_CAP) { atomicAdd(&bar[XB_TMO], 1u); break; } }
    }
    nloc = mine > 0u ? mine : 1u; nx = cnt > 0u ? cnt : 1u;
}
__device__ __noinline__ void xcd_barrier(unsigned* bar_, unsigned x_, volatile LAS unsigned* st_) {
    XcdBarrier b; b.bar = bar_; b.x = x_; b.st = st_;
    asm volatile("s_waitcnt vmcnt(0)" ::: "memory");
    __syncthreads();
    if (threadIdx.x == 0) {
        unsigned* bar = b.bar;
        __builtin_amdgcn_s_waitcnt(0);
        unsigned nloc = b.st[0], nx = b.st[1];
        if (nloc == 0u) { xcd_barrier_complete(bar, b.x, nloc, nx); b.st[0] = nloc; b.st[1] = nx; }
        const unsigned old = xb_add(&bar[XB_XSUB(b.x)], 1u);
        const unsigned gen = old / nloc;
        if (old + 1u == (gen + 1u) * nloc) {
            __builtin_amdgcn_fence(__ATOMIC_RELEASE, "agent");
            asm volatile("s_waitcnt vmcnt(0)" ::: "memory");
            const unsigned og = xb_add(&bar[XB_TOP], 1u);
            const unsigned tg = og / nx;
            if (og + 1u == (tg + 1u) * nx) xb_add(&bar[XB_TOPGEN], 1u);
            else XB_SPIN(xb_ld(&bar[XB_TOPGEN]) == tg, bar);
            __builtin_amdgcn_fence(__ATOMIC_ACQUIRE, "agent");
            xb_add(&bar[XB_XGEN(b.x)], 1u);
            asm volatile("s_waitcnt vmcnt(0)" ::: "memory");
        } else {
            XB_SPIN(xb_ld(&bar[XB_XGEN(b.x)]) == gen, bar);
            __builtin_amdgcn_fence(__ATOMIC_ACQUIRE, "agent");
            asm volatile("s_waitcnt vmcnt(0)" ::: "memory");
        }
    }
    __syncthreads();
}

constexpr int LDS_BYTES = 147456;
constexpr int MISC_OFF = 131072 + 320;
struct Args { const float* in[30]; float* out; unsigned char* ws; int ph_lo, ph_hi; };
struct Frame {
    LAS unsigned char* lds; int tid, lane, wave, G, gw, NGW;
    const float* const* in; float* out; unsigned char* ws;
    __device__ __forceinline__ float* MOD() const { return (float*)(ws + WS_MOD); }
    __device__ __forceinline__ float* X() const { return (float*)(ws + WS_X); }
    __device__ __forceinline__ bf16* H() const { return (bf16*)(ws + WS_H); }
    __device__ __forceinline__ bf16* HID() const { return (bf16*)(ws + WS_HID); }
    __device__ __forceinline__ bf16* Q() const { return (bf16*)(ws + WS_Q); }
    __device__ __forceinline__ bf16* K() const { return (bf16*)(ws + WS_K); }
    __device__ __forceinline__ bf16* V() const { return (bf16*)(ws + WS_V); }
    __device__ __forceinline__ bf16* O() const { return (bf16*)(ws + WS_O); }
    __device__ __forceinline__ bf16* QKVO() const { return (bf16*)(ws + WS_QKVO); }
    __device__ __forceinline__ float* GATES() const { return (float*)(ws + WS_GATES); }
    __device__ __forceinline__ float* HDb() const { return (float*)(ws + WS_HD); }
    __device__ __forceinline__ bf16* WT() const { return (bf16*)(ws + WS_WT); }
    __device__ __forceinline__ float* PEND() const { return (float*)(ws + WS_PEND); }
};
__device__ __forceinline__ Frame launder(const Frame& F0) {
    Frame F = F0; asm volatile("" : "+v"(F.tid));
    { unsigned lo = (unsigned)(uintptr_t)F0.ws, hi = (unsigned)((uintptr_t)F0.ws >> 32); asm volatile("" : "+v"(lo), "+v"(hi));
      F.ws = (unsigned char*)(((uintptr_t)(unsigned)__builtin_amdgcn_readfirstlane(hi) << 32) | (uintptr_t)(unsigned)__builtin_amdgcn_readfirstlane(lo)); }
    F.lane = F.tid & 63; F.wave = __builtin_amdgcn_readfirstlane(F.tid >> 6); F.gw = blockIdx.x * NWAVES + F.wave; return F;
}
enum { IN_X = 0, IN_C, IN_CTX, IN_CCTX, IN_MODW, IN_MODB, IN_NORMG, IN_FFNWI, IN_FFNWO, IN_AWQKV, IN_AQKG, IN_AWO,
       IN_S5LRE, IN_S5LIM, IN_S5LDT, IN_S5BRE, IN_S5BIM, IN_S5CRE, IN_S5CIM, IN_S5D, IN_S5WGLU,
       IN_MWIN, IN_MWGATE, IN_MBGATE, IN_MNORMG, IN_MWOUT, IN_WWQKV, IN_WQKG, IN_WSINK, IN_WWO };

__device__ __forceinline__ const float* modp(const Frame& F, int L, int ms, int j) { return F.MOD() + ((size_t)(L * 5 + ms) * NMOD + j) * D; }

__device__ __forceinline__ void ph_init(const Frame& F0) {
    const Frame F = launder(F0);
    const f32x4* xin = (const f32x4*)F.in[IN_X]; const f32x4* cin = (const f32x4*)F.in[IN_CTX]; f32x4* X = (f32x4*)F.X();
    const size_t n4 = (size_t)NR * D / 4, stride = (size_t)F.G * NTHREADS;
    for (size_t i0 = (size_t)blockIdx.x * NTHREADS + F.tid; i0 < n4; i0 += 4 * stride) {
        f32x4 v[4];
#pragma unroll
        for (int k = 0; k < 4; ++k) { const size_t i = i0 + k * stride; const int r = (int)(i / (D / 4)), c4 = (int)(i % (D / 4)); const int b = r / TPB, p = r - b * TPB;
            v[k] = p < CTXL ? cin[((size_t)b * CTXL + p) * (D / 4) + c4] : xin[((size_t)b * SEQ + (p - CTXL)) * (D / 4) + c4]; }
#pragma unroll
        for (int k = 0; k < 4; ++k) X[i0 + k * stride] = v[k];
    }
}
__device__ __forceinline__ void ph_mod(const Frame& F0) {
    const Frame F = launder(F0);
    LAS float* sc = (LAS float*)F.lds;
    for (int i = F.tid; i < 5 * D; i += NTHREADS) { const int ms = i / D, k = i % D; const float v = ms < 4 ? F.in[IN_C][ms * D + k] : F.in[IN_CCTX][k]; sc[i] = silu_f(v); }
    __syncthreads();
    const int NC = NMOD * D;
    for (int idx = blockIdx.x * NTHREADS + F.tid; idx < DEPTH * NC; idx += F.G * NTHREADS) {
        const int L = idx / NC, col = idx % NC; const float* w = F.in[IN_MODW] + (size_t)L * D * NC + col;
        float a0 = 0, a1 = 0, a2 = 0, a3 = 0, a4 = 0;
#pragma unroll 8
        for (int k = 0; k < D; ++k) { const float wv = w[(size_t)k * NC]; a0 += sc[k] * wv; a1 += sc[D + k] * wv; a2 += sc[2 * D + k] * wv; a3 += sc[3 * D + k] * wv; a4 += sc[4 * D + k] * wv; }
        const float bb = F.in[IN_MODB][(size_t)L * NC + col];
        float* o = F.MOD() + (size_t)L * 5 * NC + col;
        o[0] = a0 + bb; o[NC] = a1 + bb; o[2 * NC] = a2 + bb; o[3 * NC] = a3 + bb; o[4 * NC] = a4 + bb;
    }
    __syncthreads();
}
template <bool GATES>
__device__ __forceinline__ void ph_norm(const Frame& F0, int L, int j, const float* pend_gate, float pcoef, bool from_inputs = false) {
    const Frame F = launder(F0);
    const float* ng = F.in[IN_NORMG] + (size_t)(L * 3 + j) * D;
    if (!CTX_SPLIT) pend_gate = nullptr;
    for (int r = F.gw; r < NR; r += F.NGW) {
        const int ms = row_ms(r);
        const f32x4* xr = (const f32x4*)(F.X() + (size_t)r * D) + F.lane;
        if (from_inputs) { const int b = r / TPB, p = r - b * TPB; xr = (const f32x4*)(p < CTXL ? F.in[IN_CTX] + ((size_t)b * CTXL + p) * D : F.in[IN_X] + ((size_t)b * SEQ + (p - CTXL)) * D) + F.lane; }
        const f32x4* g4 = (const f32x4*)ng + F.lane; const f32x4* sh4 = (const f32x4*)modp(F, L, ms, 3 * j) + F.lane; const f32x4* sc4 = (const f32x4*)modp(F, L, ms, 3 * j + 1) + F.lane;
        f32x4 v[8], gg[8], shv[8], scv[8]; float ss = 0.f;
#pragma unroll
        for (int q = 0; q < 8; ++q) { v[q] = xr[64 * q]; gg[q] = g4[64 * q]; shv[q] = sh4[64 * q]; scv[q] = sc4[64 * q]; }
        if (pend_gate != nullptr && ms == 4) {
            const int b = r / TPB, cr = b * CTXL + (r - b * TPB); const f32x4* pg4 = (const f32x4*)pend_gate + F.lane; const f32x4* p4 = (const f32x4*)(F.PEND() + (size_t)cr * D) + F.lane;
            f32x4* xw = (f32x4*)(F.X() + (size_t)r * D) + F.lane;
            f32x4 ps[8];
#pragma unroll
            for (int q = 0; q < 8; ++q) ps[q] = ((p4[64 * q] + p4[64 * q + (size_t)NB * CTXL * D / 4]) + (p4[64 * q + (size_t)2 * NB * CTXL * D / 4] + p4[64 * q + (size_t)3 * NB * CTXL * D / 4])) * pg4[64 * q];
#pragma unroll
            for (int q = 0; q < 8; ++q) { v[q] = v[q] + pcoef * ps[q]; xw[64 * q] = v[q]; }
        }
        if (from_inputs) { f32x4* xw = (f32x4*)(F.X() + (size_t)r * D) + F.lane;
#pragma unroll
            for (int q = 0; q < 8; ++q) xw[64 * q] = v[q]; }
#pragma unroll
        for (int q = 0; q < 8; ++q) ss += (v[q].x * v[q].x + v[q].y * v[q].y) + (v[q].z * v[q].z + v[q].w * v[q].w);
        const float rstd = 1.0f / sqrtf(wave_sum(ss) * (1.0f / D) + NORM_EPS);
        u32x2* o = (u32x2*)(F.H() + (size_t)r * D) + F.lane;
#pragma unroll
        for (int q = 0; q < 8; ++q) { v[q] = (v[q] * rstd) * gg[q] * (scv[q] + 1.0f) + shv[q];
            u32x2 w; w.x = pk2(v[q].x, v[q].y); w.y = pk2(v[q].z, v[q].w); o[64 * q] = w; }
        if constexpr (GATES) {
            LAS float* hrow = (LAS float*)F.lds + F.wave * D;
#pragma unroll
            for (int q = 0; q < 8; ++q) *(LAS f32x4*)(hrow + (F.lane + 64 * q) * 4) = v[q];
            const int t = F.lane & 31, hf = F.lane >> 5; const float* wg = F.in[IN_MWGATE] + t; float acc = 0.f;
#pragma unroll 8
            for (int d = hf * 1024; d < hf * 1024 + 1024; ++d) acc += hrow[d] * wg[(size_t)d * 32];
            { auto rr = __builtin_amdgcn_permlane32_swap(__float_as_uint(acc), __float_as_uint(acc), false, false); acc = __uint_as_float(rr[0]) + __uint_as_float(rr[1]); }
            if (F.lane < 32) { const float g = acc + F.in[IN_MBGATE][t]; F.GATES()[(size_t)r * 32 + t] = GATE_CAP * tanhf(g / GATE_CAP); }
        }
    }
}

struct EpiSwiglu { bf16* HID;
    __device__ __forceinline__ void operator()(int r, int c, f32x4 a, f32x4 g) const {
        u32x2 w; w.x = pk2(silu_f(g.x) * a.x, silu_f(g.y) * a.y); w.y = pk2(silu_f(g.z) * a.z, silu_f(g.w) * a.w);
        *(u32x2*)(HID + (size_t)r * DFF + c) = w; } };
template <int HALF> struct EpiResid { float* X; const float* gate;
    __device__ __forceinline__ void operator()(int r, int c, f32x4 a, f32x4) const {
        const int ms = row_ms(r); const f32x4 g = *(const f32x4*)(gate + (size_t)ms * NMOD * D + c);
        f32x4* xp = (f32x4*)(X + (size_t)r * D + c); *xp = *xp + (HALF ? 0.5f : 1.0f) * (g * a); } };
struct EpiFinal { const float* X; const float* gate; float* out;
    __device__ __forceinline__ void operator()(int r, int c, f32x4 a, f32x4) const {
        const int b = r / TPB, p = r - b * TPB; if (p < CTXL) return;
        const f32x4 g = *(const f32x4*)(gate + (size_t)b * NMOD * D + c);
        *(f32x4*)(out + ((size_t)b * SEQ + (p - CTXL)) * D + c) = *(const f32x4*)(X + (size_t)r * D + c) + 0.5f * (g * a); } };
struct EpiGluResid { float* X; const float* gate;
    __device__ __forceinline__ void operator()(int r, int c, f32x4 a, f32x4 g) const {
        const int ms = row_ms(r); const f32x4 gt = *(const f32x4*)(gate + (size_t)ms * NMOD * D + c);
        f32x4* xp = (f32x4*)(X + (size_t)r * D + c); f32x4 s; s.x = sigmoid_f(g.x); s.y = sigmoid_f(g.y); s.z = sigmoid_f(g.z); s.w = sigmoid_f(g.w);
        *xp = *xp + gt * a * s; } };
struct EpiQKV { bf16 *Q, *K, *V;
    __device__ __forceinline__ void operator()(int r, int c, f32x4 a, f32x4) const {
        u32x2 w; w.x = pk2(a.x, a.y); w.y = pk2(a.z, a.w);
        bf16* p = c < QW ? Q + (size_t)r * QW + c : (c < QW + KVW ? K + (size_t)r * KVW + (c - QW) : V + (size_t)r * KVW + (c - QW - KVW));
        *(u32x2*)p = w; } };
struct EpiMlstmIn { bf16* O; float* G; const float* bg;
    __device__ __forceinline__ void operator()(int r, int c, f32x4 a, f32x4) const {
        if (c < MINW) { u32x2 w; w.x = pk2(a.x, a.y); w.y = pk2(a.z, a.w); *(u32x2*)(O + (size_t)r * MINW + c) = w; }
        else if (c < MINW + 32) { const f32x4 b = *(const f32x4*)(bg + (c - MINW)); f32x4 g;
            g.x = GATE_CAP * tanhf((a.x + b.x) * (1.0f / GATE_CAP)); g.y = GATE_CAP * tanhf((a.y + b.y) * (1.0f / GATE_CAP)); g.z = GATE_CAP * tanhf((a.z + b.z) * (1.0f / GATE_CAP)); g.w = GATE_CAP * tanhf((a.w + b.w) * (1.0f / GATE_CAP));
            *(f32x4*)(G + (size_t)r * 32 + (c - MINW)) = g; }
    } };
struct EpiBf16 { bf16* O; int ld;
    __device__ __forceinline__ void operator()(int r, int c, f32x4 a, f32x4) const { u32x2 w; w.x = pk2(a.x, a.y); w.y = pk2(a.z, a.w); *(u32x2*)(O + (size_t)r * ld + c) = w; } };

template <bool DUAL, class Epi>
__device__ __forceinline__ void gemm_naive(const Frame& F0, const bf16* A, int lda, const float* W, int ldw, int M, int N, int K, int dual_off, const Epi E) {
    const Frame F = launder(F0);
    constexpr int BM = 128, BN = 128, BK = 16;
    LAS float* As = (LAS float*)F.lds;
    LAS float* Bs = As + BK * (BM + 4);
    LAS float* B2 = Bs + BK * BN;
    const int ty = F.tid >> 5, tx = F.tid & 31;
    const int ntm = M / BM, ntn = N / BN, nt = ntm * ntn;
    for (int t = blockIdx.x; t < nt; t += F.G) {
        const int tm = t / ntn, tn = t % ntn; const int m0 = tm * BM, n0 = tn * BN;
        f32x4 acc[8], acc2[8];
#pragma unroll
        for (int i = 0; i < 8; ++i) { acc[i] = (f32x4){0.f, 0.f, 0.f, 0.f}; acc2[i] = (f32x4){0.f, 0.f, 0.f, 0.f}; }
        for (int k0 = 0; k0 < K; k0 += BK) {
            { const int row = F.tid >> 2, kq = (F.tid & 3) * 4; const u32x2 w = *(const u32x2*)(A + (size_t)(m0 + row) * lda + k0 + kq);
              As[(kq + 0) * (BM + 4) + row] = bf2f(w.x & 0xffffu); As[(kq + 1) * (BM + 4) + row] = bf2f(w.x >> 16); As[(kq + 2) * (BM + 4) + row] = bf2f(w.y & 0xffffu); As[(kq + 3) * (BM + 4) + row] = bf2f(w.y >> 16); }
            { const int kk = F.tid >> 5, c4 = (F.tid & 31) * 4; *(LAS f32x4*)(Bs + kk * BN + c4) = *(const f32x4*)(W + (size_t)(k0 + kk) * ldw + n0 + c4);
              if constexpr (DUAL) *(LAS f32x4*)(B2 + kk * BN + c4) = *(const f32x4*)(W + (size_t)(k0 + kk) * ldw + dual_off + n0 + c4); }
            __syncthreads();
#pragma unroll
            for (int kk = 0; kk < BK; ++kk) {
                const f32x4 a0 = *(LAS f32x4*)(As + kk * (BM + 4) + ty * 8), a1 = *(LAS f32x4*)(As + kk * (BM + 4) + ty * 8 + 4);
                const f32x4 b = *(LAS f32x4*)(Bs + kk * BN + tx * 4);
                acc[0] += a0.x * b; acc[1] += a0.y * b; acc[2] += a0.z * b; acc[3] += a0.w * b; acc[4] += a1.x * b; acc[5] += a1.y * b; acc[6] += a1.z * b; acc[7] += a1.w * b;
                if constexpr (DUAL) { const f32x4 b2 = *(LAS f32x4*)(B2 + kk * BN + tx * 4);
                    acc2[0] += a0.x * b2; acc2[1] += a0.y * b2; acc2[2] += a0.z * b2; acc2[3] += a0.w * b2; acc2[4] += a1.x * b2; acc2[5] += a1.y * b2; acc2[6] += a1.z * b2; acc2[7] += a1.w * b2; }
            }
            __syncthreads();
        }
#pragma unroll
        for (int i = 0; i < 8; ++i) E(m0 + ty * 8 + i, n0 + tx * 4, acc[i], acc2[i]);
    }
}

namespace pg8 {
#define PG8_LAS __attribute__((address_space(3)))
typedef unsigned short bf16_t;
typedef short bf16x8 __attribute__((ext_vector_type(8)));
typedef float f32x4 __attribute__((ext_vector_type(4)));
typedef unsigned u32x4 __attribute__((ext_vector_type(4)));
constexpr int BM = 256, BK = 64, HALF = 128, HTB = HALF * BK * 2  , STAGE_BYTES = 8 * HTB, NXCD = 8, WGM = 8;

__host__ __device__ __forceinline__ int lds_byte(int r, int c) { const int st = (r >> 4) * 2 + (c >> 5), rr = r & 15, cc = c & 31, ob = rr * 64 + cc * 2; return st * 1024 + (ob ^ (((ob >> 9) & 1) << 5)); }
__host__ __device__ __forceinline__ void stage_rc(int b, int& R, int& C) { const int st = b / 1024, sb = b % 1024, swz = sb ^ (((sb >> 9) & 1) << 5); R = (st >> 1) * 16 + swz / 64; C = (st & 1) * 32 + (swz % 64) / 2; }
__host__ __device__ __forceinline__ int perm32(int rho) { const int n = rho >> 4, i = rho & 15; return 8 * (i >> 2) + 4 * n + (i & 3); }

struct Unit { int pm, pn, ks; };
struct Gemm { const bf16_t* A; const bf16_t* Bt; int lda, ldb; };

struct StaticOrder {
    int nM, nN, nwg, G, c;
    __host__ __device__ void init(int M, int N, int G_, int c_) { nM = M / BM; nN = N / BM; nwg = nM * nN; G = G_; c = c_; }
    __host__ __device__ bool next(int i, Unit& u) const {
        const long L = (long)i * G + c; if (L >= nwg) { u.pm = 0; u.pn = 0; return false; }
        int wgid = (int)L; { const int q = nwg / NXCD, r = nwg % NXCD, xcd = wgid % NXCD, off = wgid / NXCD; wgid = (xcd < r ? xcd * (q + 1) : r * (q + 1) + (xcd - r) * q) + off; }
        const int nig = WGM * nN, gid = wgid / nig, fm = gid * WGM, gsz = (nM - fm) < WGM ? (nM - fm) : WGM;
        u.pm = fm + ((wgid % nig) % gsz); u.pn = (wgid % nig) / gsz; return true;
    }
    __device__ __forceinline__ void a_ready(const Unit&) const {}
    __device__ __forceinline__ void done(const Unit&) const {}
};
struct TileSched {
    StaticOrder so; int lat, ctx_split, lda, ldb, ntK;
    __device__ __forceinline__ void init(int nMlog, int Nbt, int G, int c, int lat_, int ctx_split_, int lda_, int ldb_, int K) { so.init(nMlog * BM, Nbt, G, c); lat = lat_; ctx_split = ctx_split_; lda = lda_; ldb = ldb_; ntK = K / BK; }
    __device__ __forceinline__ bool next(int i, Unit& u) const {
        Unit t; t.pm = 0; t.pn = 0; t.ks = -1; const bool main = so.next(i, t);
        int pm = lat ? t.pm + t.pm / 8 + 1 : t.pm, pn = t.pn, ks = -1; bool ok = main;
        if (!main && ctx_split) { const long e = (long)i * so.G + so.c - so.nwg; ok = (e >= 0 && e < 128); const int tile = (int)e >> 2; ks = (int)e & 3; pm = 9 * (tile >> 3); pn = tile & 7; }
        u.pm = pm; u.pn = pn; u.ks = ks; return ok;
    }
    __device__ __forceinline__ int k0(const Unit& u) const { return u.ks <= 0 ? 0 : (ntK >> 2) * u.ks; }
    __device__ __forceinline__ int nt(const Unit& u) const { return u.ks < 0 ? ntK : (ntK >> 2); }
    __device__ __forceinline__ size_t a_off(const Unit& u) const { return ((size_t)u.pm * BM * lda + (size_t)k0(u) * BK) * 2; }
    __device__ __forceinline__ size_t b_off(const Unit& u) const { return ((size_t)u.pn * BM * ldb + (size_t)k0(u) * BK) * 2; }
    __device__ __forceinline__ void a_ready(const Unit&) const {}
    __device__ __forceinline__ void done(const Unit&) const {}
};
template <class Epi, class Sched, bool ALIGN_EPI = false, bool SP2 = false>
__device__ __forceinline__ void gemm_phase(PG8_LAS unsigned char* lds, const Gemm g, const Sched& S, const Epi& E) {
    int tid_ = threadIdx.x; asm volatile("" : "+v"(tid_));
    const int tid = tid_, wid = __builtin_amdgcn_readfirstlane(tid >> 6), lane = tid & 63, wr = wid >> 2, wc = wid & 3, fr = lane & 15, fq = lane >> 4;
    unsigned voffA[2], voffB[2];
#pragma unroll
    for (int i = 0; i < 2; ++i) { int R, C; stage_rc(tid * 16 + i * 8192, R, C); const int Rb = Epi::PERM ? ((R & ~31) + perm32(R & 31)) : R;
        voffA[i] = (unsigned)(R * g.lda + C) * 2u; voffB[i] = (unsigned)(Rb * g.ldb + C) * 2u; }
    const size_t kstep = (size_t)(BK * 2);
    const size_t hstepA = (size_t)HALF * g.lda * 2, hstepB = (size_t)HALF * g.ldb * 2;
    const unsigned ldsw = (unsigned)wid * 1024u;
    const int aoff = lds_byte(wr * 64 + fr, fq * 8), boff = lds_byte(wc * 32 + fr, fq * 8);
#define PG8_SA(b, h) (((b) * 2 + (h)) * HTB)
#define PG8_SB(b, h) ((4 + (b) * 2 + (h)) * HTB)
#define PG8_STAGE(bufoff, gbase, voff) do { _Pragma("unroll") for (int _i = 0; _i < 2; ++_i) \
        __builtin_amdgcn_global_load_lds((const unsigned*)((const char*)(gbase) + (voff)[_i]), (PG8_LAS unsigned*)(lds + (bufoff) + ldsw + _i * 8192), 16, 0, 0); } while (0)
#define PG8_LDA(dst, b, h) do { _Pragma("unroll") for (int m = 0; m < 4; ++m) _Pragma("unroll") for (int k = 0; k < 2; ++k) dst[m][k] = *(const PG8_LAS bf16x8*)(lds + PG8_SA(b, h) + aoff + m * 2048 + k * 1024); } while (0)
#define PG8_LDB(dst, b, h) do { _Pragma("unroll") for (int n = 0; n < 2; ++n) _Pragma("unroll") for (int k = 0; k < 2; ++k) dst[n][k] = *(const PG8_LAS bf16x8*)(lds + PG8_SB(b, h) + boff + n * 2048 + k * 1024); } while (0)
#define PG8_MMA(ai, bj, At, Bt) do { __builtin_amdgcn_s_setprio(1); _Pragma("unroll") for (int m = 0; m < 4; ++m) _Pragma("unroll") for (int n = 0; n < 2; ++n) _Pragma("unroll") for (int k = 0; k < 2; ++k) \
        acc[ai][bj][m][n] = __builtin_amdgcn_mfma_f32_16x16x32_bf16(Bt[n][k], At[m][k], acc[ai][bj][m][n], 0, 0, 0); __builtin_amdgcn_s_setprio(0); } while (0)
#define PG8_WAIT_V(n) asm volatile("s_waitcnt vmcnt(" #n ")" ::: "memory")
#define PG8_WAIT_L(n) asm volatile("s_waitcnt lgkmcnt(" #n ")" ::: "memory")
#define PG8_BAR __builtin_amdgcn_s_barrier()
#define PG8_SCHED __builtin_amdgcn_sched_barrier(0)
    Unit cur, nxt; int ui = 0;
    if (!S.next(0, cur)) return;
    f32x4 acc[2][2][4][2];
#pragma unroll
    for (int a = 0; a < 2; ++a)
#pragma unroll
        for (int b = 0; b < 2; ++b)
#pragma unroll
            for (int m = 0; m < 4; ++m)
#pragma unroll
                for (int n = 0; n < 2; ++n) acc[a][b][m][n] = (f32x4){0.f, 0.f, 0.f, 0.f};
    bf16x8 At[4][2], B0[2][2], B1[2][2];
    const char* cA = (const char*)g.A + S.a_off(cur); const char* cB = (const char*)g.Bt + S.b_off(cur);
    S.a_ready(cur);
    if constexpr (SP2) {
        PG8_STAGE(PG8_SB(0, 0), cB, voffB); PG8_STAGE(PG8_SB(0, 1), cB + hstepB, voffB); PG8_STAGE(PG8_SA(0, 0), cA, voffA); PG8_STAGE(PG8_SA(0, 1), cA + hstepA, voffA);
        if (wr == 1) PG8_BAR;
        PG8_WAIT_V(2); PG8_BAR;
        PG8_STAGE(PG8_SB(1, 0), cB + kstep, voffB); PG8_STAGE(PG8_SA(1, 0), cA + kstep, voffA); PG8_STAGE(PG8_SB(1, 1), cB + hstepB + kstep, voffB);
        PG8_WAIT_V(6); PG8_BAR;
    } else {
        PG8_STAGE(PG8_SB(0, 0), cB, voffB); PG8_STAGE(PG8_SA(0, 0), cA, voffA); PG8_STAGE(PG8_SB(0, 1), cB + hstepB, voffB); PG8_STAGE(PG8_SA(0, 1), cA + hstepA, voffA);
        if (wr == 1) PG8_BAR;
        PG8_WAIT_V(4); PG8_BAR;
        PG8_STAGE(PG8_SB(1, 0), cB + kstep, voffB); PG8_STAGE(PG8_SA(1, 0), cA + kstep, voffA); PG8_STAGE(PG8_SB(1, 1), cB + hstepB + kstep, voffB);
        PG8_WAIT_V(6); PG8_BAR;
    }
    for (;;) {
        const bool has_next = S.next(ui + 1, nxt);
        const char* nA = has_next ? (const char*)g.A + S.a_off(nxt) : cA; const char* nB = has_next ? (const char*)g.Bt + S.b_off(nxt) : cB;
        const int nt = S.nt(cur);
        for (int t = 0; t < nt; t += 2) {
            const bool last = (t == nt - 2);
            const char* a1 = cA + (size_t)(t + 1) * kstep;
            const char* a2 = last ? nA : cA + (size_t)(t + 2) * kstep; const char* b2 = last ? nB : cB + (size_t)(t + 2) * kstep;
            const char* a3 = a2 + kstep; const char* b3 = b2 + kstep;
            if (last && has_next) S.a_ready(nxt);
            if constexpr (SP2) {
            PG8_LDB(B0, 0, 0); PG8_LDB(B1, 0, 1); PG8_SCHED; PG8_LDA(At, 0, 0); PG8_STAGE(PG8_SA(1, 1), a1 + hstepA, voffA);
            PG8_WAIT_V(8); PG8_WAIT_L(0); PG8_BAR; PG8_MMA(0, 0, At, B0); PG8_MMA(0, 1, At, B1); PG8_BAR; PG8_SCHED;
            PG8_LDA(At, 0, 1); PG8_STAGE(PG8_SB(0, 0), b2, voffB); PG8_STAGE(PG8_SB(0, 1), b2 + hstepB, voffB); PG8_STAGE(PG8_SA(0, 0), a2, voffA);
            PG8_WAIT_V(8); PG8_WAIT_L(0); PG8_BAR; PG8_MMA(1, 0, At, B0); PG8_MMA(1, 1, At, B1); PG8_BAR; PG8_SCHED;
            PG8_LDB(B0, 1, 0); PG8_LDB(B1, 1, 1); PG8_SCHED; PG8_LDA(At, 1, 0); PG8_STAGE(PG8_SA(0, 1), a2 + hstepA, voffA);
            PG8_WAIT_V(8); PG8_WAIT_L(0); PG8_BAR; PG8_MMA(0, 0, At, B0); PG8_MMA(0, 1, At, B1); PG8_BAR; PG8_SCHED;
            PG8_LDA(At, 1, 1); PG8_STAGE(PG8_SB(1, 0), b3, voffB); PG8_STAGE(PG8_SB(1, 1), b3 + hstepB, voffB); PG8_STAGE(PG8_SA(1, 0), a3, voffA);
            PG8_WAIT_V(8); PG8_WAIT_L(0); PG8_BAR; PG8_MMA(1, 0, At, B0); PG8_MMA(1, 1, At, B1); PG8_BAR; PG8_SCHED;
            } else {
            PG8_LDB(B0, 0, 0); PG8_SCHED; PG8_LDA(At, 0, 0); PG8_STAGE(PG8_SA(1, 1), a1 + hstepA, voffA);
            PG8_WAIT_L(8); PG8_BAR; PG8_WAIT_L(0); PG8_MMA(0, 0, At, B0); PG8_BAR; PG8_SCHED;
            PG8_LDB(B1, 0, 1); PG8_STAGE(PG8_SB(0, 0), b2, voffB);
            PG8_BAR; PG8_WAIT_L(0); PG8_MMA(0, 1, At, B1); PG8_BAR;
            PG8_LDA(At, 0, 1); PG8_STAGE(PG8_SA(0, 0), a2, voffA);
            PG8_BAR; PG8_WAIT_L(0); PG8_MMA(1, 0, At, B0); PG8_BAR; PG8_SCHED;
            PG8_STAGE(PG8_SB(0, 1), b2 + hstepB, voffB);
            PG8_WAIT_V(6); PG8_BAR; PG8_MMA(1, 1, At, B1); PG8_BAR;
            PG8_LDB(B0, 1, 0); PG8_SCHED; PG8_LDA(At, 1, 0); PG8_STAGE(PG8_SA(0, 1), a2 + hstepA, voffA);
            PG8_WAIT_L(8); PG8_BAR; PG8_WAIT_L(0); PG8_MMA(0, 0, At, B0); PG8_BAR; PG8_SCHED;
            PG8_LDB(B1, 1, 1); PG8_STAGE(PG8_SB(1, 0), b3, voffB);
            PG8_BAR; PG8_WAIT_L(0); PG8_MMA(0, 1, At, B1); PG8_BAR;
            PG8_LDA(At, 1, 1); PG8_STAGE(PG8_SA(1, 0), a3, voffA);
            PG8_BAR; PG8_WAIT_L(0); PG8_MMA(1, 0, At, B0); PG8_BAR; PG8_SCHED;
            PG8_STAGE(PG8_SB(1, 1), b3 + hstepB, voffB);
            PG8_WAIT_V(6); PG8_BAR; PG8_MMA(1, 1, At, B1); PG8_BAR;
            }
        }
        if constexpr (ALIGN_EPI) { if (wr == 0) PG8_BAR; }
        if constexpr (!Epi::AFTER_DRAIN) { E(acc, cur, wr, wc, fr, fq); S.done(cur); }
        if (!has_next) break;
#pragma unroll
        for (int a = 0; a < 2; ++a)
#pragma unroll
            for (int b = 0; b < 2; ++b)
#pragma unroll
                for (int m = 0; m < 4; ++m)
#pragma unroll
                    for (int n = 0; n < 2; ++n) acc[a][b][m][n] = (f32x4){0.f, 0.f, 0.f, 0.f};
        cur = nxt; cA = nA; cB = nB; ++ui;
        if constexpr (ALIGN_EPI) { if (wr == 1) PG8_BAR; }
    }
    PG8_WAIT_V(0);
    if constexpr (!ALIGN_EPI) { if (wr == 0) PG8_BAR; }
    PG8_BAR;
    if constexpr (Epi::AFTER_DRAIN) { E.fused(acc, cur, wr, wc, fr, fq, lds, wid, lane); S.done(cur); }
#undef PG8_SA
#undef PG8_SB
#undef PG8_STAGE
#undef PG8_LDA
#undef PG8_LDB
#undef PG8_MMA
#undef PG8_WAIT_V
#undef PG8_WAIT_L
#undef PG8_BAR
#undef PG8_SCHED
}
}

template <int KIND> struct EpiRmw { static constexpr bool RMW = true; float* X; const float* gate; float* out; };
template <int KIND, bool DUAL>
__device__ __forceinline__ void rmw_tile(const EpiRmw<KIND>& e, const pg8::f32x4 (&acc)[2][2][4][2], const pg8::Unit& u, int wr, int wc, int fr, int fq) {
    constexpr int NC = DUAL ? 2 : 4;
    const int b = u.pm / 9, ms = (u.pm - 9 * b) == 0 ? 4 : b;
    int col[NC]; f32x4 gv[NC];
#pragma unroll
    for (int k = 0; k < NC; ++k) { col[k] = DUAL ? u.pn * 128 + wc * 32 + k * 16 + 4 * fq : u.pn * 256 + (k >> 1) * 128 + wc * 32 + (k & 1) * 16 + 4 * fq;
        gv[k] = *(const f32x4*)(e.gate + (size_t)ms * NMOD * D + col[k]); if (KIND == 1 || KIND == 2) gv[k] = gv[k] * 0.5f; }
#pragma unroll
    for (int ai = 0; ai < 2; ++ai)
#pragma unroll
        for (int mp = 0; mp < 2; ++mp) {
            f32x4 x[2][NC];
#pragma unroll
            for (int mi = 0; mi < 2; ++mi) { const int r = u.pm * 256 + ai * 128 + wr * 64 + (2 * mp + mi) * 16 + fr;
#pragma unroll
                for (int k = 0; k < NC; ++k) x[mi][k] = *(const f32x4*)(e.X + (size_t)r * D + col[k]); }
#pragma unroll
            for (int mi = 0; mi < 2; ++mi) { const int m = 2 * mp + mi, rl = ai * 128 + wr * 64 + m * 16 + fr, r = u.pm * 256 + rl;
                float* dst = KIND == 2 ? e.out + ((size_t)b * SEQ + (size_t)(u.pm - 9 * b - 1) * 256 + rl) * D : e.X + (size_t)r * D;
#pragma unroll
                for (int k = 0; k < NC; ++k) { f32x4 a;
                    if constexpr (DUAL) { const f32x4 aa = acc[ai][0][m][k], gg = acc[ai][1][m][k]; a.x = aa.x * sigmoid_f(gg.x); a.y = aa.y * sigmoid_f(gg.y); a.z = aa.z * sigmoid_f(gg.z); a.w = aa.w * sigmoid_f(gg.w); }
                    else a = acc[ai][k >> 1][m][k & 1];
                    *(f32x4*)(dst + col[k]) = x[mi][k] + gv[k] * a; } }
            asm volatile("" ::: "memory");
        }
}
template <class T> struct is_rmw { static constexpr bool value = false; static constexpr int kind = -1; };
template <int KIND> struct is_rmw<EpiRmw<KIND>> { static constexpr bool value = true; static constexpr int kind = KIND; };

template <bool DUAL, class SE> struct EpiWrap {
    static constexpr bool PERM = false, AFTER_DRAIN = false;
    SE e;
    __device__ __forceinline__ void operator()(const pg8::f32x4 (&acc)[2][2][4][2], const pg8::Unit& u, int wr, int wc, int fr, int fq) const {
        if constexpr (is_rmw<SE>::value) { rmw_tile<is_rmw<SE>::kind, DUAL>(e, acc, u, wr, wc, fr, fq); return; } else {
#pragma unroll
        for (int ai = 0; ai < 2; ++ai)
#pragma unroll
            for (int m = 0; m < 4; ++m) { const int r = u.pm * 256 + ai * 128 + wr * 64 + m * 16 + fr;
                if constexpr (DUAL) {
#pragma unroll
                    for (int n = 0; n < 2; ++n) e(r, u.pn * 128 + wc * 32 + n * 16 + 4 * fq, acc[ai][0][m][n], acc[ai][1][m][n]);
                } else {
#pragma unroll
                    for (int bj = 0; bj < 2; ++bj)
#pragma unroll
                        for (int n = 0; n < 2; ++n) e(r, u.pn * 256 + bj * 128 + wc * 32 + n * 16 + 4 * fq, acc[ai][bj][m][n], acc[ai][bj][m][n]);
                }
                asm volatile("" ::: "memory"); }
        }
    }
};
template <bool DUAL, class SE>
__device__ __forceinline__ void gemm_fast(const Frame& F, const bf16* A, const bf16* Bt, int nMlog, int lat, int Nbt, int K, const SE e) {
    pg8::Gemm g{A, Bt, K, K}; pg8::TileSched S; S.init(nMlog, Nbt, F.G, (int)blockIdx.x, lat, 0, K, K, K);
    EpiWrap<DUAL, SE> E{e};
    pg8::gemm_phase<EpiWrap<DUAL, SE>, pg8::TileSched, true, true>(F.lds, g, S, E);
}
template <class SE> struct EpiDownWrap {
    static constexpr bool PERM = false, AFTER_DRAIN = false;
    SE e; float* P;
    __device__ __forceinline__ void operator()(const pg8::f32x4 (&acc)[2][2][4][2], const pg8::Unit& u, int wr, int wc, int fr, int fq) const {
        if (u.ks < 0) { rmw_tile<is_rmw<SE>::kind, false>(e, acc, u, wr, wc, fr, fq); return; }
#pragma unroll
        for (int ai = 0; ai < 2; ++ai)
#pragma unroll
            for (int m = 0; m < 4; ++m) { const int rl = ai * 128 + wr * 64 + m * 16 + fr, r = u.pm * 256 + rl;
                if (u.ks < 0) { (void)r; } else { float* pr = P + ((size_t)u.ks * (NB * CTXL) + (u.pm / 9) * 256 + rl) * D + u.pn * 256 + wc * 32 + 4 * fq;
#pragma unroll
                    for (int bj = 0; bj < 2; ++bj)
#pragma unroll
                        for (int n = 0; n < 2; ++n) *(f32x4*)(pr + bj * 128 + n * 16) = acc[ai][bj][m][n];
                }
                asm volatile("" ::: "memory"); }
    }
};
template <class SE>
__device__ __forceinline__ void gemm_down(const Frame& F, const bf16* A, const bf16* Bt, int K, int ctx_split, const SE e) {
    pg8::Gemm g{A, Bt, K, K}; pg8::TileSched S; if (CTX_SPLIT || !ctx_split) S.init(32, D, F.G, (int)blockIdx.x, 1, ctx_split, K, K, K); else S.init(36, D, F.G, (int)blockIdx.x, 0, 0, K, K, K);
    EpiDownWrap<SE> E{e, F.PEND()};
    pg8::gemm_phase<EpiDownWrap<SE>, pg8::TileSched, true, true>(F.lds, g, S, E);
}
__device__ __forceinline__ void cvt_item(const float* W, int K, int N, bf16* WT, int split, LAS float* scr, int item, int lane) {
    const int nblk = N / 32, kb = item / nblk, nb = item % nblk, k0 = 64 * kb, n0 = 32 * nb;
    int r0 = n0; if (split) { const int j = n0 < split ? n0 : n0 - split; r0 = (j >> 7) * 256 + (j & 127) + (n0 < split ? 0 : 128); }
#pragma unroll 8
    for (int i = 0; i < 32; ++i) { const int kk = 2 * i + (lane >> 5); scr[kk * 33 + (lane & 31)] = W[(size_t)(k0 + kk) * N + n0 + (lane & 31)]; }
    asm volatile("s_waitcnt lgkmcnt(0)" ::: "memory");
    const int c = lane & 7;
#pragma unroll
    for (int j = 0; j < 4; ++j) { const int n = (lane >> 3) + 8 * j; const LAS float* sp = scr + (8 * c) * 33 + n;
        u32x4 o; o.x = pk2(sp[0 * 33], sp[1 * 33]); o.y = pk2(sp[2 * 33], sp[3 * 33]); o.z = pk2(sp[4 * 33], sp[5 * 33]); o.w = pk2(sp[6 * 33], sp[7 * 33]);
        *(u32x4*)(WT + (size_t)(r0 + n) * K + k0 + 8 * c) = o; }
    asm volatile("s_waitcnt lgkmcnt(0)" ::: "memory");
}
__device__ __forceinline__ void ph_cvt_weights(const Frame& F0) {
    const Frame F = launder(F0);
    LAS float* scr = (LAS float*)(F.lds + F.wave * 16384);
    int it = F.gw;
#define CVT(Wp, K_, N_, dst, split) do { const int ni = ((K_) / 64) * ((N_) / 32); for (; it < ni; it += F.NGW) cvt_item((Wp), (K_), (N_), (dst), (split), scr, it, F.lane); it -= ni; } while (0)
#pragma unroll 1
    for (int m = 0; m < 8; ++m) CVT(F.in[IN_FFNWI] + (size_t)m * D * 2 * DFF, D, 2 * DFF, F.WT() + WT_FFNWI + (size_t)m * D * 2 * DFF, DFF);
#pragma unroll 1
    for (int m = 0; m < 8; ++m) CVT(F.in[IN_FFNWO] + (size_t)m * DFF * D, DFF, D, F.WT() + WT_FFNWO + (size_t)m * DFF * D, 0);
    CVT(F.in[IN_AWQKV], D, QKVW, F.WT() + WT_AWQKV, 0);
    CVT(F.in[IN_AWO], D, D, F.WT() + WT_AWO, 0);
    CVT(F.in[IN_S5WGLU], D, 2 * D, F.WT() + WT_GLU, D);
    CVT(F.in[IN_MWIN], D, MINW, F.WT() + WT_MWIN, 0);
    CVT(F.in[IN_MWGATE], D, 32, F.WT() + WT_MWIN + (size_t)MINW * D, 0);
    CVT(F.in[IN_MWOUT], D, D, F.WT() + WT_MWOUT, 0);
    CVT(F.in[IN_WWQKV], D, QKVW, F.WT() + WT_WWQKV, 0);
    CVT(F.in[IN_WWO], D, D, F.WT() + WT_WWO, 0);
#undef CVT
}

__device__ __forceinline__ void ph_qknorm_rope(const Frame& F0, const float* qkg) {
    const Frame F = launder(F0);
    const int lane = F.lane; const float g1q = qkg[lane] * 0.08838834764831845f, g2q = qkg[64 + lane] * 0.08838834764831845f, g1k = qkg[HD + lane], g2k = qkg[HD + 64 + lane];
    const float inv = exp2f(-(float)(lane & 31) * (13.287712379549449f / 32.0f));
    for (int r = F.gw; r < NR; r += F.NGW) {
        const int b = r / TPB, p = r - b * TPB;
        bf16* qb = F.Q() + (size_t)r * QW; bf16* kb = F.K() + (size_t)r * KVW;
        float x1[20], x2[20];
#pragma unroll
        for (int h = 0; h < 20; ++h) { const bf16* base = h < 16 ? qb + h * HD : kb + (h - 16) * HD; x1[h] = bf2f(base[lane]); x2[h] = bf2f(base[64 + lane]); }
        float cs = 1.f, sn = 0.f;
        if (p >= CTXL) { const int t = p - CTXL; const float pos = (lane < 32) ? (float)(t / GRID_W) : (float)(t % GRID_W); sincosf(pos * inv, &sn, &cs); }
#pragma unroll
        for (int h = 0; h < 20; ++h) {
            const float ss = wave_sum(x1[h] * x1[h] + x2[h] * x2[h]); const float rstd = 1.0f / sqrtf(ss * (1.0f / HD) + NORM_EPS);
            const float a1 = x1[h] * rstd * (h < 16 ? g1q : g1k), a2 = x2[h] * rstd * (h < 16 ? g2q : g2k);
            x1[h] = a1 * cs - a2 * sn; x2[h] = a2 * cs + a1 * sn; }
#pragma unroll
        for (int h = 0; h < 20; ++h) { bf16* base = h < 16 ? qb + h * HD : kb + (h - 16) * HD; base[lane] = (bf16)f2bf(x1[h]); base[64 + lane] = (bf16)f2bf(x2[h]); }
    }
}
template <bool WINDOW>
__device__ __forceinline__ void ph_attn_naive(const Frame& F0, const float* sink) {
    const Frame F = launder(F0);
    const int lane = F.lane;
    for (int it = F.gw; it < NR * NH; it += F.NGW) {
        const int r = it / NH, h = it % NH; const int b = r / TPB, p = r - b * TPB; const int kv = h / 4;
        if (WINDOW && p < CTXL) continue;
        const unsigned qw = *(const unsigned*)(F.Q() + (size_t)r * QW + h * HD + 2 * lane); const float q0 = bf2f(qw & 0xffffu), q1 = bf2f(qw >> 16);
        float m = -1e30f, l = 0.f, o0 = 0.f, o1 = 0.f;
        int lo2, hi2;
        if (p < CTXL) { lo2 = 0; hi2 = 0; } else if (WINDOW) { const int t = p - CTXL; lo2 = CTXL + (t - 128 < 0 ? 0 : t - 128); hi2 = CTXL + (t + 128 > SEQ - 1 ? SEQ - 1 : t + 128) + 1; } else { lo2 = CTXL; hi2 = TPB; }
        for (int seg = 0; seg < 2; ++seg) { const int lo = seg ? lo2 : 0, hi = seg ? hi2 : CTXL;
            for (int kp = lo; kp < hi; ++kp) {
                const size_t kr = (size_t)(b * TPB + kp) * KVW + kv * HD + 2 * lane;
                const unsigned kw = *(const unsigned*)(F.K() + kr), vw = *(const unsigned*)(F.V() + kr);
                const float s = wave_sum(q0 * bf2f(kw & 0xffffu) + q1 * bf2f(kw >> 16));
                const float mn = fmaxf(m, s); const float al = __expf(m - mn), pe = __expf(s - mn);
                l = l * al + pe; o0 = o0 * al + pe * bf2f(vw & 0xffffu); o1 = o1 * al + pe * bf2f(vw >> 16); m = mn;
            } }
        if (WINDOW) { const float sk = sink[h]; const float mn = fmaxf(m, sk); const float al = __expf(m - mn); l = l * al + __expf(sk - mn); o0 *= al; o1 *= al; }
        const float il = 1.0f / l;
        *(unsigned*)(F.O() + (size_t)r * QW + h * HD + 2 * lane) = pk2(o0 * il, o1 * il);
    }
}
namespace att {
using bf16x8 = __attribute__((ext_vector_type(8))) short;
using s16x4  = __attribute__((ext_vector_type(4))) short;
using f32x16 = __attribute__((ext_vector_type(16))) float;
using u32x4v = __attribute__((ext_vector_type(4))) unsigned;
constexpr int QBLK = 32, KVBLK = 64, LDQ = QW, LDK = KVW, LDO = QW, AD = 128;
#ifndef ATT_SDEPTH
#define ATT_SDEPTH 1
#endif
constexpr int SDEPTH = ATT_SDEPTH;
constexpr float THR = 8.f, C = 1.4426950408889634f;
constexpr size_t SHM_V = KVBLK * AD * 2, SHM_K = KVBLK * AD * 2, SHM_ATTN = 2 * SHM_V + 2 * SHM_K + 8 * 64 * 4;
#define KSWZ(row, colB) ((row) * 256 + ((colB) ^ (((row) & 7) << 4)))
#define SBAR() __builtin_amdgcn_sched_barrier(0)
__device__ __forceinline__ int crow(int r, int hi) { return (r & 3) + 8 * (r >> 2) + 4 * hi; }
__device__ __forceinline__ unsigned cvtpk(float lo, float hi) { return pk2(lo, hi); }
__device__ __forceinline__ void partialSM(f32x16& p0, f32x16& p1, float& m_reg, float& mn, float& alpha) {
  float pmax = p0[0]; for (int r = 1; r < 16; ++r) pmax = fmaxf(pmax, p0[r]); for (int r = 0; r < 16; ++r) pmax = fmaxf(pmax, p1[r]);
  { auto rr = __builtin_amdgcn_permlane32_swap(__float_as_uint(pmax), __float_as_uint(pmax), false, false);
    pmax = fmaxf(__uint_as_float(rr[0]), __uint_as_float(rr[1])); }
  if (__builtin_expect(__all(pmax - m_reg <= THR), 1)) { mn = m_reg; alpha = 1.f; }
  else { mn = fmaxf(m_reg, pmax); alpha = __builtin_amdgcn_exp2f((m_reg - mn) * C); m_reg = mn; }
  float mnC = -mn * C;
  for (int r = 0; r < 16; ++r) p0[r] = fmaf(p0[r], C, mnC); for (int r = 0; r < 16; ++r) p1[r] = fmaf(p1[r], C, mnC);
  for (int r = 0; r < 16; ++r) p0[r] = __builtin_amdgcn_exp2f(p0[r]);
}
__device__ __forceinline__ void finishSM(f32x16& p0, f32x16& p1, float alpha, float& l_reg, bf16x8& pa0, bf16x8& pa1, bf16x8& pa2, bf16x8& pa3) {
  for (int r = 0; r < 16; ++r) p1[r] = __builtin_amdgcn_exp2f(p1[r]);
  float ps = 0; for (int r = 0; r < 16; ++r) ps += p0[r]; for (int r = 0; r < 16; ++r) ps += p1[r];
  { auto rr = __builtin_amdgcn_permlane32_swap(__float_as_uint(ps), __float_as_uint(ps), false, false);
    ps = __uint_as_float(rr[0]) + __uint_as_float(rr[1]); }
  l_reg = l_reg * alpha + ps;
#define PK4(P, BASE, OUT) do { unsigned a0 = cvtpk(P[BASE + 0], P[BASE + 1]), a1 = cvtpk(P[BASE + 2], P[BASE + 3]);   \
    unsigned b0 = cvtpk(P[BASE + 4], P[BASE + 5]), b1 = cvtpk(P[BASE + 6], P[BASE + 7]);                              \
    auto r0 = __builtin_amdgcn_permlane32_swap(a0, b0, false, false); auto r1 = __builtin_amdgcn_permlane32_swap(a1, b1, false, false); \
    u32x4v w = {r0[0], r1[0], r0[1], r1[1]}; OUT = *reinterpret_cast<bf16x8*>(&w); } while (0)
  PK4(p0, 0, pa0); PK4(p0, 8, pa1); PK4(p1, 0, pa2); PK4(p1, 8, pa3);
#undef PK4
}
__device__ __forceinline__ void qkt(f32x16& p0, f32x16& p1, const bf16* Ks, const bf16x8* qr, int r32, int hi) {
  p0 = f32x16{}; p1 = f32x16{};
  for (int d0 = 0; d0 < 8; ++d0) { int cb = (d0 * 16 + hi * 8) * 2;
    bf16x8 b0 = *reinterpret_cast<const bf16x8*>((const char*)Ks + KSWZ(r32, cb));
    bf16x8 b1 = *reinterpret_cast<const bf16x8*>((const char*)Ks + KSWZ(32 + r32, cb));
    p0 = __builtin_amdgcn_mfma_f32_32x32x16_bf16(b0, qr[d0], p0, 0, 0, 0);
    p1 = __builtin_amdgcn_mfma_f32_32x32x16_bf16(b1, qr[d0], p1, 0, 0, 0); }
}
__device__ __forceinline__ void band_mask(f32x16& p0, f32x16& p1, int tq, int tk0, int hi) {
#pragma unroll
  for (int r = 0; r < 16; ++r) { const int d = tq - (tk0 + crow(r, hi)); if (d > 128 || d < -128) p0[r] = -1e30f; const int d1 = d - 32; if (d1 > 128 || d1 < -128) p1[r] = -1e30f; }
}
__device__ __forceinline__ int v_st(int k, int c) { const int kk = (k & ~0xC) | ((k & 4) << 1) | ((k & 8) >> 1); return ((kk >> 3) * 4 + (c >> 5)) * 512 + ((kk & 7) * 32 + (c & 31)) * 2; }
__device__ __forceinline__ int v_rd_base(int lane) { return ((lane & 3) << 3) | (((lane >> 2) & 3) << 6) | (((lane >> 4) & 1) << 5) | (((lane >> 5) & 1) << 8); }
constexpr int v_rd_off(int d0, int ks, int half) { return d0 * 512 + ks * 4096 + half * 2048; }
template <int OFF> __device__ __forceinline__ s16x4 tr_read(int vb) {
  s16x4 r; asm volatile("ds_read_b64_tr_b16 %0, %1 offset:%2" : "=&v"(r) : "v"(vb), "i"(OFF) : "memory"); return r;
}
template <int D0> __device__ __forceinline__ void pv_one(f32x16& od, int vb, bf16x8 pa0, bf16x8 pa1, bf16x8 pa2, bf16x8 pa3) {
  const s16x4 l0 = tr_read<v_rd_off(D0, 0, 0)>(vb), h0 = tr_read<v_rd_off(D0, 0, 1)>(vb), l1 = tr_read<v_rd_off(D0, 1, 0)>(vb), h1 = tr_read<v_rd_off(D0, 1, 1)>(vb);
  const s16x4 l2 = tr_read<v_rd_off(D0, 2, 0)>(vb), h2 = tr_read<v_rd_off(D0, 2, 1)>(vb), l3 = tr_read<v_rd_off(D0, 3, 0)>(vb), h3 = tr_read<v_rd_off(D0, 3, 1)>(vb);
  asm volatile("s_waitcnt lgkmcnt(0)" ::: "memory"); SBAR();
#define PK(L, H) (bf16x8){L[0], L[1], L[2], L[3], H[0], H[1], H[2], H[3]}
  od = __builtin_amdgcn_mfma_f32_32x32x16_bf16(pa0, PK(l0, h0), od, 0, 0, 0);
  od = __builtin_amdgcn_mfma_f32_32x32x16_bf16(pa1, PK(l1, h1), od, 0, 0, 0);
  od = __builtin_amdgcn_mfma_f32_32x32x16_bf16(pa2, PK(l2, h2), od, 0, 0, 0);
  od = __builtin_amdgcn_mfma_f32_32x32x16_bf16(pa3, PK(l3, h3), od, 0, 0, 0);
#undef PK
}
__device__ __forceinline__ void pv_d0(f32x16* o, int vb, bf16x8 pa0, bf16x8 pa1, bf16x8 pa2, bf16x8 pa3) {
  pv_one<0>(o[0], vb, pa0, pa1, pa2, pa3); pv_one<1>(o[1], vb, pa0, pa1, pa2, pa3); pv_one<2>(o[2], vb, pa0, pa1, pa2, pa3); pv_one<3>(o[3], vb, pa0, pa1, pa2, pa3);
}
template <bool WINDOW>
__device__ __forceinline__ void attn_body(int tid, const bf16* __restrict__ Qb, const bf16* __restrict__ Kh, const bf16* __restrict__ Vh, bf16* __restrict__ Ob, int NT, int kband, int tkb, int T0, float sink, char* lds) {
  const int wid = tid >> 6, lane = tid & 63, r32 = lane & 31, hi = lane >> 5;
  bf16* V_lds = (bf16*)lds; bf16* K_lds = (bf16*)(lds + 2 * SHM_V);
  float* ws = (float*)(lds + 2 * SHM_V + 2 * SHM_K) + wid * 64; float* li_l = ws; float* al_l = ws + 32;
  float m_reg = -1e30f, l_reg = 0; f32x16 o[4] = {}; bf16x8 qr[8];
  const bf16* Qw = Qb + (long)(wid * QBLK + r32) * LDQ + hi * 8;
#pragma unroll
  for (int d0 = 0; d0 < 8; ++d0) qr[d0] = *reinterpret_cast<const bf16x8*>(Qw + d0 * 16);
  const int sr = tid >> 4, sc = (tid & 15) * 8, vst0 = v_st(sr, sc), vst1 = v_st(32 + sr, sc);
  const int vb0 = (int)(uintptr_t)V_lds + v_rd_base(lane);
  const int tq = T0 + wid * QBLK + r32;
  struct { bf16x8 vs0, vs1, ks0, ks1; } sr_[SDEPTH];
#define KOFF(j) ((j) < 4 ? 64 * (j) : kband + 64 * ((j) - 4))
#define SLOAD(i, jt) do { const int k0_ = KOFF(jt); sr_[i].vs0 = *reinterpret_cast<const bf16x8*>(&Vh[(long)(k0_ + sr) * LDK + sc]); sr_[i].vs1 = *reinterpret_cast<const bf16x8*>(&Vh[(long)(k0_ + 32 + sr) * LDK + sc]); \
    sr_[i].ks0 = *reinterpret_cast<const bf16x8*>(&Kh[(long)(k0_ + sr) * LDK + sc]); sr_[i].ks1 = *reinterpret_cast<const bf16x8*>(&Kh[(long)(k0_ + 32 + sr) * LDK + sc]); } while (0)
#define SWRITE(b, i) do { *(bf16x8*)((char*)V_lds + (b) * SHM_V + vst0) = sr_[i].vs0;          \
    *(bf16x8*)((char*)V_lds + (b) * SHM_V + vst1) = sr_[i].vs1; int kc = sc * 2;               \
    *(bf16x8*)((char*)K_lds + (b) * SHM_K + KSWZ(sr, kc)) = sr_[i].ks0;                       \
    *(bf16x8*)((char*)K_lds + (b) * SHM_K + KSWZ(32 + sr, kc)) = sr_[i].ks1; } while (0)
#define SWAIT() do { if constexpr (SDEPTH == 2) asm volatile("s_waitcnt vmcnt(4)" ::: "memory"); else asm volatile("s_waitcnt vmcnt(0)" ::: "memory"); } while (0)
#define RESC(a) do { if (__any((a) < 1.f)) { if (hi == 0) al_l[r32] = (a); asm volatile("s_waitcnt lgkmcnt(0)" ::: "memory"); \
    for (int d = 0; d < 4; ++d) for (int r = 0; r < 16; ++r) o[d][r] *= al_l[crow(r, hi)]; } } while (0)
#define MASK(P0, P1, jt) do { if (WINDOW && (jt) >= 4) band_mask(P0, P1, tq, tkb + 64 * ((jt) - 4), hi); } while (0)
  f32x16 pA0, pA1, pB0, pB1; float mnA, mnB, alA, alB; bf16x8 pa0, pa1, pa2, pa3;
  constexpr int SE = 0, SO = SDEPTH - 1;
  SLOAD(SE, 0); asm volatile("s_waitcnt vmcnt(0)" ::: "memory"); SWRITE(0, SE); __syncthreads();
  qkt(pA0, pA1, K_lds, qr, r32, hi); partialSM(pA0, pA1, m_reg, mnA, alA);
  SLOAD(SO, 1); if constexpr (SDEPTH == 2) { if (2 < NT) SLOAD(SE, 2); }
  SWAIT(); SWRITE(1, SO); __syncthreads();
  for (int j = 1; j + 1 < NT; j += 2) {
    SBAR(); qkt(pB0, pB1, (bf16*)((char*)K_lds + SHM_K), qr, r32, hi); MASK(pB0, pB1, j);
    finishSM(pA0, pA1, alA, l_reg, pa0, pa1, pa2, pa3); SBAR();
    SLOAD(SO, j + SDEPTH); SBAR();
    pv_d0(o, vb0, pa0, pa1, pa2, pa3); partialSM(pB0, pB1, m_reg, mnB, alB);
    __syncthreads(); SWAIT(); SWRITE(0, SE);
    RESC(alB); __syncthreads();
    SBAR(); qkt(pA0, pA1, K_lds, qr, r32, hi); MASK(pA0, pA1, j + 1);
    finishSM(pB0, pB1, alB, l_reg, pa0, pa1, pa2, pa3); SBAR();
    if (SDEPTH == 1 || j + 3 < NT) SLOAD(SE, j + 1 + SDEPTH); SBAR();
    pv_d0(o, vb0 + (int)SHM_V, pa0, pa1, pa2, pa3); partialSM(pA0, pA1, m_reg, mnA, alA);
    __syncthreads(); SWAIT(); SWRITE(1, SO);
    RESC(alA); __syncthreads();
  }
  SBAR(); qkt(pB0, pB1, (bf16*)((char*)K_lds + SHM_K), qr, r32, hi); MASK(pB0, pB1, NT - 1);
  finishSM(pA0, pA1, alA, l_reg, pa0, pa1, pa2, pa3); SBAR();
  pv_d0(o, vb0, pa0, pa1, pa2, pa3); partialSM(pB0, pB1, m_reg, mnB, alB);
  __syncthreads(); RESC(alB);
  finishSM(pB0, pB1, alB, l_reg, pa0, pa1, pa2, pa3); SBAR();
  pv_d0(o, vb0 + (int)SHM_V, pa0, pa1, pa2, pa3);
  if (WINDOW) l_reg += __builtin_amdgcn_exp2f((sink - m_reg) * C);
  if (hi == 0) li_l[r32] = l_reg; asm volatile("s_waitcnt lgkmcnt(0)" ::: "memory");
  float rli[16];
#pragma unroll
  for (int r = 0; r < 16; ++r) rli[r] = __builtin_amdgcn_rcpf(li_l[crow(r, hi)]);
  bf16* Ow = Ob + (long)(wid * QBLK) * LDO;
#pragma unroll
  for (int r = 0; r < 16; ++r) { int orow = crow(r, hi);
    for (int d0 = 0; d0 < 4; ++d0) Ow[(long)orow * LDO + d0 * 32 + r32] = (bf16)f2bf(o[d0][r] * rli[r]); }
#undef KOFF
#undef SLOAD
#undef SWRITE
#undef SWAIT
#undef RESC
#undef MASK
}

constexpr int ML_QI = 0, ML_KI = 16384, ML_KV = 32768, ML_VV = 49152, ML_WV = 65536, ML_CI = 81920, ML_CIB = 24576, ML_SC = 132096;
template <bool MAX> __device__ __forceinline__ float dpp_scan(float v) {
    constexpr int idn = MAX ? (int)0xff800000 : 0;
#define DPP_STEP(ctrl, rmask) { const float t_ = __int_as_float(__builtin_amdgcn_update_dpp(idn, __float_as_int(v), ctrl, rmask, 0xf, false)); v = MAX ? fmaxf(v, t_) : v + t_; }
    DPP_STEP(0x111, 0xf) DPP_STEP(0x112, 0xf) DPP_STEP(0x114, 0xf) DPP_STEP(0x118, 0xf) DPP_STEP(0x142, 0xa) DPP_STEP(0x143, 0xc)
#undef DPP_STEP
    return v;
}
__device__ __forceinline__ void mlstm_scalars(float ig, float fg, float& m_prev, float* sc, int lane) {
    const float logf = fminf(fg, 0.f) - log1pf(__expf(-fabsf(fg)));
    const float bc = dpp_scan<false>(logf);
    const float b_end = __int_as_float(__builtin_amdgcn_readlane(__float_as_int(bc), 63));
    const float beta = ig - bc; const float wl = b_end + beta;
    const float pm = dpp_scan<true>(beta);
    const float mxall = b_end + __int_as_float(__builtin_amdgcn_readlane(__float_as_int(pm), 63));
    const float m_new = fmaxf(b_end + m_prev, mxall);
    const float m_t = bc + fmaxf(pm, m_prev);
    sc[lane] = bc - m_t - 2.4260151319598084f;
    sc[64 + lane] = beta;
    sc[128 + lane] = 0.08838834764831845f * __expf(bc + m_prev - m_t);
    sc[192 + lane] = __expf(wl - m_new);
    sc[256 + lane] = __expf(-m_t);
    if (lane == 0) sc[320] = __expf(b_end + m_prev - m_new);
    m_prev = m_new;
}
__device__ __forceinline__ void ph_mlstm_body(int tid, const bf16* __restrict__ QKVO_, const float* __restrict__ gates, float* __restrict__ HD_, int b, int hh, int dr, int vq, char* lds) {
    const int wid = __builtin_amdgcn_readfirstlane(tid >> 6), lane = tid & 63;
    float* scal = (float*)(lds + ML_SC);
    for (int i = tid; i < 2 * ML_CIB / 16; i += 512) *(u32x4v*)(lds + ML_CI + i * 16) = (u32x4v){0u, 0u, 0u, 0u};
    float m_prev = 0.f;
    const int gcol = dr * 16 + hh;
    const size_t bq = (size_t)hh * MDQK, bk = (size_t)MQKW + hh * MDQK, bv = (size_t)2 * MQKW + hh * MDV + vq * 64;
#define ML_ROWBASE(c) (dr == 0 ? 64 * (c) : ((c) < 4 ? 255 - 64 * (c) : 2303 - 64 * ((c) - 4)))
    const int sg = dr == 0 ? 1 : -1;
    float ig_n = 0.f, fg_n = 0.f;
#define ML_GLOAD(c) do { const size_t r_ = (size_t)(b * TPB + ML_ROWBASE(c) + sg * lane); ig_n = gates[r_ * 32 + gcol]; fg_n = gates[r_ * 32 + gcol + 8]; } while (0)
    if (wid == 7) { ML_GLOAD(0); mlstm_scalars(ig_n, fg_n, m_prev, scal, lane); ML_GLOAD(1); }
    const int sr = tid >> 4, scq = (tid & 15) * 8, vr = tid >> 3, vc = (tid & 7) * 8;
    bf16x8 gq0, gq1, gk0, gk1, gv;
#define ML_LOAD(c) do { const int rb_ = b * TPB + ML_ROWBASE(c); const bf16* r0_ = QKVO_ + (size_t)(rb_ + sg * sr) * MINW; const bf16* r1_ = QKVO_ + (size_t)(rb_ + sg * (32 + sr)) * MINW; const bf16* rv_ = QKVO_ + (size_t)(rb_ + sg * vr) * MINW; \
    gq0 = *(const bf16x8*)(r0_ + bq + scq); gq1 = *(const bf16x8*)(r1_ + bq + scq); gk0 = *(const bf16x8*)(r0_ + bk + scq); gk1 = *(const bf16x8*)(r1_ + bk + scq); gv = *(const bf16x8*)(rv_ + bv + vc); } while (0)
    ML_LOAD(0);
    f32x16 acc0 = {}, acc1 = {}, acc2 = {};
    const int kt = wid - 4;
    const int vbK = (int)(uintptr_t)(lds + ML_KV) + v_rd_base(lane), vbV = (int)(uintptr_t)(lds + ML_VV) + v_rd_base(lane), vbW = (int)(uintptr_t)(lds + ML_WV) + v_rd_base(lane);
    __syncthreads();
    constexpr int NCH = TPB / 64;
#pragma unroll 1
    for (int c = 0; c < NCH; ++c) {
        int lane_c = lane; asm volatile("" : "+v"(lane_c));
        const int r32 = lane_c & 31, hi = lane_c >> 5;
        const float* sc = scal + (c & 1) * 384; float* scn = scal + ((c + 1) & 1) * 384;
        char* CIcur = lds + ML_CI + (c & 1) * ML_CIB; char* CInext = lds + ML_CI + ((c + 1) & 1) * ML_CIB;
        asm volatile("s_waitcnt vmcnt(0)" ::: "memory");
        *(bf16x8*)(lds + ML_QI + KSWZ(sr, scq * 2)) = gq0; *(bf16x8*)(lds + ML_QI + KSWZ(32 + sr, scq * 2)) = gq1;
        *(bf16x8*)(lds + ML_KI + KSWZ(sr, scq * 2)) = gk0; *(bf16x8*)(lds + ML_KI + KSWZ(32 + sr, scq * 2)) = gk1;
        *(bf16x8*)(lds + ML_KV + v_st(sr, scq)) = gk0; *(bf16x8*)(lds + ML_KV + v_st(32 + sr, scq)) = gk1;
        *(bf16x8*)(lds + ML_VV + v_st(vr, vc)) = gv;
        { const float w = sc[192 + vr]; u32x4v gw = *reinterpret_cast<u32x4v*>(&gv), o;
          o.x = cvtpk(w * bf2f(gw.x & 0xffffu), w * bf2f(gw.x >> 16)); o.y = cvtpk(w * bf2f(gw.y & 0xffffu), w * bf2f(gw.y >> 16)); o.z = cvtpk(w * bf2f(gw.z & 0xffffu), w * bf2f(gw.z >> 16)); o.w = cvtpk(w * bf2f(gw.w & 0xffffu), w * bf2f(gw.w >> 16));
          *(u32x4v*)(lds + ML_WV + v_st(vr, vc)) = o; }
        if (tid < 64) *(bf16*)(lds + ML_WV + v_st(tid, 64)) = (bf16)f2bf(sc[192 + tid]);
        __syncthreads();
        if (c + 1 < NCH) ML_LOAD(c + 1);
        f32x16 o_in = {}, o_x = {}; int tt = 0, vt = 0;
        if (wid < 4) {
            tt = wid >> 1; vt = wid & 1;
            bf16x8 qr[8];
#pragma unroll
            for (int d0 = 0; d0 < 8; ++d0) qr[d0] = *reinterpret_cast<const bf16x8*>(lds + ML_QI + KSWZ(32 * tt + r32, (d0 * 16 + hi * 8) * 2));
            f32x16 p0, p1; qkt(p0, p1, (const bf16*)(lds + ML_KI), qr, r32, hi);
            const int t = 32 * tt + r32; const float al = sc[t];
#pragma unroll
            for (int r = 0; r < 16; ++r) { const int s0 = crow(r, hi); const float e0 = __expf(al + sc[64 + s0]), e1 = __expf(al + sc[64 + 32 + s0]);
                p0[r] = s0 <= t ? p0[r] * e0 : 0.f; p1[r] = s0 + 32 <= t ? p1[r] * e1 : 0.f; }
            float ds = 0.f;
#pragma unroll
            for (int r = 0; r < 16; ++r) ds += p0[r] + p1[r];
            { auto rr = __builtin_amdgcn_permlane32_swap(__float_as_uint(ds), __float_as_uint(ds), false, false); ds = __uint_as_float(rr[0]) + __uint_as_float(rr[1]); }
            if (vt == 0 && hi == 0) scal[768 + t] = ds;
            bf16x8 pa0, pa1, pa2, pa3;
#define PK4(P, BASE, OUT) do { unsigned a0 = cvtpk(P[BASE + 0], P[BASE + 1]), a1 = cvtpk(P[BASE + 2], P[BASE + 3]);   \
    unsigned b0 = cvtpk(P[BASE + 4], P[BASE + 5]), b1 = cvtpk(P[BASE + 6], P[BASE + 7]);                              \
    auto r0 = __builtin_amdgcn_permlane32_swap(a0, b0, false, false); auto r1 = __builtin_amdgcn_permlane32_swap(a1, b1, false, false); \
    u32x4v w = {r0[0], r1[0], r0[1], r1[1]}; OUT = *reinterpret_cast<bf16x8*>(&w); } while (0)
            PK4(p0, 0, pa0); PK4(p0, 8, pa1); PK4(p1, 0, pa2); PK4(p1, 8, pa3);
#undef PK4
            if (vt == 0) pv_one<0>(o_in, vbV, pa0, pa1, pa2, pa3); else pv_one<1>(o_in, vbV, pa0, pa1, pa2, pa3);
#pragma unroll
            for (int d0 = 0; d0 < 8; ++d0) { const bf16x8 cf = *reinterpret_cast<const bf16x8*>(CIcur + KSWZ(32 * vt + r32, (d0 * 16 + hi * 8) * 2)); o_x = __builtin_amdgcn_mfma_f32_32x32x16_bf16(qr[d0], cf, o_x, 0, 0, 0); }
        } else {
            const float decay = sc[320];
#pragma unroll
            for (int r = 0; r < 16; ++r) { acc0[r] *= decay; acc1[r] *= decay; acc2[r] *= decay; }
#pragma unroll
            for (int ks = 0; ks < 4; ++ks) {
                s16x4 al_, ah_, b0l, b0h, b1l, b1h, b2l, b2h; const int ka = vbK + kt * 512 + ks * 4096, wa = vbW + ks * 4096;
                asm volatile("ds_read_b64_tr_b16 %0, %1" : "=&v"(al_) : "v"(ka) : "memory"); asm volatile("ds_read_b64_tr_b16 %0, %1 offset:2048" : "=&v"(ah_) : "v"(ka) : "memory");
                asm volatile("ds_read_b64_tr_b16 %0, %1" : "=&v"(b0l) : "v"(wa) : "memory"); asm volatile("ds_read_b64_tr_b16 %0, %1 offset:2048" : "=&v"(b0h) : "v"(wa) : "memory");
                asm volatile("ds_read_b64_tr_b16 %0, %1 offset:512" : "=&v"(b1l) : "v"(wa) : "memory"); asm volatile("ds_read_b64_tr_b16 %0, %1 offset:2560" : "=&v"(b1h) : "v"(wa) : "memory");
                asm volatile("ds_read_b64_tr_b16 %0, %1 offset:1024" : "=&v"(b2l) : "v"(wa) : "memory"); asm volatile("ds_read_b64_tr_b16 %0, %1 offset:3072" : "=&v"(b2h) : "v"(wa) : "memory");
                asm volatile("s_waitcnt lgkmcnt(0)" ::: "memory"); SBAR();
#define PK(L, H) (bf16x8){L[0], L[1], L[2], L[3], H[0], H[1], H[2], H[3]}
                const bf16x8 af = PK(al_, ah_);
                acc0 = __builtin_amdgcn_mfma_f32_32x32x16_bf16(af, PK(b0l, b0h), acc0, 0, 0, 0);
                acc1 = __builtin_amdgcn_mfma_f32_32x32x16_bf16(af, PK(b1l, b1h), acc1, 0, 0, 0);
                acc2 = __builtin_amdgcn_mfma_f32_32x32x16_bf16(af, PK(b2l, b2h), acc2, 0, 0, 0);
#undef PK
            }
#pragma unroll
            for (int q = 0; q < 4; ++q) { const int cb = (32 * kt + 8 * q + 4 * hi) * 2;
                u32x2 w0; w0.x = cvtpk(acc0[4 * q], acc0[4 * q + 1]); w0.y = cvtpk(acc0[4 * q + 2], acc0[4 * q + 3]); *(u32x2*)(CInext + KSWZ(r32, cb)) = w0;
                u32x2 w1; w1.x = cvtpk(acc1[4 * q], acc1[4 * q + 1]); w1.y = cvtpk(acc1[4 * q + 2], acc1[4 * q + 3]); *(u32x2*)(CInext + KSWZ(32 + r32, cb)) = w1;
                if (r32 == 0) { u32x2 w2; w2.x = cvtpk(acc2[4 * q], acc2[4 * q + 1]); w2.y = cvtpk(acc2[4 * q + 2], acc2[4 * q + 3]); *(u32x2*)(CInext + KSWZ(64, cb)) = w2; } }
            if (wid < 6) {
                const int t2 = wid - 4; f32x16 o_n = {};
#pragma unroll
                for (int d0 = 0; d0 < 8; ++d0) { const bf16x8 qf = *reinterpret_cast<const bf16x8*>(lds + ML_QI + KSWZ(32 * t2 + r32, (d0 * 16 + hi * 8) * 2));
                    const bf16x8 cf = *reinterpret_cast<const bf16x8*>(CIcur + KSWZ(64 + r32, (d0 * 16 + hi * 8) * 2)); o_n = __builtin_amdgcn_mfma_f32_32x32x16_bf16(qf, cf, o_n, 0, 0, 0); }
                if (r32 == 0) {
#pragma unroll
                    for (int r = 0; r < 16; ++r) scal[832 + 32 * t2 + crow(r, hi)] = o_n[r]; }
            }
            if (wid == 7 && c + 1 < NCH) { const float ig_c = ig_n, fg_c = fg_n; if (c + 2 < NCH) ML_GLOAD(c + 2); mlstm_scalars(ig_c, fg_c, m_prev, scn, lane); }
        }
        __syncthreads();
        if (wid < 4) {
            const int rb = b * TPB + ML_ROWBASE(c);
#pragma unroll
            for (int r = 0; r < 16; ++r) { const int t = 32 * tt + crow(r, hi); const float ai = sc[128 + t];
                const float dn = fmaxf(fabsf(scal[768 + t] + ai * scal[832 + t]), sc[256 + t]);
                HD_[(size_t)(rb + sg * t) * D + hh * MDV + vq * 64 + 32 * vt + r32] = (o_in[r] + ai * o_x[r]) / dn; }
        }
    }
#undef ML_LOAD
#undef ML_GLOAD
#undef ML_ROWBASE
    __syncthreads();
}

constexpr int S5_IMG = 8192;
__device__ __forceinline__ int s5_st(int k, int t) { const int k6 = k & 63; const int kk = (k6 & ~0xC) | ((k6 & 4) << 1) | ((k6 & 8) >> 1); return (k >> 6) * 4096 + (kk >> 3) * 512 + ((kk & 7) * 32 + t) * 2; }
__device__ __forceinline__ void s5_disc(const float* lre, const float* lim, float dt, int n, float& ar, float& ai, float& kr, float& ki) {
    const float lr = fminf(lre[n], -1e-4f), li = lim[n]; const float mag = expf(lr * dt); float sn, cs; sincosf(li * dt, &sn, &cs); ar = mag * cs; ai = mag * sn;
    const float den = lr * lr + li * li; kr = ((ar - 1.f) * lr + ai * li) / den; ki = (ai * lr - (ar - 1.f) * li) / den;
}
__device__ __forceinline__ void s5_task(int lane, const float* const* in, const bf16* __restrict__ Hb, float* __restrict__ out, int b, int g, int dr, char* img) {
    const int r32 = lane & 31, hi = lane >> 5; const size_t pg = (size_t)(dr * S5G + g);
    const float dt = expf(in[IN_S5LDT][pg]); const float* lre = in[IN_S5LRE] + pg * S5N; const float* lim = in[IN_S5LIM] + pg * S5N;
    float ar, ai, kr_o, ki_o, ar2, ai2, kr_p, ki_p;
    s5_disc(lre, lim, dt, lane, ar, ai, kr_o, ki_o);
    float kr0, ki0, kr1, ki1;
    s5_disc(lre, lim, dt, r32, ar2, ai2, kr0, ki0); s5_disc(lre, lim, dt, 32 + r32, ar2, ai2, kr1, ki1); (void)kr_o; (void)ki_o; (void)kr_p; (void)ki_p;
    bf16x8 Bf[4];
#pragma unroll
    for (int q = 0; q < 4; ++q) { const int n = (q & 1) * 32 + r32; const float kr = (q & 1) ? kr1 : kr0, ki = (q & 1) ? ki1 : ki0;
        const float* bre = in[IN_S5BRE] + (pg * S5N + n) * 16 + 8 * hi; const float* bim = in[IN_S5BIM] + (pg * S5N + n) * 16 + 8 * hi; u32x4v w;
        float v[8];
#pragma unroll
        for (int j = 0; j < 8; ++j) v[j] = (q < 2) ? (kr * bre[j] - ki * bim[j]) : (kr * bim[j] + ki * bre[j]);
        w.x = cvtpk(v[0], v[1]); w.y = cvtpk(v[2], v[3]); w.z = cvtpk(v[4], v[5]); w.w = cvtpk(v[6], v[7]); Bf[q] = *reinterpret_cast<bf16x8*>(&w); }
    bf16x8 Cf[8];
#pragma unroll
    for (int kb = 0; kb < 8; ++kb) { u32x4v w = {0u, 0u, 0u, 0u};
        if (r32 < 16) { const int k0 = 16 * kb + 8 * hi; const float* cp = (k0 < 64 ? in[IN_S5CRE] : in[IN_S5CIM]) + (pg * 16 + r32) * S5N + (k0 & 63); const float sgn = k0 < 64 ? 1.f : -1.f;
            w.x = cvtpk(sgn * cp[0], sgn * cp[1]); w.y = cvtpk(sgn * cp[2], sgn * cp[3]); w.z = cvtpk(sgn * cp[4], sgn * cp[5]); w.w = cvtpk(sgn * cp[6], sgn * cp[7]); }
        Cf[kb] = *reinterpret_cast<bf16x8*>(&w); }
    float xr = 0.f, xi = 0.f;
    const int vb = (int)(uintptr_t)img + v_rd_base(lane);
#define S5_ROW(s) (dr == 0 ? (s) : ((s) < CTXL ? CTXL - 1 - (s) : TPB - 1 - ((s) - CTXL)))
    bf16x8 uf = *reinterpret_cast<const bf16x8*>(Hb + ((size_t)b * TPB + S5_ROW(r32)) * D + 16 * g + 8 * hi);
#pragma unroll 1
    for (int blk = 0; blk < TPB / 32; ++blk) {
        const bf16x8 ucur = uf;
        if (blk + 1 < TPB / 32) uf = *reinterpret_cast<const bf16x8*>(Hb + ((size_t)b * TPB + S5_ROW(32 * (blk + 1) + r32)) * D + 16 * g + 8 * hi);
        f32x16 d0 = {}, d1 = {}, d2 = {}, d3 = {};
        d0 = __builtin_amdgcn_mfma_f32_32x32x16_bf16(ucur, Bf[0], d0, 0, 0, 0); d1 = __builtin_amdgcn_mfma_f32_32x32x16_bf16(ucur, Bf[1], d1, 0, 0, 0);
        d2 = __builtin_amdgcn_mfma_f32_32x32x16_bf16(ucur, Bf[2], d2, 0, 0, 0); d3 = __builtin_amdgcn_mfma_f32_32x32x16_bf16(ucur, Bf[3], d3, 0, 0, 0);
#pragma unroll
        for (int r = 0; r < 16; ++r) { auto s0 = __builtin_amdgcn_permlane32_swap(__float_as_uint(d0[r]), __float_as_uint(d1[r]), false, false); d0[r] = __uint_as_float(s0[0]); d1[r] = __uint_as_float(s0[1]);
            auto s1 = __builtin_amdgcn_permlane32_swap(__float_as_uint(d2[r]), __float_as_uint(d3[r]), false, false); d2[r] = __uint_as_float(s1[0]); d3[r] = __uint_as_float(s1[1]); }
        unsigned pre[16], pim[16]; float lr_ = 0.f, li_ = 0.f;
#pragma unroll
        for (int t = 0; t < 32; ++t) { const int odd = (t >> 2) & 1, tt = odd ? t - 4 : t, r = (tt & 3) + 4 * (tt >> 3);
            const float br = odd ? d1[r] : d0[r], bi = odd ? d3[r] : d2[r];
            const float nr = fmaf(ar, xr, fmaf(-ai, xi, br)), ni = fmaf(ar, xi, fmaf(ai, xr, bi)); xr = nr; xi = ni;
            if (t & 1) { pre[t >> 1] = cvtpk(lr_, xr); pim[t >> 1] = cvtpk(li_, xi); } else { lr_ = xr; li_ = xi; } }
#pragma unroll
        for (int j = 0; j < 4; ++j) { *(u32x4v*)(img + s5_st(lane, 8 * j)) = (u32x4v){pre[4 * j], pre[4 * j + 1], pre[4 * j + 2], pre[4 * j + 3]};
            *(u32x4v*)(img + s5_st(64 + lane, 8 * j)) = (u32x4v){pim[4 * j], pim[4 * j + 1], pim[4 * j + 2], pim[4 * j + 3]}; }
        asm volatile("s_waitcnt lgkmcnt(0)" ::: "memory");
        f32x16 y = {};
#define S5_TR(KB, L, H) const s16x4 L = tr_read<((KB) >> 2) * 4096 + ((KB) & 3) * 1024>(vb), H = tr_read<((KB) >> 2) * 4096 + ((KB) & 3) * 1024 + 512>(vb)
        S5_TR(0, l0, h0); S5_TR(1, l1, h1); S5_TR(2, l2, h2); S5_TR(3, l3, h3); S5_TR(4, l4, h4); S5_TR(5, l5, h5); S5_TR(6, l6, h6); S5_TR(7, l7, h7);
        asm volatile("s_waitcnt lgkmcnt(0)" ::: "memory"); SBAR();
#define S5_MM(KB, L, H) y = __builtin_amdgcn_mfma_f32_32x32x16_bf16((bf16x8){L[0], L[1], L[2], L[3], H[0], H[1], H[2], H[3]}, Cf[KB], y, 0, 0, 0)
        S5_MM(0, l0, h0); S5_MM(1, l1, h1); S5_MM(2, l2, h2); S5_MM(3, l3, h3); S5_MM(4, l4, h4); S5_MM(5, l5, h5); S5_MM(6, l6, h6); S5_MM(7, l7, h7);
#undef S5_TR
#undef S5_MM
        if (r32 < 16) {
#pragma unroll
            for (int r = 0; r < 16; ++r) out[((size_t)b * TPB + S5_ROW(32 * blk + crow(r, hi))) * D + 16 * g + r32] = y[r]; }
    }
#undef S5_ROW
}
#undef KSWZ
#undef SBAR
}

template <bool WINDOW>
__device__ __forceinline__ void ph_attn_fast(const Frame& F0, const float* sinkp) {
    const Frame F = launder(F0);
    const int bx = blockIdx.x; const int vcu = (F.G % 8 == 0) ? (bx % 8) * (F.G / 8) + bx / 8 : bx;
    const int nlat = NB * NH * 8, nslots = nlat / 2 + (WINDOW ? 0 : NB * NH);
    for (int slot = vcu; slot < nslots; slot += F.G) {
#pragma unroll 1
        for (int k = 0; k < 2; ++k) {
            int u = slot < nlat / 2 ? 2 * slot + k : nlat + (slot - nlat / 2);
            if (slot >= nlat / 2 && k == 1) continue;
            int b, h, qb;
            if (u < nlat) { const int grp = u / 32, w = u % 32; b = grp / NKV; h = (grp % NKV) * 4 + w / 8; qb = 1 + w % 8; } else { const int c = u - nlat; b = c / NH; h = c % NH; qb = 0; }
            const int kv = h / 4; const size_t row0 = (size_t)b * TPB + qb * 256;
            const bf16* Qb = F.Q() + row0 * QW + h * HD; const bf16* Kh = F.K() + (size_t)b * TPB * KVW + kv * HD; const bf16* Vh = F.V() + (size_t)b * TPB * KVW + kv * HD; bf16* Ob = F.O() + row0 * QW + h * HD;
            int NT, kband = CTXL, tkb = 0, T0 = 0; float sk = 0.f;
            if (WINDOW) { T0 = (qb - 1) * 256; const int ks = T0 - 128 < 0 ? 0 : T0 - 128, ke = T0 + 384 > SEQ ? SEQ : T0 + 384; NT = 4 + (ke - ks) / 64; kband = CTXL + ks; tkb = ks; sk = sinkp[h]; }
            else NT = qb == 0 ? 4 : TPB / 64;
            att::attn_body<WINDOW>(F.tid, Qb, Kh, Vh, Ob, NT, kband, tkb, T0, sk, (char*)(unsigned char*)F.lds);
            __syncthreads();
        }
    }
}

__device__ __forceinline__ void ph_s5_naive(const Frame& F0) {
    const Frame F = launder(F0);
    const int n = F.lane;
    for (int it = F.gw; it < NB * S5G * 2; it += F.NGW) {
        const int dr = it & 1, g = (it >> 1) % S5G, b = it / (2 * S5G);
        const size_t pg = (size_t)(dr * S5G + g);
        const float lr = fminf(F.in[IN_S5LRE][pg * S5N + n], -1e-4f), li = F.in[IN_S5LIM][pg * S5N + n], dt = expf(F.in[IN_S5LDT][pg]);
        const float mag = expf(lr * dt); float sn, cs; sincosf(li * dt, &sn, &cs); const float ar = mag * cs, ai = mag * sn;
        const float den = lr * lr + li * li; const float kr = ((ar - 1.f) * lr + ai * li) / den, ki = (ai * lr - (ar - 1.f) * li) / den;
        float bre[16], bim[16], cre[16], cim[16];
#pragma unroll
        for (int c = 0; c < 16; ++c) { const float br_ = F.in[IN_S5BRE][(pg * S5N + n) * 16 + c], bi_ = F.in[IN_S5BIM][(pg * S5N + n) * 16 + c];
            bre[c] = kr * br_ - ki * bi_; bim[c] = kr * bi_ + ki * br_;
            cre[c] = F.in[IN_S5CRE][(pg * 16 + c) * S5N + n]; cim[c] = F.in[IN_S5CIM][(pg * 16 + c) * S5N + n]; }
        float xr = 0.f, xi = 0.f;
        float* out = F.HDb() + (size_t)dr * NR * D;
        for (int s = 0; s < TPB; ++s) {
            int p; if (dr == 0) p = s; else p = s < CTXL ? CTXL - 1 - s : TPB - 1 - (s - CTXL);
            const size_t r = (size_t)b * TPB + p;
            const u32x4 u0 = *(const u32x4*)(F.H() + r * D + 16 * g), u1 = *(const u32x4*)(F.H() + r * D + 16 * g + 8);
            float u[16]; u[0] = bf2f(u0.x & 0xffffu); u[1] = bf2f(u0.x >> 16); u[2] = bf2f(u0.y & 0xffffu); u[3] = bf2f(u0.y >> 16); u[4] = bf2f(u0.z & 0xffffu); u[5] = bf2f(u0.z >> 16); u[6] = bf2f(u0.w & 0xffffu); u[7] = bf2f(u0.w >> 16);
            u[8] = bf2f(u1.x & 0xffffu); u[9] = bf2f(u1.x >> 16); u[10] = bf2f(u1.y & 0xffffu); u[11] = bf2f(u1.y >> 16); u[12] = bf2f(u1.z & 0xffffu); u[13] = bf2f(u1.z >> 16); u[14] = bf2f(u1.w & 0xffffu); u[15] = bf2f(u1.w >> 16);
            float br = 0.f, bi = 0.f;
#pragma unroll
            for (int c = 0; c < 16; ++c) { br += bre[c] * u[c]; bi += bim[c] * u[c]; }
            const float nr = ar * xr - ai * xi + br, ni = ar * xi + ai * xr + bi; xr = nr; xi = ni;
            float mine = 0.f;
#pragma unroll
            for (int c = 0; c < 16; ++c) { const float y = wave_sum(xr * cre[c] - xi * cim[c]); if (n == c) mine = y; }
            if (n < 16) out[r * D + 16 * g + n] = mine;
        }
    }
}
__device__ __forceinline__ void ph_s5_fast(const Frame& F0) {
    const Frame F = launder(F0);
    if (F.wave < 4) {
        for (int task = blockIdx.x * 4 + F.wave; task < NB * 2 * S5G; task += F.G * 4) {
            const int g = task % S5G, dr = (task / S5G) & 1, b = task / (2 * S5G);
            att::s5_task(F.lane, F.in, F.H(), F.HDb() + (size_t)dr * NR * D, b, g, dr, (char*)(unsigned char*)F.lds + F.wave * att::S5_IMG);
        }
    }
}
__device__ __forceinline__ void ph_s5_combine(const Frame& F0) {
    const Frame F = launder(F0);
    const size_t n4 = (size_t)NR * D / 4, stride = (size_t)F.G * NTHREADS; const f32x4* yf = (const f32x4*)F.HDb(); const f32x4* yb = (const f32x4*)(F.HDb() + (size_t)NR * D);
    for (size_t i0 = (size_t)blockIdx.x * NTHREADS + F.tid; i0 < n4; i0 += 4 * stride) {
        f32x4 dsk[4], f[4], bb[4]; u32x2 hw[4];
#pragma unroll
        for (int k = 0; k < 4; ++k) { const size_t i = i0 + k * stride; dsk[k] = ((const f32x4*)F.in[IN_S5D])[(int)(i % (D / 4))]; hw[k] = ((const u32x2*)F.H())[i]; f[k] = yf[i]; bb[k] = yb[i]; }
#pragma unroll
        for (int k = 0; k < 4; ++k) { const size_t i = i0 + k * stride; f32x4 h; h.x = bf2f(hw[k].x & 0xffffu); h.y = bf2f(hw[k].x >> 16); h.z = bf2f(hw[k].y & 0xffffu); h.w = bf2f(hw[k].y >> 16);
            const f32x4 y = dsk[k] * h + f[k] + bb[k];
            u32x2 w; w.x = pk2(gelu_tanh_f(y.x), gelu_tanh_f(y.y)); w.y = pk2(gelu_tanh_f(y.z), gelu_tanh_f(y.w)); ((u32x2*)F.O())[i] = w; }
    }
}
__device__ __forceinline__ void ph_mlstm_naive(const Frame& F0) {
    const Frame F = launder(F0);
    LAS float* sk = (LAS float*)F.lds; LAS float* sq = sk + 128; LAS float* sn = sq + 128; LAS float* spart = sn + 128; LAS float* snq = spart + 512;
    const int tid = F.tid, v = tid & 255, kh = tid >> 8;
    for (int it = blockIdx.x; it < NB * MH * 2; it += F.G) {
        const int dr = it & 1, hh = (it >> 1) % MH, b = it / (2 * MH);
        float C[64];
#pragma unroll
        for (int i = 0; i < 64; ++i) C[i] = 0.f;
        if (tid < 128) sn[tid] = 0.f;
        float m = 0.f;
        float* out = F.HDb() + (size_t)dr * NR * D;
        __syncthreads();
        for (int s = 0; s < TPB; ++s) {
            int p; if (dr == 0) p = s; else p = s < CTXL ? CTXL - 1 - s : TPB - 1 - (s - CTXL);
            const size_t r = (size_t)b * TPB + p; const bf16* row = F.QKVO() + r * MINW;
            const float ig = F.GATES()[r * 32 + dr * 16 + hh], fg = F.GATES()[r * 32 + dr * 16 + 8 + hh];
            const float logf = fminf(fg, 0.f) - log1pf(expf(-fabsf(fg)));
            const float mn = fmaxf(logf + m, ig); const float fp = expf(logf + m - mn), ip = expf(ig - mn); m = mn;
            const float vv = bf2f(row[2 * MQKW + hh * MDV + v]);
            if (tid < 128) { const float kk = bf2f(row[MQKW + hh * MDQK + tid]) * 0.08838834764831845f, qq = bf2f(row[hh * MDQK + tid]); sk[tid] = kk; sq[tid] = qq;
                const float nn = fp * sn[tid] + ip * kk; sn[tid] = nn; const float pq = wave_sum(nn * qq); if (F.lane == 0) snq[tid >> 6] = pq; }
            __syncthreads();
            float part = 0.f; const float iv = ip * vv;
#pragma unroll
            for (int i = 0; i < 64; ++i) { C[i] = fp * C[i] + iv * sk[kh * 64 + i]; part += C[i] * sq[kh * 64 + i]; }
            spart[kh * 256 + v] = part;
            __syncthreads();
            if (tid < 256) { const float num = spart[v] + spart[256 + v]; const float nq = snq[0] + snq[1]; const float dn = fmaxf(fabsf(nq), expf(-m)); out[r * D + hh * MDV + v] = num / dn; }
            __syncthreads();
        }
    }
}
__device__ __forceinline__ void ph_mlstm_fast(const Frame& F0) {
    const Frame F = launder(F0);
    for (int u = blockIdx.x; u < NB * MH * 2 * 4; u += F.G) {
        const int vq = u & 3, dr = (u >> 2) & 1, hh = (u >> 3) % MH, b = u / (8 * MH);
        att::ph_mlstm_body(F.tid, F.QKVO(), F.GATES(), F.HDb() + (size_t)dr * NR * D, b, hh, dr, vq, (char*)(unsigned char*)F.lds);
    }
}
__device__ __forceinline__ void ph_mlstm_readout(const Frame& F0) {
    const Frame F = launder(F0);
    const int lane = F.lane; const float* h0 = F.HDb(); const float* h1 = F.HDb() + (size_t)NR * D; const float* ng = F.in[IN_MNORMG];
    for (int r = F.gw; r < NR; r += F.NGW) {
        f32x4 a[MH], g[MH]; u32x2 ow[MH];
#pragma unroll
        for (int hh = 0; hh < MH; ++hh) { const size_t off = (size_t)r * D + hh * MDV + 4 * lane; a[hh] = *(const f32x4*)(h0 + off) + *(const f32x4*)(h1 + off); g[hh] = *(const f32x4*)(ng + hh * MDV + 4 * lane);
            ow[hh] = *(const u32x2*)(F.QKVO() + (size_t)r * MINW + 2 * MQKW + MVW + hh * MDV + 4 * lane); }
#pragma unroll
        for (int hh = 0; hh < MH; ++hh) {
            const float ss = wave_sum((a[hh].x * a[hh].x + a[hh].y * a[hh].y) + (a[hh].z * a[hh].z + a[hh].w * a[hh].w)); const float rstd = 1.0f / sqrtf(ss * (1.0f / MDV) + NORM_EPS);
            f32x4 y = a[hh] * rstd * g[hh]; y.x *= sigmoid_f(bf2f(ow[hh].x & 0xffffu)); y.y *= sigmoid_f(bf2f(ow[hh].x >> 16)); y.z *= sigmoid_f(bf2f(ow[hh].y & 0xffffu)); y.w *= sigmoid_f(bf2f(ow[hh].y >> 16));
            u32x2 w; w.x = pk2(y.x, y.y); w.y = pk2(y.z, y.w); *(u32x2*)(F.O() + (size_t)r * D + hh * MDV + 4 * lane) = w; }
    }
}

__global__ void __launch_bounds__(NTHREADS, 2) fwd(Args args) {
    extern __shared__ __attribute__((aligned(16))) unsigned char lds_raw[];
    Frame F; F.lds = (LAS unsigned char*)lds_raw; F.tid = threadIdx.x; F.lane = F.tid & 63; F.wave = __builtin_amdgcn_readfirstlane(F.tid >> 6); F.G = gridDim.x;
    F.gw = blockIdx.x * NWAVES + F.wave; F.NGW = F.G * NWAVES; F.in = args.in; F.out = args.out; F.ws = args.ws;
    unsigned char* ws = args.ws;
    volatile LAS unsigned* MISC = (volatile LAS unsigned*)(F.lds + MISC_OFF);
    if (F.tid < 32) MISC[F.tid] = 0u;
    __syncthreads();
    XcdBarrier bar; bar.bar = (unsigned*)(ws + WS_CTL) + CW_BAR; bar.x = 0; bar.st = nullptr;
#if !MK_PER_PHASE
    bar = xcd_barrier_post((unsigned*)(ws + WS_CTL) + CW_BAR, MISC + 8);
#endif
    const int lo = args.ph_lo, hi = args.ph_hi; int ph = 0;
#define RUN() (lo <= ph && ph < hi)
#if MK_PER_PHASE
#define SEAM() do { ++ph; } while (0)
#else
#define SEAM() do { if (lo <= ph && ph + 1 < hi) xcd_barrier(bar.bar, bar.x, bar.st); ++ph; } while (0)
#endif
#if FAST_GEMM
#define GEMM(DUAL, A, lda, Wf, ldw, Bt, M, N, Nbt, K, doff, E) gemm_fast<DUAL>(F, A, Bt, (M) / 256, 0, Nbt, K, E)
    if (RUN()) { ph_mod(F); ph_cvt_weights(F); } SEAM();
#else
#define GEMM(DUAL, A, lda, Wf, ldw, Bt, M, N, Nbt, K, doff, E) gemm_naive<DUAL>(F, A, lda, Wf, ldw, M, N, K, doff, E)
    if (RUN()) { ph_init(F); ph_mod(F); } SEAM();
#endif
#pragma unroll 1
    for (int L = 0; L < DEPTH; ++L) {
#pragma unroll 1
        for (int half = 0; half < 2; ++half) {
            if (half == 1) {
                const float* pg1 = F.MOD() + ((size_t)(L * 5 + 4) * NMOD + 2) * D;
                if (RUN()) ph_norm<false>(F, L, 1, pg1, 0.5f);
                SEAM();
                const float* g5 = F.MOD() + ((size_t)(L * 5) * NMOD + 5) * D;
                if (L == 0 || L == 3) {
                    const float* wqkv = F.in[L == 0 ? IN_AWQKV : IN_WWQKV]; const float* qkg = F.in[L == 0 ? IN_AQKG : IN_WQKG]; const float* wo = F.in[L == 0 ? IN_AWO : IN_WWO];
                    const bf16* wqkv_t = F.WT() + (L == 0 ? WT_AWQKV : WT_WWQKV); const bf16* wo_t = F.WT() + (L == 0 ? WT_AWO : WT_WWO);
                    if (RUN()) { EpiQKV E{F.Q(), F.K(), F.V()}; GEMM(false, F.H(), D, wqkv, QKVW, wqkv_t, NR, QKVW, QKVW, D, 0, E); } SEAM();
                    if (RUN()) ph_qknorm_rope(F, qkg); SEAM();
#if FAST_ATTN
                    if (L == 0) { if (RUN()) { ph_attn_fast<false>(F, nullptr); if (PROBE_DUP == 3) { __syncthreads(); ph_attn_fast<false>(F, nullptr); } } } else { if (RUN()) { ph_attn_fast<true>(F, F.in[IN_WSINK]); if (PROBE_DUP == 3) { __syncthreads(); ph_attn_fast<true>(F, F.in[IN_WSINK]); } } }
#else
                    if (L == 0) { if (RUN()) ph_attn_naive<false>(F, nullptr); } else { if (RUN()) ph_attn_naive<true>(F, F.in[IN_WSINK]); }
#endif
                    SEAM();
                    if (RUN()) { EpiRmw<0> E{F.X(), g5, nullptr}; gemm_down(F, F.O(), wo_t, D, L == 3 ? 0 : 1, E); } SEAM();
                } else if (L == 1) {
#if FAST_S5
                    if (RUN()) { ph_s5_fast(F); if (PROBE_DUP == 4) { __syncthreads(); ph_s5_fast(F); } } SEAM();
#else
                    if (RUN()) ph_s5_naive(F); SEAM();
#endif
                    if (RUN()) ph_s5_combine(F); SEAM();
                    if (RUN()) { EpiRmw<3> E{F.X(), g5, nullptr}; GEMM(true, F.O(), D, F.in[IN_S5WGLU], 2 * D, F.WT() + WT_GLU, NR, D, 2 * D, D, D, E); } SEAM();
                } else {
                    if (RUN()) { EpiMlstmIn E{F.QKVO(), F.GATES(), F.in[IN_MBGATE]}; gemm_fast<false>(F, F.H(), F.WT() + WT_MWIN, 36, 0, MINW + 256, D, E); } SEAM();
#if FAST_MLSTM
                    if (RUN()) { ph_mlstm_fast(F); if (PROBE_DUP == 4) { __syncthreads(); ph_mlstm_fast(F); } } SEAM();
#else
                    if (RUN()) ph_mlstm_naive(F); SEAM();
#endif
                    if (RUN()) ph_mlstm_readout(F); SEAM();
                    if (RUN()) { EpiRmw<0> E{F.X(), g5, nullptr}; gemm_down(F, F.O(), F.WT() + WT_MWOUT, D, 1, E); } SEAM();
                }
            }
            const int j = half * 2;
            const float* pg0 = (half == 0 && L > 0) ? F.MOD() + ((size_t)((L - 1) * 5 + 4) * NMOD + 8) * D : nullptr;
            if (half == 1 && (L == 0 || L == 2)) pg0 = F.MOD() + ((size_t)(L * 5 + 4) * NMOD + 5) * D;
            if (RUN()) ph_norm<false>(F, L, j, pg0, half == 1 ? 1.0f : 0.5f, L == 0 && half == 0); SEAM();
            const float* wi = F.in[IN_FFNWI] + (size_t)(L * 2 + half) * D * 2 * DFF; const float* wo = F.in[IN_FFNWO] + (size_t)(L * 2 + half) * DFF * D;
            const bf16* wi_t = F.WT() + WT_FFNWI + (size_t)(L * 2 + half) * D * 2 * DFF; const bf16* wo_t = F.WT() + WT_FFNWO + (size_t)(L * 2 + half) * DFF * D;
            const int lastff = (L == DEPTH - 1 && half == 1);
            if (RUN()) { EpiSwiglu E{F.HID()}; gemm_fast<true>(F, F.H(), wi_t, lastff ? 32 : 36, lastff, 2 * DFF, D, E); } SEAM();
            const float* gg = F.MOD() + ((size_t)(L * 5) * NMOD + 3 * j + 2) * D;
            if (lastff) { if (RUN()) { EpiRmw<2> E{F.X(), gg, F.out}; gemm_down(F, F.HID(), wo_t, DFF, 0, E); } }
            else { if (RUN()) { EpiRmw<1> E{F.X(), gg, nullptr}; gemm_down(F, F.HID(), wo_t, DFF, 1, E); } }
            SEAM();
        }
    }
#undef RUN
#undef SEAM
}

constexpr int N_PHASES = 1 + 4 * 6 + (1 + 4) * 2 + (1 + 3) + (1 + 4);

extern "C" void kernel_launch(void* const* d_in, const int* in_sizes, int n_in, void* d_out, int out_size, void* d_ws, size_t ws_size, hipStream_t stream) {
    static int grid = 0;
    if (grid == 0) {
        if (n_in != 30 || out_size != NB * SEQ * D || ws_size < WS_END) { fprintf(stderr, "kernel_launch: unexpected shapes n_in %d out %d ws %zu\n", n_in, out_size, ws_size); grid = -1; return; }
        int dev = 0, cus = 0;
        if (hipGetDevice(&dev) != hipSuccess || hipDeviceGetAttribute(&cus, hipDeviceAttributeMultiprocessorCount, dev) != hipSuccess) { grid = -1; return; }
        if (hipFuncSetAttribute((const void*)fwd, hipFuncAttributeMaxDynamicSharedMemorySize, LDS_BYTES) != hipSuccess) { fprintf(stderr, "kernel_launch: hipFuncSetAttribute failed\n"); grid = -1; return; }
        int per_cu = 0; (void)hipOccupancyMaxActiveBlocksPerMultiprocessor(&per_cu, (const void*)fwd, NTHREADS, LDS_BYTES); (void)hipGetLastError();
        grid = cus;
    }
    if (grid < 0) return;
    (void)hipMemsetAsync((char*)d_ws + WS_CTL, 0, CTL_BYTES, stream);
    Args a{};
    for (int i = 0; i < 30; ++i) a.in[i] = (const float*)d_in[i];
    a.out = (float*)d_out; a.ws = (unsigned char*)d_ws;
#if MK_PER_PHASE
    for (int p = 0; p < N_PHASES; ++p) { a.ph_lo = p; a.ph_hi = p + 1; hipLaunchKernelGGL(fwd, dim3(grid), dim3(NTHREADS), LDS_BYTES, stream, a); }
#else
    a.ph_lo = 0; a.ph_hi = N_PHASES; hipLaunchKernelGGL(fwd, dim3(grid), dim3(NTHREADS), LDS_BYTES, stream, a);
#endif
    const hipError_t le = hipPeekAtLastError();
    if (le != hipSuccess) fprintf(stderr, "kernel_launch: launch failed: %s\n", hipGetErrorName(le));
}
```

```cpp
#include <hip/hip_runtime.h>
#include <cstdio>
#include <cstdint>

#ifndef MK_PER_PHASE
#define MK_PER_PHASE 0
#endif

#ifndef FAST_MLSTM
#define FAST_MLSTM 1
#endif
#ifndef CTX_SPLIT
#define CTX_SPLIT 1
#endif
#ifndef PROBE_DUP
#define PROBE_DUP 0
#endif
#ifndef FAST_S5
#define FAST_S5 1
#endif
#ifndef FAST_ATTN
#define FAST_ATTN 1
#endif
#ifndef FAST_GEMM
#define FAST_GEMM 1
#endif

#define GAS __attribute__((address_space(1)))
#define LAS __attribute__((address_space(3)))
typedef unsigned short bf16;
typedef float f32x4 __attribute__((ext_vector_type(4)));
typedef float f32x2 __attribute__((ext_vector_type(2)));
typedef unsigned u32x4 __attribute__((ext_vector_type(4)));
typedef unsigned u32x2 __attribute__((ext_vector_type(2)));

constexpr int D = 2048, NB = 4, SEQ = 2048, CTXL = 256, TPB = SEQ + CTXL, NR = NB * TPB;
constexpr int DFF = 5632, NMOD = 9, DEPTH = 4, GRID_W = 64;
constexpr int NH = 16, NKV = 4, HD = 128, QW = 2048, KVW = 512, QKVW = 3072;
constexpr int S5G = 128, S5GS = 16, S5N = 64;
constexpr int MH = 8, MDQK = 128, MDV = 256, MQKW = 1024, MVW = 2048, MINW = 6144;
constexpr float NORM_EPS = 1e-6f, GATE_CAP = 15.0f;
constexpr int NWAVES = 8, NTHREADS = 512;

constexpr size_t MiB = 1u << 20;
constexpr size_t WS_CTL = 0, CTL_BYTES = 1 * MiB;
constexpr size_t WS_MOD = 1 * MiB;
constexpr size_t WS_X = 4 * MiB;
constexpr size_t WS_H = 76 * MiB;
constexpr size_t WS_HID = 112 * MiB;
constexpr size_t WS_Q = 212 * MiB;
constexpr size_t WS_K = 248 * MiB;
constexpr size_t WS_V = 257 * MiB;
constexpr size_t WS_O = 266 * MiB;
constexpr size_t WS_QKVO = 302 * MiB;
constexpr size_t WS_GATES = 410 * MiB;
constexpr size_t WS_HD = 412 * MiB;
constexpr size_t WS_WT = 556 * MiB;
constexpr size_t WT_FFNWI = 0, WT_FFNWO = WT_FFNWI + (size_t)8 * D * 2 * DFF, WT_AWQKV = WT_FFNWO + (size_t)8 * DFF * D, WT_AWO = WT_AWQKV + (size_t)D * QKVW, WT_GLU = WT_AWO + (size_t)D * D,
                 WT_MWIN = WT_GLU + (size_t)D * 2 * D, WT_MWOUT = WT_MWIN + (size_t)D * (MINW + 256), WT_WWQKV = WT_MWOUT + (size_t)D * D, WT_WWO = WT_WWQKV + (size_t)D * QKVW, WT_ELEMS = WT_WWO + (size_t)D * D;
constexpr size_t WS_PEND = 1176 * MiB;
static_assert(WS_WT + WT_ELEMS * 2 <= WS_PEND, "ws map");
constexpr size_t WS_END = WS_PEND + 32 * MiB;

constexpr int CW_BAR = 4096;

__device__ __forceinline__ float bf2f(unsigned v) { return __uint_as_float(v << 16); }
typedef __bf16 bf16x2_t __attribute__((ext_vector_type(2)));
__device__ __forceinline__ unsigned pk2(float lo, float hi) { const f32x2 v = {lo, hi}; const bf16x2_t r = __builtin_convertvector(v, bf16x2_t); return __builtin_bit_cast(unsigned, r); }
__device__ __forceinline__ unsigned f2bf(float f) { return pk2(f, 0.f) & 0xffffu; }
template <int X> __device__ __forceinline__ float swz_xor(float v) { return __int_as_float(__builtin_amdgcn_ds_swizzle(__float_as_int(v), (X << 10) | 0x1f)); }
__device__ __forceinline__ float xor32(float v) { auto rr = __builtin_amdgcn_permlane32_swap(__float_as_uint(v), __float_as_uint(v), false, false); return __uint_as_float(rr[0]) + __uint_as_float(rr[1]) - v; }
__device__ __forceinline__ float wave_sum(float v) {
    v += swz_xor<1>(v); v += swz_xor<2>(v); v += swz_xor<4>(v); v += swz_xor<8>(v); v += swz_xor<16>(v);
    { auto rr = __builtin_amdgcn_permlane32_swap(__float_as_uint(v), __float_as_uint(v), false, false); v = __uint_as_float(rr[0]) + __uint_as_float(rr[1]); }
    return v;
}
__device__ __forceinline__ float sigmoid_f(float v) { return __builtin_amdgcn_rcpf(1.0f + __builtin_amdgcn_exp2f(v * -1.4426950408889634f)); }
__device__ __forceinline__ float silu_f(float v) { return v * sigmoid_f(v); }
__device__ __forceinline__ float gelu_tanh_f(float x) { const float u = 0.7978845608028654f * (x + 0.044715f * x * x * x); return 0.5f * x * (1.0f + tanhf(u)); }
__device__ __forceinline__ int row_ms(int r) { const int b = r / TPB; const int p = r - b * TPB; return p < CTXL ? 4 : b; }

#define XB_TMO      128
#define XB_XCNT(j)  (256  + 64 * (j))
#define XB_XSUB(j)  (1280 + 64 * (j))
#define XB_XGEN(j)  (2304 + 64 * (j))
#define XB_TOP      3328
#define XB_TOPGEN   3392
#define XCD_BAR_WORDS 3456
#define XB_SPIN_CAP (1u << 22)
__device__ __forceinline__ unsigned xb_ld(unsigned* p)              { return __hip_atomic_load(p, __ATOMIC_RELAXED, __HIP_MEMORY_SCOPE_AGENT); }
__device__ __forceinline__ unsigned xb_add(unsigned* p, unsigned v) { return __hip_atomic_fetch_add(p, v, __ATOMIC_RELAXED, __HIP_MEMORY_SCOPE_AGENT); }
__device__ __forceinline__ unsigned xb_xcc_id() { return (unsigned)__builtin_amdgcn_s_getreg((3 << 11) | 20) & 0xFu; }
#define XB_SPIN(cond, bar) do { unsigned _sp = 0; while (cond) { __builtin_amdgcn_s_sleep(1); \
    if ((++_sp & 255u) == 0u) { if (xb_ld(&(bar)[XB_TMO])) break; if (_sp > XB_SPIN_CAP) { atomicAdd(&(bar)[XB_TMO], 1u); break; } } } } while (0)
struct XcdBarrier { unsigned* bar; unsigned x; volatile LAS unsigned* st; };
__device__ __forceinline__ XcdBarrier xcd_barrier_post(unsigned* bar, volatile LAS unsigned* st) {
    XcdBarrier b; b.bar = bar; b.x = xb_xcc_id(); b.st = st;
    if (threadIdx.x == 0) (void)xb_add(&bar[XB_XCNT(b.x)], 1u);
    return b;
}
__device__ __forceinline__ void xcd_barrier_complete(unsigned* bar, unsigned x, unsigned& nloc, unsigned& nx) {
    const unsigned G = gridDim.x * gridDim.y * gridDim.z;
    unsigned sum, cnt, mine, sp = 0u;
    for (;;) {
        sum = 0u; cnt = 0u; mine = 0u;
#pragma unroll
        for (unsigned j = 0; j < 16; ++j) { const unsigned c = xb_ld(&bar[XB_XCNT(j)]); sum += c; cnt += (c > 0u) ? 1u : 0u; mine = (j == x) ? c : mine; }
        if (sum == G) break;
        __builtin_amdgcn_s_sleep(1);
        if ((++sp & 255u) == 0u) { if (xb_ld(&bar[XB_TMO])) break; if (sp > XB_SPIN_CAP) { atomicAdd(&bar[XB_TMO], 1u); break; } }
    }
    nloc = mine > 0u ? mine : 1u; nx = cnt > 0u ? cnt : 1u;
}
__device__ __noinline__ void xcd_barrier(unsigned* bar_, unsigned x_, volatile LAS unsigned* st_) {
    XcdBarrier b; b.bar = bar_; b.x = x_; b.st = st_;
    asm volatile("s_waitcnt vmcnt(0)" ::: "memory");
    __syncthreads();
    if (threadIdx.x == 0) {
        unsigned* bar = b.bar;
        __builtin_amdgcn_s_waitcnt(0);
        unsigned nloc = b.st[0], nx = b.st[1];
        if (nloc == 0u) { xcd_barrier_complete(bar, b.x, nloc, nx); b.st[0] = nloc; b.st[1] = nx; }
        const unsigned old = xb_add(&bar[XB_XSUB(b.x)], 1u);
        const unsigned gen = old / nloc;
        if (old + 1u == (gen + 1u) * nloc) {
            __builtin_amdgcn_fence(__ATOMIC_RELEASE, "agent");
            asm volatile("s_waitcnt vmcnt(0)" ::: "memory");
            const unsigned og = xb_add(&bar[XB_TOP], 1u);
            const unsigned tg = og / nx;
            if (og + 1u == (tg + 1u) * nx) xb_add(&bar[XB_TOPGEN], 1u);
            else XB_SPIN(xb_ld(&bar[XB_TOPGEN]) == tg, bar);
            __builtin_amdgcn_fence(__ATOMIC_ACQUIRE, "agent");
            xb_add(&bar[XB_XGEN(b.x)], 1u);
            asm volatile("s_waitcnt vmcnt(0)" ::: "memory");
        } else {
            XB_SPIN(xb_ld(&bar[XB_XGEN(b.x)]) == gen, bar);
            __builtin_amdgcn_fence(__ATOMIC_ACQUIRE, "agent");
            asm volatile("s_waitcnt vmcnt(0)" ::: "memory");
        }
    }
    __syncthreads();
}

constexpr int LDS_BYTES = 147456;
constexpr int MISC_OFF = 131072 + 320;
struct Args { const float* in[30]; float* out; unsigned char* ws; int ph_lo, ph_hi; };
struct Frame {
    LAS unsigned char* lds; int tid, lane, wave, G, gw, NGW;
    const float* const* in; float* out; unsigned char* ws;
    __device__ __forceinline__ float* MOD() const { return (float*)(ws + WS_MOD); }
    __device__ __forceinline__ float* X() const { return (float*)(ws + WS_X); }
    __device__ __forceinline__ bf16* H() const { return (bf16*)(ws + WS_H); }
    __device__ __forceinline__ bf16* HID() const { return (bf16*)(ws + WS_HID); }
    __device__ __forceinline__ bf16* Q() const { return (bf16*)(ws + WS_Q); }
    __device__ __forceinline__ bf16* K() const { return (bf16*)(ws + WS_K); }
    __device__ __forceinline__ bf16* V() const { return (bf16*)(ws + WS_V); }
    __device__ __forceinline__ bf16* O() const { return (bf16*)(ws + WS_O); }
    __device__ __forceinline__ bf16* QKVO() const { return (bf16*)(ws + WS_QKVO); }
    __device__ __forceinline__ float* GATES() const { return (float*)(ws + WS_GATES); }
    __device__ __forceinline__ float* HDb() const { return (float*)(ws + WS_HD); }
    __device__ __forceinline__ bf16* WT() const { return (bf16*)(ws + WS_WT); }
    __device__ __forceinline__ float* PEND() const { return (float*)(ws + WS_PEND); }
};
__device__ __forceinline__ Frame launder(const Frame& F0) {
    Frame F = F0; asm volatile("" : "+v"(F.tid));
    { unsigned lo = (unsigned)(uintptr_t)F0.ws, hi = (unsigned)((uintptr_t)F0.ws >> 32); asm volatile("" : "+v"(lo), "+v"(hi));
      F.ws = (unsigned char*)(((uintptr_t)(unsigned)__builtin_amdgcn_readfirstlane(hi) << 32) | (uintptr_t)(unsigned)__builtin_amdgcn_readfirstlane(lo)); }
    F.lane = F.tid & 63; F.wave = __builtin_amdgcn_readfirstlane(F.tid >> 6); F.gw = blockIdx.x * NWAVES + F.wave; return F;
}
enum { IN_X = 0, IN_C, IN_CTX, IN_CCTX, IN_MODW, IN_MODB, IN_NORMG, IN_FFNWI, IN_FFNWO, IN_AWQKV, IN_AQKG, IN_AWO,
       IN_S5LRE, IN_S5LIM, IN_S5LDT, IN_S5BRE, IN_S5BIM, IN_S5CRE, IN_S5CIM, IN_S5D, IN_S5WGLU,
       IN_MWIN, IN_MWGATE, IN_MBGATE, IN_MNORMG, IN_MWOUT, IN_WWQKV, IN_WQKG, IN_WSINK, IN_WWO };

__device__ __forceinline__ const float* modp(const Frame& F, int L, int ms, int j) { return F.MOD() + ((size_t)(L * 5 + ms) * NMOD + j) * D; }

__device__ __forceinline__ void ph_init(const Frame& F0) {
    const Frame F = launder(F0);
    const f32x4* xin = (const f32x4*)F.in[IN_X]; const f32x4* cin = (const f32x4*)F.in[IN_CTX]; f32x4* X = (f32x4*)F.X();
    const size_t n4 = (size_t)NR * D / 4, stride = (size_t)F.G * NTHREADS;
    for (size_t i0 = (size_t)blockIdx.x * NTHREADS + F.tid; i0 < n4; i0 += 4 * stride) {
        f32x4 v[4];
#pragma unroll
        for (int k = 0; k < 4; ++k) { const size_t i = i0 + k * stride; const int r = (int)(i / (D / 4)), c4 = (int)(i % (D / 4)); const int b = r / TPB, p = r - b * TPB;
            v[k] = p < CTXL ? cin[((size_t)b * CTXL + p) * (D / 4) + c4] : xin[((size_t)b * SEQ + (p - CTXL)) * (D / 4) + c4]; }
#pragma unroll
        for (int k = 0; k < 4; ++k) X[i0 + k * stride] = v[k];
    }
}
__device__ __forceinline__ void ph_mod(const Frame& F0) {
    const Frame F = launder(F0);
    LAS float* sc = (LAS float*)F.lds;
    for (int i = F.tid; i < 5 * D; i += NTHREADS) { const int ms = i / D, k = i % D; const float v = ms < 4 ? F.in[IN_C][ms * D + k] : F.in[IN_CCTX][k]; sc[i] = silu_f(v); }
    __syncthreads();
    const int NC = NMOD * D;
    for (int idx = blockIdx.x * NTHREADS + F.tid; idx < DEPTH * NC; idx += F.G * NTHREADS) {
        const int L = idx / NC, col = idx % NC; const float* w = F.in[IN_MODW] + (size_t)L * D * NC + col;
        float a0 = 0, a1 = 0, a2 = 0, a3 = 0, a4 = 0;
#pragma unroll 8
        for (int k = 0; k < D; ++k) { const float wv = w[(size_t)k * NC]; a0 += sc[k] * wv; a1 += sc[D + k] * wv; a2 += sc[2 * D + k] * wv; a3 += sc[3 * D + k] * wv; a4 += sc[4 * D + k] * wv; }
        const float bb = F.in[IN_MODB][(size_t)L * NC + col];
        float* o = F.MOD() + (size_t)L * 5 * NC + col;
        o[0] = a0 + bb; o[NC] = a1 + bb; o[2 * NC] = a2 + bb; o[3 * NC] = a3 + bb; o[4 * NC] = a4 + bb;
    }
    __syncthreads();
}
template <bool GATES>
__device__ __forceinline__ void ph_norm(const Frame& F0, int L, int j, const float* pend_gate, float pcoef, bool from_inputs = false) {
    const Frame F = launder(F0);
    const float* ng = F.in[IN_NORMG] + (size_t)(L * 3 + j) * D;
    if (!CTX_SPLIT) pend_gate = nullptr;
    for (int r = F.gw; r < NR; r += F.NGW) {
        const int ms = row_ms(r);
        const f32x4* xr = (const f32x4*)(F.X() + (size_t)r * D) + F.lane;
        if (from_inputs) { const int b = r / TPB, p = r - b * TPB; xr = (const f32x4*)(p < CTXL ? F.in[IN_CTX] + ((size_t)b * CTXL + p) * D : F.in[IN_X] + ((size_t)b * SEQ + (p - CTXL)) * D) + F.lane; }
        const f32x4* g4 = (const f32x4*)ng + F.lane; const f32x4* sh4 = (const f32x4*)modp(F, L, ms, 3 * j) + F.lane; const f32x4* sc4 = (const f32x4*)modp(F, L, ms, 3 * j + 1) + F.lane;
        f32x4 v[8], gg[8], shv[8], scv[8]; float ss = 0.f;
#pragma unroll
        for (int q = 0; q < 8; ++q) { v[q] = xr[64 * q]; gg[q] = g4[64 * q]; shv[q] = sh4[64 * q]; scv[q] = sc4[64 * q]; }
        if (pend_gate != nullptr && ms == 4) {
            const int b = r / TPB, cr = b * CTXL + (r - b * TPB); const f32x4* pg4 = (const f32x4*)pend_gate + F.lane; const f32x4* p4 = (const f32x4*)(F.PEND() + (size_t)cr * D) + F.lane;
            f32x4* xw = (f32x4*)(F.X() + (size_t)r * D) + F.lane;
            f32x4 ps[8];
#pragma unroll
            for (int q = 0; q < 8; ++q) ps[q] = ((p4[64 * q] + p4[64 * q + (size_t)NB * CTXL * D / 4]) + (p4[64 * q + (size_t)2 * NB * CTXL * D / 4] + p4[64 * q + (size_t)3 * NB * CTXL * D / 4])) * pg4[64 * q];
#pragma unroll
            for (int q = 0; q < 8; ++q) { v[q] = v[q] + pcoef * ps[q]; xw[64 * q] = v[q]; }
        }
        if (from_inputs) { f32x4* xw = (f32x4*)(F.X() + (size_t)r * D) + F.lane;
#pragma unroll
            for (int q = 0; q < 8; ++q) xw[64 * q] = v[q]; }
#pragma unroll
        for (int q = 0; q < 8; ++q) ss += (v[q].x * v[q].x + v[q].y * v[q].y) + (v[q].z * v[q].z + v[q].w * v[q].w);
        const float rstd = 1.0f / sqrtf(wave_sum(ss) * (1.0f / D) + NORM_EPS);
        u32x2* o = (u32x2*)(F.H() + (size_t)r * D) + F.lane;
#pragma unroll
        for (int q = 0; q < 8; ++q) { v[q] = (v[q] * rstd) * gg[q] * (scv[q] + 1.0f) + shv[q];
            u32x2 w; w.x = pk2(v[q].x, v[q].y); w.y = pk2(v[q].z, v[q].w); o[64 * q] = w; }
        if constexpr (GATES) {
            LAS float* hrow = (LAS float*)F.lds + F.wave * D;
#pragma unroll
            for (int q = 0; q < 8; ++q) *(LAS f32x4*)(hrow + (F.lane + 64 * q) * 4) = v[q];
            const int t = F.lane & 31, hf = F.lane >> 5; const float* wg = F.in[IN_MWGATE] + t; float acc = 0.f;
#pragma unroll 8
            for (int d = hf * 1024; d < hf * 1024 + 1024; ++d) acc += hrow[d] * wg[(size_t)d * 32];
            { auto rr = __builtin_amdgcn_permlane32_swap(__float_as_uint(acc), __float_as_uint(acc), false, false); acc = __uint_as_float(rr[0]) + __uint_as_float(rr[1]); }
            if (F.lane < 32) { const float g = acc + F.in[IN_MBGATE][t]; F.GATES()[(size_t)r * 32 + t] = GATE_CAP * tanhf(g / GATE_CAP); }
        }
    }
}

struct EpiSwiglu { bf16* HID;
    __device__ __forceinline__ void operator()(int r, int c, f32x4 a, f32x4 g) const {
        u32x2 w; w.x = pk2(silu_f(g.x) * a.x, silu_f(g.y) * a.y); w.y = pk2(silu_f(g.z) * a.z, silu_f(g.w) * a.w);
        *(u32x2*)(HID + (size_t)r * DFF + c) = w; } };
template <int HALF> struct EpiResid { float* X; const float* gate;
    __device__ __forceinline__ void operator()(int r, int c, f32x4 a, f32x4) const {
        const int ms = row_ms(r); const f32x4 g = *(const f32x4*)(gate + (size_t)ms * NMOD * D + c);
        f32x4* xp = (f32x4*)(X + (size_t)r * D + c); *xp = *xp + (HALF ? 0.5f : 1.0f) * (g * a); } };
struct EpiFinal { const float* X; const float* gate; float* out;
    __device__ __forceinline__ void operator()(int r, int c, f32x4 a, f32x4) const {
        const int b = r / TPB, p = r - b * TPB; if (p < CTXL) return;
        const f32x4 g = *(const f32x4*)(gate + (size_t)b * NMOD * D + c);
        *(f32x4*)(out + ((size_t)b * SEQ + (p - CTXL)) * D + c) = *(const f32x4*)(X + (size_t)r * D + c) + 0.5f * (g * a); } };
struct EpiGluResid { float* X; const float* gate;
    __device__ __forceinline__ void operator()(int r, int c, f32x4 a, f32x4 g) const {
        const int ms = row_ms(r); const f32x4 gt = *(const f32x4*)(gate + (size_t)ms * NMOD * D + c);
        f32x4* xp = (f32x4*)(X + (size_t)r * D + c); f32x4 s; s.x = sigmoid_f(g.x); s.y = sigmoid_f(g.y); s.z = sigmoid_f(g.z); s.w = sigmoid_f(g.w);
        *xp = *xp + gt * a * s; } };
struct EpiQKV { bf16 *Q, *K, *V;
    __device__ __forceinline__ void operator()(int r, int c, f32x4 a, f32x4) const {
        u32x2 w; w.x = pk2(a.x, a.y); w.y = pk2(a.z, a.w);
        bf16* p = c < QW ? Q + (size_t)r * QW + c : (c < QW + KVW ? K + (size_t)r * KVW + (c - QW) : V + (size_t)r * KVW + (c - QW - KVW));
        *(u32x2*)p = w; } };
struct EpiMlstmIn { bf16* O; float* G; const float* bg;
    __device__ __forceinline__ void operator()(int r, int c, f32x4 a, f32x4) const {
        if (c < MINW) { u32x2 w; w.x = pk2(a.x, a.y); w.y = pk2(a.z, a.w); *(u32x2*)(O + (size_t)r * MINW + c) = w; }
        else if (c < MINW + 32) { const f32x4 b = *(const f32x4*)(bg + (c - MINW)); f32x4 g;
            g.x = GATE_CAP * tanhf((a.x + b.x) * (1.0f / GATE_CAP)); g.y = GATE_CAP * tanhf((a.y + b.y) * (1.0f / GATE_CAP)); g.z = GATE_CAP * tanhf((a.z + b.z) * (1.0f / GATE_CAP)); g.w = GATE_CAP * tanhf((a.w + b.w) * (1.0f / GATE_CAP));
            *(f32x4*)(G + (size_t)r * 32 + (c - MINW)) = g; }
    } };
struct EpiBf16 { bf16* O; int ld;
    __device__ __forceinline__ void operator()(int r, int c, f32x4 a, f32x4) const { u32x2 w; w.x = pk2(a.x, a.y); w.y = pk2(a.z, a.w); *(u32x2*)(O + (size_t)r * ld + c) = w; } };

template <bool DUAL, class Epi>
__device__ __forceinline__ void gemm_naive(const Frame& F0, const bf16* A, int lda, const float* W, int ldw, int M, int N, int K, int dual_off, const Epi E) {
    const Frame F = launder(F0);
    constexpr int BM = 128, BN = 128, BK = 16;
    LAS float* As = (LAS float*)F.lds;
    LAS float* Bs = As + BK * (BM + 4);
    LAS float* B2 = Bs + BK * BN;
    const int ty = F.tid >> 5, tx = F.tid & 31;
    const int ntm = M / BM, ntn = N / BN, nt = ntm * ntn;
    for (int t = blockIdx.x; t < nt; t += F.G) {
        const int tm = t / ntn, tn = t % ntn; const int m0 = tm * BM, n0 = tn * BN;
        f32x4 acc[8], acc2[8];
#pragma unroll
        for (int i = 0; i < 8; ++i) { acc[i] = (f32x4){0.f, 0.f, 0.f, 0.f}; acc2[i] = (f32x4){0.f, 0.f, 0.f, 0.f}; }
        for (int k0 = 0; k0 < K; k0 += BK) {
            { const int row = F.tid >> 2, kq = (F.tid & 3) * 4; const u32x2 w = *(const u32x2*)(A + (size_t)(m0 + row) * lda + k0 + kq);
              As[(kq + 0) * (BM + 4) + row] = bf2f(w.x & 0xffffu); As[(kq + 1) * (BM + 4) + row] = bf2f(w.x >> 16); As[(kq + 2) * (BM + 4) + row] = bf2f(w.y & 0xffffu); As[(kq + 3) * (BM + 4) + row] = bf2f(w.y >> 16); }
            { const int kk = F.tid >> 5, c4 = (F.tid & 31) * 4; *(LAS f32x4*)(Bs + kk * BN + c4) = *(const f32x4*)(W + (size_t)(k0 + kk) * ldw + n0 + c4);
              if constexpr (DUAL) *(LAS f32x4*)(B2 + kk * BN + c4) = *(const f32x4*)(W + (size_t)(k0 + kk) * ldw + dual_off + n0 + c4); }
            __syncthreads();
#pragma unroll
            for (int kk = 0; kk < BK; ++kk) {
                const f32x4 a0 = *(LAS f32x4*)(As + kk * (BM + 4) + ty * 8), a1 = *(LAS f32x4*)(As + kk * (BM + 4) + ty * 8 + 4);
                const f32x4 b = *(LAS f32x4*)(Bs + kk * BN + tx * 4);
                acc[0] += a0.x * b; acc[1] += a0.y * b; acc[2] += a0.z * b; acc[3] += a0.w * b; acc[4] += a1.x * b; acc[5] += a1.y * b; acc[6] += a1.z * b; acc[7] += a1.w * b;
                if constexpr (DUAL) { const f32x4 b2 = *(LAS f32x4*)(B2 + kk * BN + tx * 4);
                    acc2[0] += a0.x * b2; acc2[1] += a0.y * b2; acc2[2] += a0.z * b2; acc2[3] += a0.w * b2; acc2[4] += a1.x * b2; acc2[5] += a1.y * b2; acc2[6] += a1.z * b2; acc2[7] += a1.w * b2; }
            }
            __syncthreads();
        }
#pragma unroll
        for (int i = 0; i < 8; ++i) E(m0 + ty * 8 + i, n0 + tx * 4, acc[i], acc2[i]);
    }
}

namespace pg8 {
#define PG8_LAS __attribute__((address_space(3)))
typedef unsigned short bf16_t;
typedef short bf16x8 __attribute__((ext_vector_type(8)));
typedef float f32x4 __attribute__((ext_vector_type(4)));
typedef unsigned u32x4 __attribute__((ext_vector_type(4)));
constexpr int BM = 256, BK = 64, HALF = 128, HTB = HALF * BK * 2  , STAGE_BYTES = 8 * HTB, NXCD = 8, WGM = 8;

__host__ __device__ __forceinline__ int lds_byte(int r, int c) { const int st = (r >> 4) * 2 + (c >> 5), rr = r & 15, cc = c & 31, ob = rr * 64 + cc * 2; return st * 1024 + (ob ^ (((ob >> 9) & 1) << 5)); }
__host__ __device__ __forceinline__ void stage_rc(int b, int& R, int& C) { const int st = b / 1024, sb = b % 1024, swz = sb ^ (((sb >> 9) & 1) << 5); R = (st >> 1) * 16 + swz / 64; C = (st & 1) * 32 + (swz % 64) / 2; }
__host__ __device__ __forceinline__ int perm32(int rho) { const int n = rho >> 4, i = rho & 15; return 8 * (i >> 2) + 4 * n + (i & 3); }

struct Unit { int pm, pn, ks; };
struct Gemm { const bf16_t* A; const bf16_t* Bt; int lda, ldb; };

struct StaticOrder {
    int nM, nN, nwg, G, c;
    __host__ __device__ void init(int M, int N, int G_, int c_) { nM = M / BM; nN = N / BM; nwg = nM * nN; G = G_; c = c_; }
    __host__ __device__ bool next(int i, Unit& u) const {
        const long L = (long)i * G + c; if (L >= nwg) { u.pm = 0; u.pn = 0; return false; }
        int wgid = (int)L; { const int q = nwg / NXCD, r = nwg % NXCD, xcd = wgid % NXCD, off = wgid / NXCD; wgid = (xcd < r ? xcd * (q + 1) : r * (q + 1) + (xcd - r) * q) + off; }
        const int nig = WGM * nN, gid = wgid / nig, fm = gid * WGM, gsz = (nM - fm) < WGM ? (nM - fm) : WGM;
        u.pm = fm + ((wgid % nig) % gsz); u.pn = (wgid % nig) / gsz; return true;
    }
    __device__ __forceinline__ void a_ready(const Unit&) const {}
    __device__ __forceinline__ void done(const Unit&) const {}
};
struct TileSched {
    StaticOrder so; int lat, ctx_split, lda, ldb, ntK;
    __device__ __forceinline__ void init(int nMlog, int Nbt, int G, int c, int lat_, int ctx_split_, int lda_, int ldb_, int K) { so.init(nMlog * BM, Nbt, G, c); lat = lat_; ctx_split = ctx_split_; lda = lda_; ldb = ldb_; ntK = K / BK; }
    __device__ __forceinline__ bool next(int i, Unit& u) const {
        Unit t; t.pm = 0; t.pn = 0; t.ks = -1; const bool main = so.next(i, t);
        int pm = lat ? t.pm + t.pm / 8 + 1 : t.pm, pn = t.pn, ks = -1; bool ok = main;
        if (!main && ctx_split) { const long e = (long)i * so.G + so.c - so.nwg; ok = (e >= 0 && e < 128); const int tile = (int)e >> 2; ks = (int)e & 3; pm = 9 * (tile >> 3); pn = tile & 7; }
        u.pm = pm; u.pn = pn; u.ks = ks; return ok;
    }
    __device__ __forceinline__ int k0(const Unit& u) const { return u.ks <= 0 ? 0 : (ntK >> 2) * u.ks; }
    __device__ __forceinline__ int nt(const Unit& u) const { return u.ks < 0 ? ntK : (ntK >> 2); }
    __device__ __forceinline__ size_t a_off(const Unit& u) const { return ((size_t)u.pm * BM * lda + (size_t)k0(u) * BK) * 2; }
    __device__ __forceinline__ size_t b_off(const Unit& u) const { return ((size_t)u.pn * BM * ldb + (size_t)k0(u) * BK) * 2; }
    __device__ __forceinline__ void a_ready(const Unit&) const {}
    __device__ __forceinline__ void done(const Unit&) const {}
};
template <class Epi, class Sched, bool ALIGN_EPI = false, bool SP2 = false>
__device__ __forceinline__ void gemm_phase(PG8_LAS unsigned char* lds, const Gemm g, const Sched& S, const Epi& E) {
    int tid_ = threadIdx.x; asm volatile("" : "+v"(tid_));
    const int tid = tid_, wid = __builtin_amdgcn_readfirstlane(tid >> 6), lane = tid & 63, wr = wid >> 2, wc = wid & 3, fr = lane & 15, fq = lane >> 4;
    unsigned voffA[2], voffB[2];
#pragma unroll
    for (int i = 0; i < 2; ++i) { int R, C; stage_rc(tid * 16 + i * 8192, R, C); const int Rb = Epi::PERM ? ((R & ~31) + perm32(R & 31)) : R;
        voffA[i] = (unsigned)(R * g.lda + C) * 2u; voffB[i] = (unsigned)(Rb * g.ldb + C) * 2u; }
    const size_t kstep = (size_t)(BK * 2);
    const size_t hstepA = (size_t)HALF * g.lda * 2, hstepB = (size_t)HALF * g.ldb * 2;
    const unsigned ldsw = (unsigned)wid * 1024u;
    const int aoff = lds_byte(wr * 64 + fr, fq * 8), boff = lds_byte(wc * 32 + fr, fq * 8);
#define PG8_SA(b, h) (((b) * 2 + (h)) * HTB)
#define PG8_SB(b, h) ((4 + (b) * 2 + (h)) * HTB)
#define PG8_STAGE(bufoff, gbase, voff) do { _Pragma("unroll") for (int _i = 0; _i < 2; ++_i) \
        __builtin_amdgcn_global_load_lds((const unsigned*)((const char*)(gbase) + (voff)[_i]), (PG8_LAS unsigned*)(lds + (bufoff) + ldsw + _i * 8192), 16, 0, 0); } while (0)
#define PG8_LDA(dst, b, h) do { _Pragma("unroll") for (int m = 0; m < 4; ++m) _Pragma("unroll") for (int k = 0; k < 2; ++k) dst[m][k] = *(const PG8_LAS bf16x8*)(lds + PG8_SA(b, h) + aoff + m * 2048 + k * 1024); } while (0)
#define PG8_LDB(dst, b, h) do { _Pragma("unroll") for (int n = 0; n < 2; ++n) _Pragma("unroll") for (int k = 0; k < 2; ++k) dst[n][k] = *(const PG8_LAS bf16x8*)(lds + PG8_SB(b, h) + boff + n * 2048 + k * 1024); } while (0)
#define PG8_MMA(ai, bj, At, Bt) do { __builtin_amdgcn_s_setprio(1); _Pragma("unroll") for (int m = 0; m < 4; ++m) _Pragma("unroll") for (int n = 0; n < 2; ++n) _Pragma("unroll") for (int k = 0; k < 2; ++k) \
        acc[ai][bj][m][n] = __builtin_amdgcn_mfma_f32_16x16x32_bf16(Bt[n][k], At[m][k], acc[ai][bj][m][n], 0, 0, 0); __builtin_amdgcn_s_setprio(0); } while (0)
#define PG8_WAIT_V(n) asm volatile("s_waitcnt vmcnt(" #n ")" ::: "memory")
#define PG8_WAIT_L(n) asm volatile("s_waitcnt lgkmcnt(" #n ")" ::: "memory")
#define PG8_BAR __builtin_amdgcn_s_barrier()
#define PG8_SCHED __builtin_amdgcn_sched_barrier(0)
    Unit cur, nxt; int ui = 0;
    if (!S.next(0, cur)) return;
    f32x4 acc[2][2][4][2];
#pragma unroll
    for (int a = 0; a < 2; ++a)
#pragma unroll
        for (int b = 0; b < 2; ++b)
#pragma unroll
            for (int m = 0; m < 4; ++m)
#pragma unroll
                for (int n = 0; n < 2; ++n) acc[a][b][m][n] = (f32x4){0.f, 0.f, 0.f, 0.f};
    bf16x8 At[4][2], B0[2][2], B1[2][2];
    const char* cA = (const char*)g.A + S.a_off(cur); const char* cB = (const char*)g.Bt + S.b_off(cur);
    S.a_ready(cur);
    if constexpr (SP2) {
        PG8_STAGE(PG8_SB(0, 0), cB, voffB); PG8_STAGE(PG8_SB(0, 1), cB + hstepB, voffB); PG8_STAGE(PG8_SA(0, 0), cA, voffA); PG8_STAGE(PG8_SA(0, 1), cA + hstepA, voffA);
        if (wr == 1) PG8_BAR;
        PG8_WAIT_V(2); PG8_BAR;
        PG8_STAGE(PG8_SB(1, 0), cB + kstep, voffB); PG8_STAGE(PG8_SA(1, 0), cA + kstep, voffA); PG8_STAGE(PG8_SB(1, 1), cB + hstepB + kstep, voffB);
        PG8_WAIT_V(6); PG8_BAR;
    } else {
        PG8_STAGE(PG8_SB(0, 0), cB, voffB); PG8_STAGE(PG8_SA(0, 0), cA, voffA); PG8_STAGE(PG8_SB(0, 1), cB + hstepB, voffB); PG8_STAGE(PG8_SA(0, 1), cA + hstepA, voffA);
        if (wr == 1) PG8_BAR;
        PG8_WAIT_V(4); PG8_BAR;
        PG8_STAGE(PG8_SB(1, 0), cB + kstep, voffB); PG8_STAGE(PG8_SA(1, 0), cA + kstep, voffA); PG8_STAGE(PG8_SB(1, 1), cB + hstepB + kstep, voffB);
        PG8_WAIT_V(6); PG8_BAR;
    }
    for (;;) {
        const bool has_next = S.next(ui + 1, nxt);
        const char* nA = has_next ? (const char*)g.A + S.a_off(nxt) : cA; const char* nB = has_next ? (const char*)g.Bt + S.b_off(nxt) : cB;
        const int nt = S.nt(cur);
        for (int t = 0; t < nt; t += 2) {
            const bool last = (t == nt - 2);
            const char* a1 = cA + (size_t)(t + 1) * kstep;
            const char* a2 = last ? nA : cA + (size_t)(t + 2) * kstep; const char* b2 = last ? nB : cB + (size_t)(t + 2) * kstep;
            const char* a3 = a2 + kstep; const char* b3 = b2 + kstep;
            if (last && has_next) S.a_ready(nxt);
            if constexpr (SP2) {
            PG8_LDB(B0, 0, 0); PG8_LDB(B1, 0, 1); PG8_SCHED; PG8_LDA(At, 0, 0); PG8_STAGE(PG8_SA(1, 1), a1 + hstepA, voffA);
            PG8_WAIT_V(8); PG8_WAIT_L(0); PG8_BAR; PG8_MMA(0, 0, At, B0); PG8_MMA(0, 1, At, B1); PG8_BAR; PG8_SCHED;
            PG8_LDA(At, 0, 1); PG8_STAGE(PG8_SB(0, 0), b2, voffB); PG8_STAGE(PG8_SB(0, 1), b2 + hstepB, voffB); PG8_STAGE(PG8_SA(0, 0), a2, voffA);
            PG8_WAIT_V(8); PG8_WAIT_L(0); PG8_BAR; PG8_MMA(1, 0, At, B0); PG8_MMA(1, 1, At, B1); PG8_BAR; PG8_SCHED;
            PG8_LDB(B0, 1, 0); PG8_LDB(B1, 1, 1); PG8_SCHED; PG8_LDA(At, 1, 0); PG8_STAGE(PG8_SA(0, 1), a2 + hstepA, voffA);
            PG8_WAIT_V(8); PG8_WAIT_L(0); PG8_BAR; PG8_MMA(0, 0, At, B0); PG8_MMA(0, 1, At, B1); PG8_BAR; PG8_SCHED;
            PG8_LDA(At, 1, 1); PG8_STAGE(PG8_SB(1, 0), b3, voffB); PG8_STAGE(PG8_SB(1, 1), b3 + hstepB, voffB); PG8_STAGE(PG8_SA(1, 0), a3, voffA);
            PG8_WAIT_V(8); PG8_WAIT_L(0); PG8_BAR; PG8_MMA(1, 0, At, B0); PG8_MMA(1, 1, At, B1); PG8_BAR; PG8_SCHED;
            } else {
            PG8_LDB(B0, 0, 0); PG8_SCHED; PG8_LDA(At, 0, 0); PG8_STAGE(PG8_SA(1, 1), a1 + hstepA, voffA);
            PG8_WAIT_L(8); PG8_BAR; PG8_WAIT_L(0); PG8_MMA(0, 0, At, B0); PG8_BAR; PG8_SCHED;
            PG8_LDB(B1, 0, 1); PG8_STAGE(PG8_SB(0, 0), b2, voffB);
            PG8_BAR; PG8_WAIT_L(0); PG8_MMA(0, 1, At, B1); PG8_BAR;
            PG8_LDA(At, 0, 1); PG8_STAGE(PG8_SA(0, 0), a2, voffA);
            PG8_BAR; PG8_WAIT_L(0); PG8_MMA(1, 0, At, B0); PG8_BAR; PG8_SCHED;
            PG8_STAGE(PG8_SB(0, 1), b2 + hstepB, voffB);
            PG8_WAIT_V(6); PG8_BAR; PG8_MMA(1, 1, At, B1); PG8_BAR;
            PG8_LDB(B0, 1, 0); PG8_SCHED; PG8_LDA(At, 1, 0); PG8_STAGE(PG8_SA(0, 1), a2 + hstepA, voffA);
            PG8_WAIT_L(8); PG8_BAR; PG8_WAIT_L(0); PG8_MMA(0, 0, At, B0); PG8_BAR; PG8_SCHED;
            PG8_LDB(B1, 1, 1); PG8_STAGE(PG8_SB(1, 0), b3, voffB);
            PG8_BAR; PG8_WAIT_L(0); PG8_MMA(0, 1, At, B1); PG8_BAR;
            PG8_LDA(At, 1, 1); PG8_STAGE(PG8_SA(1, 0), a3, voffA);
            PG8_BAR; PG8_WAIT_L(0); PG8_MMA(1, 0, At, B0); PG8_BAR; PG8_SCHED;
            PG8_STAGE(PG8_SB(1, 1), b3 + hstepB, voffB);
            PG8_WAIT_V(6); PG8_BAR; PG8_MMA(1, 1, At, B1); PG8_BAR;
            }
        }
        if constexpr (ALIGN_EPI) { if (wr == 0) PG8_BAR; }
        if constexpr (!Epi::AFTER_DRAIN) { E(acc, cur, wr, wc, fr, fq); S.done(cur); }
        if (!has_next) break;
#pragma unroll
        for (int a = 0; a < 2; ++a)
#pragma unroll
            for (int b = 0; b < 2; ++b)
#pragma unroll
                for (int m = 0; m < 4; ++m)
#pragma unroll
                    for (int n = 0; n < 2; ++n) acc[a][b][m][n] = (f32x4){0.f, 0.f, 0.f, 0.f};
        cur = nxt; cA = nA; cB = nB; ++ui;
        if constexpr (ALIGN_EPI) { if (wr == 1) PG8_BAR; }
    }
    PG8_WAIT_V(0);
    if constexpr (!ALIGN_EPI) { if (wr == 0) PG8_BAR; }
    PG8_BAR;
    if constexpr (Epi::AFTER_DRAIN) { E.fused(acc, cur, wr, wc, fr, fq, lds, wid, lane); S.done(cur); }
#undef PG8_SA
#undef PG8_SB
#undef PG8_STAGE
#undef PG8_LDA
#undef PG8_LDB
#undef PG8_MMA
#undef PG8_WAIT_V
#undef PG8_WAIT_L
#undef PG8_BAR
#undef PG8_SCHED
}
}

template <int KIND> struct EpiRmw { static constexpr bool RMW = true; float* X; const float* gate; float* out; };
template <int KIND, bool DUAL>
__device__ __forceinline__ void rmw_tile(const EpiRmw<KIND>& e, const pg8::f32x4 (&acc)[2][2][4][2], const pg8::Unit& u, int wr, int wc, int fr, int fq) {
    constexpr int NC = DUAL ? 2 : 4;
    const int b = u.pm / 9, ms = (u.pm - 9 * b) == 0 ? 4 : b;
    int col[NC]; f32x4 gv[NC];
#pragma unroll
    for (int k = 0; k < NC; ++k) { col[k] = DUAL ? u.pn * 128 + wc * 32 + k * 16 + 4 * fq : u.pn * 256 + (k >> 1) * 128 + wc * 32 + (k & 1) * 16 + 4 * fq;
        gv[k] = *(const f32x4*)(e.gate + (size_t)ms * NMOD * D + col[k]); if (KIND == 1 || KIND == 2) gv[k] = gv[k] * 0.5f; }
#pragma unroll
    for (int ai = 0; ai < 2; ++ai)
#pragma unroll
        for (int mp = 0; mp < 2; ++mp) {
            f32x4 x[2][NC];
#pragma unroll
            for (int mi = 0; mi < 2; ++mi) { const int r = u.pm * 256 + ai * 128 + wr * 64 + (2 * mp + mi) * 16 + fr;
#pragma unroll
                for (int k = 0; k < NC; ++k) x[mi][k] = *(const f32x4*)(e.X + (size_t)r * D + col[k]); }
#pragma unroll
            for (int mi = 0; mi < 2; ++mi) { const int m = 2 * mp + mi, rl = ai * 128 + wr * 64 + m * 16 + fr, r = u.pm * 256 + rl;
                float* dst = KIND == 2 ? e.out + ((size_t)b * SEQ + (size_t)(u.pm - 9 * b - 1) * 256 + rl) * D : e.X + (size_t)r * D;
#pragma unroll
                for (int k = 0; k < NC; ++k) { f32x4 a;
                    if constexpr (DUAL) { const f32x4 aa = acc[ai][0][m][k], gg = acc[ai][1][m][k]; a.x = aa.x * sigmoid_f(gg.x); a.y = aa.y * sigmoid_f(gg.y); a.z = aa.z * sigmoid_f(gg.z); a.w = aa.w * sigmoid_f(gg.w); }
                    else a = acc[ai][k >> 1][m][k & 1];
                    *(f32x4*)(dst + col[k]) = x[mi][k] + gv[k] * a; } }
            asm volatile("" ::: "memory");
        }
}
template <class T> struct is_rmw { static constexpr bool value = false; static constexpr int kind = -1; };
template <int KIND> struct is_rmw<EpiRmw<KIND>> { static constexpr bool value = true; static constexpr int kind = KIND; };

template <bool DUAL, class SE> struct EpiWrap {
    static constexpr bool PERM = false, AFTER_DRAIN = false;
    SE e;
    __device__ __forceinline__ void operator()(const pg8::f32x4 (&acc)[2][2][4][2], const pg8::Unit& u, int wr, int wc, int fr, int fq) const {
        if constexpr (is_rmw<SE>::value) { rmw_tile<is_rmw<SE>::kind, DUAL>(e, acc, u, wr, wc, fr, fq); return; } else {
#pragma unroll
        for (int ai = 0; ai < 2; ++ai)
#pragma unroll
            for (int m = 0; m < 4; ++m) { const int r = u.pm * 256 + ai * 128 + wr * 64 + m * 16 + fr;
                if constexpr (DUAL) {
#pragma unroll
                    for (int n = 0; n < 2; ++n) e(r, u.pn * 128 + wc * 32 + n * 16 + 4 * fq, acc[ai][0][m][n], acc[ai][1][m][n]);
                } else {
#pragma unroll
                    for (int bj = 0; bj < 2; ++bj)
#pragma unroll
                        for (int n = 0; n < 2; ++n) e(r, u.pn * 256 + bj * 128 + wc * 32 + n * 16 + 4 * fq, acc[ai][bj][m][n], acc[ai][bj][m][n]);
                }
                asm volatile("" ::: "memory"); }
        }
    }
};
template <bool DUAL, class SE>
__device__ __forceinline__ void gemm_fast(const Frame& F, const bf16* A, const bf16* Bt, int nMlog, int lat, int Nbt, int K, const SE e) {
    pg8::Gemm g{A, Bt, K, K}; pg8::TileSched S; S.init(nMlog, Nbt, F.G, (int)blockIdx.x, lat, 0, K, K, K);
    EpiWrap<DUAL, SE> E{e};
    pg8::gemm_phase<EpiWrap<DUAL, SE>, pg8::TileSched, true, true>(F.lds, g, S, E);
}
template <class SE> struct EpiDownWrap {
    static constexpr bool PERM = false, AFTER_DRAIN = false;
    SE e; float* P;
    __device__ __forceinline__ void operator()(const pg8::f32x4 (&acc)[2][2][4][2], const pg8::Unit& u, int wr, int wc, int fr, int fq) const {
        if (u.ks < 0) { rmw_tile<is_rmw<SE>::kind, false>(e, acc, u, wr, wc, fr, fq); return; }
#pragma unroll
        for (int ai = 0; ai < 2; ++ai)
#pragma unroll
            for (int m = 0; m < 4; ++m) { const int rl = ai * 128 + wr * 64 + m * 16 + fr, r = u.pm * 256 + rl;
                if (u.ks < 0) { (void)r; } else { float* pr = P + ((size_t)u.ks * (NB * CTXL) + (u.pm / 9) * 256 + rl) * D + u.pn * 256 + wc * 32 + 4 * fq;
#pragma unroll
                    for (int bj = 0; bj < 2; ++bj)
#pragma unroll
                        for (int n = 0; n < 2; ++n) *(f32x4*)(pr + bj * 128 + n * 16) = acc[ai][bj][m][n];
                }
                asm volatile("" ::: "memory"); }
    }
};
template <class SE>
__device__ __forceinline__ void gemm_down(const Frame& F, const bf16* A, const bf16* Bt, int K, int ctx_split, const SE e) {
    pg8::Gemm g{A, Bt, K, K}; pg8::TileSched S; if (CTX_SPLIT || !ctx_split) S.init(32, D, F.G, (int)blockIdx.x, 1, ctx_split, K, K, K); else S.init(36, D, F.G, (int)blockIdx.x, 0, 0, K, K, K);
    EpiDownWrap<SE> E{e, F.PEND()};
    pg8::gemm_phase<EpiDownWrap<SE>, pg8::TileSched, true, true>(F.lds, g, S, E);
}
__device__ __forceinline__ void cvt_item(const float* W, int K, int N, bf16* WT, int split, LAS float* scr, int item, int lane) {
    const int nblk = N / 32, kb = item / nblk, nb = item % nblk, k0 = 64 * kb, n0 = 32 * nb;
    int r0 = n0; if (split) { const int j = n0 < split ? n0 : n0 - split; r0 = (j >> 7) * 256 + (j & 127) + (n0 < split ? 0 : 128); }
    f32x4 wv[8];
#pragma unroll
    for (int i = 0; i < 8; ++i) wv[i] = *(const f32x4*)(W + (size_t)(k0 + 8 * i + (lane >> 3)) * N + n0 + 4 * (lane & 7));
#pragma unroll
    for (int i = 0; i < 8; ++i) { LAS float* d = scr + (8 * i + (lane >> 3)) * 33 + 4 * (lane & 7); d[0] = wv[i].x; d[1] = wv[i].y; d[2] = wv[i].z; d[3] = wv[i].w; }
    asm volatile("s_waitcnt lgkmcnt(0)" ::: "memory");
    const int c = lane & 7;
#pragma unroll
    for (int j = 0; j < 4; ++j) { const int n = (lane >> 3) + 8 * j; const LAS float* sp = scr + (8 * c) * 33 + n;
        u32x4 o; o.x = pk2(sp[0 * 33], sp[1 * 33]); o.y = pk2(sp[2 * 33], sp[3 * 33]); o.z = pk2(sp[4 * 33], sp[5 * 33]); o.w = pk2(sp[6 * 33], sp[7 * 33]);
        *(u32x4*)(WT + (size_t)(r0 + n) * K + k0 + 8 * c) = o; }
    asm volatile("s_waitcnt lgkmcnt(0)" ::: "memory");
}
__device__ __forceinline__ void ph_cvt_weights(const Frame& F0) {
    const Frame F = launder(F0);
    LAS float* scr = (LAS float*)(F.lds + F.wave * 16384);
    int it = F.gw;
#define CVT(Wp, K_, N_, dst, split) do { const int ni = ((K_) / 64) * ((N_) / 32); for (; it < ni; it += F.NGW) cvt_item((Wp), (K_), (N_), (dst), (split), scr, it, F.lane); it -= ni; } while (0)
#pragma unroll 1
    for (int m = 0; m < 8; ++m) CVT(F.in[IN_FFNWI] + (size_t)m * D * 2 * DFF, D, 2 * DFF, F.WT() + WT_FFNWI + (size_t)m * D * 2 * DFF, DFF);
#pragma unroll 1
    for (int m = 0; m < 8; ++m) CVT(F.in[IN_FFNWO] + (size_t)m * DFF * D, DFF, D, F.WT() + WT_FFNWO + (size_t)m * DFF * D, 0);
    CVT(F.in[IN_AWQKV], D, QKVW, F.WT() + WT_AWQKV, 0);
    CVT(F.in[IN_AWO], D, D, F.WT() + WT_AWO, 0);
    CVT(F.in[IN_S5WGLU], D, 2 * D, F.WT() + WT_GLU, D);
    CVT(F.in[IN_MWIN], D, MINW, F.WT() + WT_MWIN, 0);
    CVT(F.in[IN_MWGATE], D, 32, F.WT() + WT_MWIN + (size_t)MINW * D, 0);
    CVT(F.in[IN_MWOUT], D, D, F.WT() + WT_MWOUT, 0);
    CVT(F.in[IN_WWQKV], D, QKVW, F.WT() + WT_WWQKV, 0);
    CVT(F.in[IN_WWO], D, D, F.WT() + WT_WWO, 0);
#undef CVT
}

__device__ __forceinline__ void ph_qknorm_rope(const Frame& F0, const float* qkg) {
    const Frame F = launder(F0);
    const int lane = F.lane; const float g1q = qkg[lane] * 0.08838834764831845f, g2q = qkg[64 + lane] * 0.08838834764831845f, g1k = qkg[HD + lane], g2k = qkg[HD + 64 + lane];
    const float inv = exp2f(-(float)(lane & 31) * (13.287712379549449f / 32.0f));
    for (int r = F.gw; r < NR; r += F.NGW) {
        const int b = r / TPB, p = r - b * TPB;
        bf16* qb = F.Q() + (size_t)r * QW; bf16* kb = F.K() + (size_t)r * KVW;
        float x1[20], x2[20];
#pragma unroll
        for (int h = 0; h < 20; ++h) { const bf16* base = h < 16 ? qb + h * HD : kb + (h - 16) * HD; x1[h] = bf2f(base[lane]); x2[h] = bf2f(base[64 + lane]); }
        float cs = 1.f, sn = 0.f;
        if (p >= CTXL) { const int t = p - CTXL; const float pos = (lane < 32) ? (float)(t / GRID_W) : (float)(t % GRID_W); sincosf(pos * inv, &sn, &cs); }
#pragma unroll
        for (int h = 0; h < 20; ++h) {
            const float ss = wave_sum(x1[h] * x1[h] + x2[h] * x2[h]); const float rstd = 1.0f / sqrtf(ss * (1.0f / HD) + NORM_EPS);
            const float a1 = x1[h] * rstd * (h < 16 ? g1q : g1k), a2 = x2[h] * rstd * (h < 16 ? g2q : g2k);
            x1[h] = a1 * cs - a2 * sn; x2[h] = a2 * cs + a1 * sn; }
#pragma unroll
        for (int h = 0; h < 20; ++h) { bf16* base = h < 16 ? qb + h * HD : kb + (h - 16) * HD; base[lane] = (bf16)f2bf(x1[h]); base[64 + lane] = (bf16)f2bf(x2[h]); }
    }
}
template <bool WINDOW>
__device__ __forceinline__ void ph_attn_naive(const Frame& F0, const float* sink) {
    const Frame F = launder(F0);
    const int lane = F.lane;
    for (int it = F.gw; it < NR * NH; it += F.NGW) {
        const int r = it / NH, h = it % NH; const int b = r / TPB, p = r - b * TPB; const int kv = h / 4;
        if (WINDOW && p < CTXL) continue;
        const unsigned qw = *(const unsigned*)(F.Q() + (size_t)r * QW + h * HD + 2 * lane); const float q0 = bf2f(qw & 0xffffu), q1 = bf2f(qw >> 16);
        float m = -1e30f, l = 0.f, o0 = 0.f, o1 = 0.f;
        int lo2, hi2;
        if (p < CTXL) { lo2 = 0; hi2 = 0; } else if (WINDOW) { const int t = p - CTXL; lo2 = CTXL + (t - 128 < 0 ? 0 : t - 128); hi2 = CTXL + (t + 128 > SEQ - 1 ? SEQ - 1 : t + 128) + 1; } else { lo2 = CTXL; hi2 = TPB; }
        for (int seg = 0; seg < 2; ++seg) { const int lo = seg ? lo2 : 0, hi = seg ? hi2 : CTXL;
            for (int kp = lo; kp < hi; ++kp) {
                const size_t kr = (size_t)(b * TPB + kp) * KVW + kv * HD + 2 * lane;
                const unsigned kw = *(const unsigned*)(F.K() + kr), vw = *(const unsigned*)(F.V() + kr);
                const float s = wave_sum(q0 * bf2f(kw & 0xffffu) + q1 * bf2f(kw >> 16));
                const float mn = fmaxf(m, s); const float al = __expf(m - mn), pe = __expf(s - mn);
                l = l * al + pe; o0 = o0 * al + pe * bf2f(vw & 0xffffu); o1 = o1 * al + pe * bf2f(vw >> 16); m = mn;
            } }
        if (WINDOW) { const float sk = sink[h]; const float mn = fmaxf(m, sk); const float al = __expf(m - mn); l = l * al + __expf(sk - mn); o0 *= al; o1 *= al; }
        const float il = 1.0f / l;
        *(unsigned*)(F.O() + (size_t)r * QW + h * HD + 2 * lane) = pk2(o0 * il, o1 * il);
    }
}
namespace att {
using bf16x8 = __attribute__((ext_vector_type(8))) short;
using s16x4  = __attribute__((ext_vector_type(4))) short;
using f32x16 = __attribute__((ext_vector_type(16))) float;
using u32x4v = __attribute__((ext_vector_type(4))) unsigned;
constexpr int QBLK = 32, KVBLK = 64, LDQ = QW, LDK = KVW, LDO = QW, AD = 128;
#ifndef ATT_SDEPTH
#define ATT_SDEPTH 1
#endif
constexpr int SDEPTH = ATT_SDEPTH;
constexpr float THR = 8.f, C = 1.4426950408889634f;
constexpr size_t SHM_V = KVBLK * AD * 2, SHM_K = KVBLK * AD * 2, SHM_ATTN = 2 * SHM_V + 2 * SHM_K + 8 * 64 * 4;
#define KSWZ(row, colB) ((row) * 256 + ((colB) ^ (((row) & 7) << 4)))
#define SBAR() __builtin_amdgcn_sched_barrier(0)
__device__ __forceinline__ int crow(int r, int hi) { return (r & 3) + 8 * (r >> 2) + 4 * hi; }
__device__ __forceinline__ unsigned cvtpk(float lo, float hi) { return pk2(lo, hi); }
__device__ __forceinline__ void partialSM(f32x16& p0, f32x16& p1, float& m_reg, float& mn, float& alpha) {
  float pmax = p0[0]; for (int r = 1; r < 16; ++r) pmax = fmaxf(pmax, p0[r]); for (int r = 0; r < 16; ++r) pmax = fmaxf(pmax, p1[r]);
  { auto rr = __builtin_amdgcn_permlane32_swap(__float_as_uint(pmax), __float_as_uint(pmax), false, false);
    pmax = fmaxf(__uint_as_float(rr[0]), __uint_as_float(rr[1])); }
  if (__builtin_expect(__all(pmax - m_reg <= THR), 1)) { mn = m_reg; alpha = 1.f; }
  else { mn = fmaxf(m_reg, pmax); alpha = __builtin_amdgcn_exp2f((m_reg - mn) * C); m_reg = mn; }
  float mnC = -mn * C;
  for (int r = 0; r < 16; ++r) p0[r] = fmaf(p0[r], C, mnC); for (int r = 0; r < 16; ++r) p1[r] = fmaf(p1[r], C, mnC);
  for (int r = 0; r < 16; ++r) p0[r] = __builtin_amdgcn_exp2f(p0[r]);
}
__device__ __forceinline__ void finishSM(f32x16& p0, f32x16& p1, float alpha, float& l_reg, bf16x8& pa0, bf16x8& pa1, bf16x8& pa2, bf16x8& pa3) {
  for (int r = 0; r < 16; ++r) p1[r] = __builtin_amdgcn_exp2f(p1[r]);
  float ps = 0; for (int r = 0; r < 16; ++r) ps += p0[r]; for (int r = 0; r < 16; ++r) ps += p1[r];
  { auto rr = __builtin_amdgcn_permlane32_swap(__float_as_uint(ps), __float_as_uint(ps), false, false);
    ps = __uint_as_float(rr[0]) + __uint_as_float(rr[1]); }
  l_reg = l_reg * alpha + ps;
#define PK4(P, BASE, OUT) do { unsigned a0 = cvtpk(P[BASE + 0], P[BASE + 1]), a1 = cvtpk(P[BASE + 2], P[BASE + 3]);   \
    unsigned b0 = cvtpk(P[BASE + 4], P[BASE + 5]), b1 = cvtpk(P[BASE + 6], P[BASE + 7]);                              \
    auto r0 = __builtin_amdgcn_permlane32_swap(a0, b0, false, false); auto r1 = __builtin_amdgcn_permlane32_swap(a1, b1, false, false); \
    u32x4v w = {r0[0], r1[0], r0[1], r1[1]}; OUT = *reinterpret_cast<bf16x8*>(&w); } while (0)
  PK4(p0, 0, pa0); PK4(p0, 8, pa1); PK4(p1, 0, pa2); PK4(p1, 8, pa3);
#undef PK4
}
__device__ __forceinline__ void qkt(f32x16& p0, f32x16& p1, const bf16* Ks, const bf16x8* qr, int r32, int hi) {
  p0 = f32x16{}; p1 = f32x16{};
  for (int d0 = 0; d0 < 8; ++d0) { int cb = (d0 * 16 + hi * 8) * 2;
    bf16x8 b0 = *reinterpret_cast<const bf16x8*>((const char*)Ks + KSWZ(r32, cb));
    bf16x8 b1 = *reinterpret_cast<const bf16x8*>((const char*)Ks + KSWZ(32 + r32, cb));
    p0 = __builtin_amdgcn_mfma_f32_32x32x16_bf16(b0, qr[d0], p0, 0, 0, 0);
    p1 = __builtin_amdgcn_mfma_f32_32x32x16_bf16(b1, qr[d0], p1, 0, 0, 0); }
}
__device__ __forceinline__ void band_mask(f32x16& p0, f32x16& p1, int tq, int tk0, int hi) {
#pragma unroll
  for (int r = 0; r < 16; ++r) { const int d = tq - (tk0 + crow(r, hi)); if (d > 128 || d < -128) p0[r] = -1e30f; const int d1 = d - 32; if (d1 > 128 || d1 < -128) p1[r] = -1e30f; }
}
__device__ __forceinline__ int v_st(int k, int c) { const int kk = (k & ~0xC) | ((k & 4) << 1) | ((k & 8) >> 1); return ((kk >> 3) * 4 + (c >> 5)) * 512 + ((kk & 7) * 32 + (c & 31)) * 2; }
__device__ __forceinline__ int v_rd_base(int lane) { return ((lane & 3) << 3) | (((lane >> 2) & 3) << 6) | (((lane >> 4) & 1) << 5) | (((lane >> 5) & 1) << 8); }
constexpr int v_rd_off(int d0, int ks, int half) { return d0 * 512 + ks * 4096 + half * 2048; }
template <int OFF> __device__ __forceinline__ s16x4 tr_read(int vb) {
  s16x4 r; asm volatile("ds_read_b64_tr_b16 %0, %1 offset:%2" : "=&v"(r) : "v"(vb), "i"(OFF) : "memory"); return r;
}
template <int D0> __device__ __forceinline__ void pv_one(f32x16& od, int vb, bf16x8 pa0, bf16x8 pa1, bf16x8 pa2, bf16x8 pa3) {
  const s16x4 l0 = tr_read<v_rd_off(D0, 0, 0)>(vb), h0 = tr_read<v_rd_off(D0, 0, 1)>(vb), l1 = tr_read<v_rd_off(D0, 1, 0)>(vb), h1 = tr_read<v_rd_off(D0, 1, 1)>(vb);
  const s16x4 l2 = tr_read<v_rd_off(D0, 2, 0)>(vb), h2 = tr_read<v_rd_off(D0, 2, 1)>(vb), l3 = tr_read<v_rd_off(D0, 3, 0)>(vb), h3 = tr_read<v_rd_off(D0, 3, 1)>(vb);
  asm volatile("s_waitcnt lgkmcnt(0)" ::: "memory"); SBAR();
#define PK(L, H) (bf16x8){L[0], L[1], L[2], L[3], H[0], H[1], H[2], H[3]}
  od = __builtin_amdgcn_mfma_f32_32x32x16_bf16(pa0, PK(l0, h0), od, 0, 0, 0);
  od = __builtin_amdgcn_mfma_f32_32x32x16_bf16(pa1, PK(l1, h1), od, 0, 0, 0);
  od = __builtin_amdgcn_mfma_f32_32x32x16_bf16(pa2, PK(l2, h2), od, 0, 0, 0);
  od = __builtin_amdgcn_mfma_f32_32x32x16_bf16(pa3, PK(l3, h3), od, 0, 0, 0);
#undef PK
}
__device__ __forceinline__ void pv_d0(f32x16* o, int vb, bf16x8 pa0, bf16x8 pa1, bf16x8 pa2, bf16x8 pa3) {
  pv_one<0>(o[0], vb, pa0, pa1, pa2, pa3); pv_one<1>(o[1], vb, pa0, pa1, pa2, pa3); pv_one<2>(o[2], vb, pa0, pa1, pa2, pa3); pv_one<3>(o[3], vb, pa0, pa1, pa2, pa3);
}
template <bool WINDOW>
__device__ __forceinline__ void attn_body(int tid, const bf16* __restrict__ Qb, const bf16* __restrict__ Kh, const bf16* __restrict__ Vh, bf16* __restrict__ Ob, int NT, int kband, int tkb, int T0, float sink, char* lds) {
  const int wid = tid >> 6, lane = tid & 63, r32 = lane & 31, hi = lane >> 5;
  bf16* V_lds = (bf16*)lds; bf16* K_lds = (bf16*)(lds + 2 * SHM_V);
  float* ws = (float*)(lds + 2 * SHM_V + 2 * SHM_K) + wid * 64; float* li_l = ws; float* al_l = ws + 32;
  float m_reg = -1e30f, l_reg = 0; f32x16 o[4] = {}; bf16x8 qr[8];
  const bf16* Qw = Qb + (long)(wid * QBLK + r32) * LDQ + hi * 8;
#pragma unroll
  for (int d0 = 0; d0 < 8; ++d0) qr[d0] = *reinterpret_cast<const bf16x8*>(Qw + d0 * 16);
  const int sr = tid >> 4, sc = (tid & 15) * 8, vst0 = v_st(sr, sc), vst1 = v_st(32 + sr, sc);
  const int vb0 = (int)(uintptr_t)V_lds + v_rd_base(lane);
  const int tq = T0 + wid * QBLK + r32;
  struct { bf16x8 vs0, vs1, ks0, ks1; } sr_[SDEPTH];
#define KOFF(j) ((j) < 4 ? 64 * (j) : kband + 64 * ((j) - 4))
#define SLOAD(i, jt) do { const int k0_ = KOFF(jt); sr_[i].vs0 = *reinterpret_cast<const bf16x8*>(&Vh[(long)(k0_ + sr) * LDK + sc]); sr_[i].vs1 = *reinterpret_cast<const bf16x8*>(&Vh[(long)(k0_ + 32 + sr) * LDK + sc]); \
    sr_[i].ks0 = *reinterpret_cast<const bf16x8*>(&Kh[(long)(k0_ + sr) * LDK + sc]); sr_[i].ks1 = *reinterpret_cast<const bf16x8*>(&Kh[(long)(k0_ + 32 + sr) * LDK + sc]); } while (0)
#define SWRITE(b, i) do { *(bf16x8*)((char*)V_lds + (b) * SHM_V + vst0) = sr_[i].vs0;          \
    *(bf16x8*)((char*)V_lds + (b) * SHM_V + vst1) = sr_[i].vs1; int kc = sc * 2;               \
    *(bf16x8*)((char*)K_lds + (b) * SHM_K + KSWZ(sr, kc)) = sr_[i].ks0;                       \
    *(bf16x8*)((char*)K_lds + (b) * SHM_K + KSWZ(32 + sr, kc)) = sr_[i].ks1; } while (0)
#define SWAIT() do { if constexpr (SDEPTH == 2) asm volatile("s_waitcnt vmcnt(4)" ::: "memory"); else asm volatile("s_waitcnt vmcnt(0)" ::: "memory"); } while (0)
#define RESC(a) do { if (__any((a) < 1.f)) { if (hi == 0) al_l[r32] = (a); asm volatile("s_waitcnt lgkmcnt(0)" ::: "memory"); \
    for (int d = 0; d < 4; ++d) for (int r = 0; r < 16; ++r) o[d][r] *= al_l[crow(r, hi)]; } } while (0)
#define MASK(P0, P1, jt) do { if (WINDOW && (jt) >= 4) band_mask(P0, P1, tq, tkb + 64 * ((jt) - 4), hi); } while (0)
  f32x16 pA0, pA1, pB0, pB1; float mnA, mnB, alA, alB; bf16x8 pa0, pa1, pa2, pa3;
  constexpr int SE = 0, SO = SDEPTH - 1;
  SLOAD(SE, 0); asm volatile("s_waitcnt vmcnt(0)" ::: "memory"); SWRITE(0, SE); __syncthreads();
  qkt(pA0, pA1, K_lds, qr, r32, hi); partialSM(pA0, pA1, m_reg, mnA, alA);
  SLOAD(SO, 1); if constexpr (SDEPTH == 2) { if (2 < NT) SLOAD(SE, 2); }
  SWAIT(); SWRITE(1, SO); __syncthreads();
  for (int j = 1; j + 1 < NT; j += 2) {
    SBAR(); qkt(pB0, pB1, (bf16*)((char*)K_lds + SHM_K), qr, r32, hi); MASK(pB0, pB1, j);
    finishSM(pA0, pA1, alA, l_reg, pa0, pa1, pa2, pa3); SBAR();
    SLOAD(SO, j + SDEPTH); SBAR();
    pv_d0(o, vb0, pa0, pa1, pa2, pa3); partialSM(pB0, pB1, m_reg, mnB, alB);
    __syncthreads(); SWAIT(); SWRITE(0, SE);
    RESC(alB); __syncthreads();
    SBAR(); qkt(pA0, pA1, K_lds, qr, r32, hi); MASK(pA0, pA1, j + 1);
    finishSM(pB0, pB1, alB, l_reg, pa0, pa1, pa2, pa3); SBAR();
    if (SDEPTH == 1 || j + 3 < NT) SLOAD(SE, j + 1 + SDEPTH); SBAR();
    pv_d0(o, vb0 + (int)SHM_V, pa0, pa1, pa2, pa3); partialSM(pA0, pA1, m_reg, mnA, alA);
    __syncthreads(); SWAIT(); SWRITE(1, SO);
    RESC(alA); __syncthreads();
  }
  SBAR(); qkt(pB0, pB1, (bf16*)((char*)K_lds + SHM_K), qr, r32, hi); MASK(pB0, pB1, NT - 1);
  finishSM(pA0, pA1, alA, l_reg, pa0, pa1, pa2, pa3); SBAR();
  pv_d0(o, vb0, pa0, pa1, pa2, pa3); partialSM(pB0, pB1, m_reg, mnB, alB);
  __syncthreads(); RESC(alB);
  finishSM(pB0, pB1, alB, l_reg, pa0, pa1, pa2, pa3); SBAR();
  pv_d0(o, vb0 + (int)SHM_V, pa0, pa1, pa2, pa3);
  if (WINDOW) l_reg += __builtin_amdgcn_exp2f((sink - m_reg) * C);
  if (hi == 0) li_l[r32] = l_reg; asm volatile("s_waitcnt lgkmcnt(0)" ::: "memory");
  float rli[16];
#pragma unroll
  for (int r = 0; r < 16; ++r) rli[r] = __builtin_amdgcn_rcpf(li_l[crow(r, hi)]);
  bf16* Ow = Ob + (long)(wid * QBLK) * LDO;
#pragma unroll
  for (int r = 0; r < 16; ++r) { int orow = crow(r, hi);
    for (int d0 = 0; d0 < 4; ++d0) Ow[(long)orow * LDO + d0 * 32 + r32] = (bf16)f2bf(o[d0][r] * rli[r]); }
#undef KOFF
#undef SLOAD
#undef SWRITE
#undef SWAIT
#undef RESC
#undef MASK
}

constexpr int ML_QI = 0, ML_KI = 16384, ML_KV = 32768, ML_VV = 49152, ML_WV = 65536, ML_CI = 81920, ML_CIB = 24576, ML_SC = 132096;
template <bool MAX> __device__ __forceinline__ float dpp_scan(float v) {
    constexpr int idn = MAX ? (int)0xff800000 : 0;
#define DPP_STEP(ctrl, rmask) { const float t_ = __int_as_float(__builtin_amdgcn_update_dpp(idn, __float_as_int(v), ctrl, rmask, 0xf, false)); v = MAX ? fmaxf(v, t_) : v + t_; }
    DPP_STEP(0x111, 0xf) DPP_STEP(0x112, 0xf) DPP_STEP(0x114, 0xf) DPP_STEP(0x118, 0xf) DPP_STEP(0x142, 0xa) DPP_STEP(0x143, 0xc)
#undef DPP_STEP
    return v;
}
__device__ __forceinline__ void mlstm_scalars(float ig, float fg, float& m_prev, float* sc, int lane) {
    const float logf = fminf(fg, 0.f) - log1pf(__expf(-fabsf(fg)));
    const float bc = dpp_scan<false>(logf);
    const float b_end = __int_as_float(__builtin_amdgcn_readlane(__float_as_int(bc), 63));
    const float beta = ig - bc; const float wl = b_end + beta;
    const float pm = dpp_scan<true>(beta);
    const float mxall = b_end + __int_as_float(__builtin_amdgcn_readlane(__float_as_int(pm), 63));
    const float m_new = fmaxf(b_end + m_prev, mxall);
    const float m_t = bc + fmaxf(pm, m_prev);
    sc[lane] = bc - m_t - 2.4260151319598084f;
    sc[64 + lane] = beta;
    sc[128 + lane] = 0.08838834764831845f * __expf(bc + m_prev - m_t);
    sc[192 + lane] = __expf(wl - m_new);
    sc[256 + lane] = __expf(-m_t);
    if (lane == 0) sc[320] = __expf(b_end + m_prev - m_new);
    m_prev = m_new;
}
__device__ __forceinline__ void ph_mlstm_body(int tid, const bf16* __restrict__ QKVO_, const float* __restrict__ gates, float* __restrict__ HD_, int b, int hh, int dr, int vq, char* lds) {
    const int wid = __builtin_amdgcn_readfirstlane(tid >> 6), lane = tid & 63;
    float* scal = (float*)(lds + ML_SC);
    for (int i = tid; i < 2 * ML_CIB / 16; i += 512) *(u32x4v*)(lds + ML_CI + i * 16) = (u32x4v){0u, 0u, 0u, 0u};
    float m_prev = 0.f;
    const int gcol = dr * 16 + hh;
    const size_t bq = (size_t)hh * MDQK, bk = (size_t)MQKW + hh * MDQK, bv = (size_t)2 * MQKW + hh * MDV + vq * 64;
#define ML_ROWBASE(c) (dr == 0 ? 64 * (c) : ((c) < 4 ? 255 - 64 * (c) : 2303 - 64 * ((c) - 4)))
    const int sg = dr == 0 ? 1 : -1;
    float ig_n = 0.f, fg_n = 0.f;
#define ML_GLOAD(c) do { const size_t r_ = (size_t)(b * TPB + ML_ROWBASE(c) + sg * lane); ig_n = gates[r_ * 32 + gcol]; fg_n = gates[r_ * 32 + gcol + 8]; } while (0)
    if (wid == 7) { ML_GLOAD(0); mlstm_scalars(ig_n, fg_n, m_prev, scal, lane); ML_GLOAD(1); }
    const int sr = tid >> 4, scq = (tid & 15) * 8, vr = tid >> 3, vc = (tid & 7) * 8;
    bf16x8 gq0, gq1, gk0, gk1, gv;
#define ML_LOAD(c) do { const int rb_ = b * TPB + ML_ROWBASE(c); const bf16* r0_ = QKVO_ + (size_t)(rb_ + sg * sr) * MINW; const bf16* r1_ = QKVO_ + (size_t)(rb_ + sg * (32 + sr)) * MINW; const bf16* rv_ = QKVO_ + (size_t)(rb_ + sg * vr) * MINW; \
    gq0 = *(const bf16x8*)(r0_ + bq + scq); gq1 = *(const bf16x8*)(r1_ + bq + scq); gk0 = *(const bf16x8*)(r0_ + bk + scq); gk1 = *(const bf16x8*)(r1_ + bk + scq); gv = *(const bf16x8*)(rv_ + bv + vc); } while (0)
    ML_LOAD(0);
    f32x16 acc0 = {}, acc1 = {}, acc2 = {};
    const int kt = wid - 4;
    const int vbK = (int)(uintptr_t)(lds + ML_KV) + v_rd_base(lane), vbV = (int)(uintptr_t)(lds + ML_VV) + v_rd_base(lane), vbW = (int)(uintptr_t)(lds + ML_WV) + v_rd_base(lane);
    __syncthreads();
    constexpr int NCH = TPB / 64;
#pragma unroll 1
    for (int c = 0; c < NCH; ++c) {
        int lane_c = lane; asm volatile("" : "+v"(lane_c));
        const int r32 = lane_c & 31, hi = lane_c >> 5;
        const float* sc = scal + (c & 1) * 384; float* scn = scal + ((c + 1) & 1) * 384;
        char* CIcur = lds + ML_CI + (c & 1) * ML_CIB; char* CInext = lds + ML_CI + ((c + 1) & 1) * ML_CIB;
        asm volatile("s_waitcnt vmcnt(0)" ::: "memory");
        *(bf16x8*)(lds + ML_QI + KSWZ(sr, scq * 2)) = gq0; *(bf16x8*)(lds + ML_QI + KSWZ(32 + sr, scq * 2)) = gq1;
        *(bf16x8*)(lds + ML_KI + KSWZ(sr, scq * 2)) = gk0; *(bf16x8*)(lds + ML_KI + KSWZ(32 + sr, scq * 2)) = gk1;
        *(bf16x8*)(lds + ML_KV + v_st(sr, scq)) = gk0; *(bf16x8*)(lds + ML_KV + v_st(32 + sr, scq)) = gk1;
        *(bf16x8*)(lds + ML_VV + v_st(vr, vc)) = gv;
        { const float w = sc[192 + vr]; u32x4v gw = *reinterpret_cast<u32x4v*>(&gv), o;
          o.x = cvtpk(w * bf2f(gw.x & 0xffffu), w * bf2f(gw.x >> 16)); o.y = cvtpk(w * bf2f(gw.y & 0xffffu), w * bf2f(gw.y >> 16)); o.z = cvtpk(w * bf2f(gw.z & 0xffffu), w * bf2f(gw.z >> 16)); o.w = cvtpk(w * bf2f(gw.w & 0xffffu), w * bf2f(gw.w >> 16));
          *(u32x4v*)(lds + ML_WV + v_st(vr, vc)) = o; }
        if (tid < 64) *(bf16*)(lds + ML_WV + v_st(tid, 64)) = (bf16)f2bf(sc[192 + tid]);
        __syncthreads();
        if (c + 1 < NCH) ML_LOAD(c + 1);
        f32x16 o_in = {}, o_x = {}; int tt = 0, vt = 0;
        if (wid < 4) {
            tt = wid >> 1; vt = wid & 1;
            bf16x8 qr[8];
#pragma unroll
            for (int d0 = 0; d0 < 8; ++d0) qr[d0] = *reinterpret_cast<const bf16x8*>(lds + ML_QI + KSWZ(32 * tt + r32, (d0 * 16 + hi * 8) * 2));
            f32x16 p0, p1; qkt(p0, p1, (const bf16*)(lds + ML_KI), qr, r32, hi);
            const int t = 32 * tt + r32; const float al = sc[t];
#pragma unroll
            for (int r = 0; r < 16; ++r) { const int s0 = crow(r, hi); const float e0 = __expf(al + sc[64 + s0]), e1 = __expf(al + sc[64 + 32 + s0]);
                p0[r] = s0 <= t ? p0[r] * e0 : 0.f; p1[r] = s0 + 32 <= t ? p1[r] * e1 : 0.f; }
            float ds = 0.f;
#pragma unroll
            for (int r = 0; r < 16; ++r) ds += p0[r] + p1[r];
            { auto rr = __builtin_amdgcn_permlane32_swap(__float_as_uint(ds), __float_as_uint(ds), false, false); ds = __uint_as_float(rr[0]) + __uint_as_float(rr[1]); }
            if (vt == 0 && hi == 0) scal[768 + t] = ds;
            bf16x8 pa0, pa1, pa2, pa3;
#define PK4(P, BASE, OUT) do { unsigned a0 = cvtpk(P[BASE + 0], P[BASE + 1]), a1 = cvtpk(P[BASE + 2], P[BASE + 3]);   \
    unsigned b0 = cvtpk(P[BASE + 4], P[BASE + 5]), b1 = cvtpk(P[BASE + 6], P[BASE + 7]);                              \
    auto r0 = __builtin_amdgcn_permlane32_swap(a0, b0, false, false); auto r1 = __builtin_amdgcn_permlane32_swap(a1, b1, false, false); \
    u32x4v w = {r0[0], r1[0], r0[1], r1[1]}; OUT = *reinterpret_cast<bf16x8*>(&w); } while (0)
            PK4(p0, 0, pa0); PK4(p0, 8, pa1); PK4(p1, 0, pa2); PK4(p1, 8, pa3);
#undef PK4
            if (vt == 0) pv_one<0>(o_in, vbV, pa0, pa1, pa2, pa3); else pv_one<1>(o_in, vbV, pa0, pa1, pa2, pa3);
#pragma unroll
            for (int d0 = 0; d0 < 8; ++d0) { const bf16x8 cf = *reinterpret_cast<const bf16x8*>(CIcur + KSWZ(32 * vt + r32, (d0 * 16 + hi * 8) * 2)); o_x = __builtin_amdgcn_mfma_f32_32x32x16_bf16(qr[d0], cf, o_x, 0, 0, 0); }
        } else {
            const float decay = sc[320];
#pragma unroll
            for (int r = 0; r < 16; ++r) { acc0[r] *= decay; acc1[r] *= decay; acc2[r] *= decay; }
#pragma unroll
            for (int ks = 0; ks < 4; ++ks) {
                s16x4 al_, ah_, b0l, b0h, b1l, b1h, b2l, b2h; const int ka = vbK + kt * 512 + ks * 4096, wa = vbW + ks * 4096;
                asm volatile("ds_read_b64_tr_b16 %0, %1" : "=&v"(al_) : "v"(ka) : "memory"); asm volatile("ds_read_b64_tr_b16 %0, %1 offset:2048" : "=&v"(ah_) : "v"(ka) : "memory");
                asm volatile("ds_read_b64_tr_b16 %0, %1" : "=&v"(b0l) : "v"(wa) : "memory"); asm volatile("ds_read_b64_tr_b16 %0, %1 offset:2048" : "=&v"(b0h) : "v"(wa) : "memory");
                asm volatile("ds_read_b64_tr_b16 %0, %1 offset:512" : "=&v"(b1l) : "v"(wa) : "memory"); asm volatile("ds_read_b64_tr_b16 %0, %1 offset:2560" : "=&v"(b1h) : "v"(wa) : "memory");
                asm volatile("ds_read_b64_tr_b16 %0, %1 offset:1024" : "=&v"(b2l) : "v"(wa) : "memory"); asm volatile("ds_read_b64_tr_b16 %0, %1 offset:3072" : "=&v"(b2h) : "v"(wa) : "memory");
                asm volatile("s_waitcnt lgkmcnt(0)" ::: "memory"); SBAR();
#define PK(L, H) (bf16x8){L[0], L[1], L[2], L[3], H[0], H[1], H[2], H[3]}
                const bf16x8 af = PK(al_, ah_);
                acc0 = __builtin_amdgcn_mfma_f32_32x32x16_bf16(af, PK(b0l, b0h), acc0, 0, 0, 0);
                acc1 = __builtin_amdgcn_mfma_f32_32x32x16_bf16(af, PK(b1l, b1h), acc1, 0, 0, 0);
                acc2 = __builtin_amdgcn_mfma_f32_32x32x16_bf16(af, PK(b2l, b2h), acc2, 0, 0, 0);
#undef PK
            }
#pragma unroll
            for (int q = 0; q < 4; ++q) { const int cb = (32 * kt + 8 * q + 4 * hi) * 2;
                u32x2 w0; w0.x = cvtpk(acc0[4 * q], acc0[4 * q + 1]); w0.y = cvtpk(acc0[4 * q + 2], acc0[4 * q + 3]); *(u32x2*)(CInext + KSWZ(r32, cb)) = w0;
                u32x2 w1; w1.x = cvtpk(acc1[4 * q], acc1[4 * q + 1]); w1.y = cvtpk(acc1[4 * q + 2], acc1[4 * q + 3]); *(u32x2*)(CInext + KSWZ(32 + r32, cb)) = w1;
                if (r32 == 0) { u32x2 w2; w2.x = cvtpk(acc2[4 * q], acc2[4 * q + 1]); w2.y = cvtpk(acc2[4 * q + 2], acc2[4 * q + 3]); *(u32x2*)(CInext + KSWZ(64, cb)) = w2; } }
            if (wid < 6) {
                const int t2 = wid - 4; f32x16 o_n = {};
#pragma unroll
                for (int d0 = 0; d0 < 8; ++d0) { const bf16x8 qf = *reinterpret_cast<const bf16x8*>(lds + ML_QI + KSWZ(32 * t2 + r32, (d0 * 16 + hi * 8) * 2));
                    const bf16x8 cf = *reinterpret_cast<const bf16x8*>(CIcur + KSWZ(64 + r32, (d0 * 16 + hi * 8) * 2)); o_n = __builtin_amdgcn_mfma_f32_32x32x16_bf16(qf, cf, o_n, 0, 0, 0); }
                if (r32 == 0) {
#pragma unroll
                    for (int r = 0; r < 16; ++r) scal[832 + 32 * t2 + crow(r, hi)] = o_n[r]; }
            }
            if (wid == 7 && c + 1 < NCH) { const float ig_c = ig_n, fg_c = fg_n; if (c + 2 < NCH) ML_GLOAD(c + 2); mlstm_scalars(ig_c, fg_c, m_prev, scn, lane); }
        }
        __syncthreads();
        if (wid < 4) {
            const int rb = b * TPB + ML_ROWBASE(c);
#pragma unroll
            for (int r = 0; r < 16; ++r) { const int t = 32 * tt + crow(r, hi); const float ai = sc[128 + t];
                const float dn = fmaxf(fabsf(scal[768 + t] + ai * scal[832 + t]), sc[256 + t]);
                HD_[(size_t)(rb + sg * t) * D + hh * MDV + vq * 64 + 32 * vt + r32] = (o_in[r] + ai * o_x[r]) / dn; }
        }
    }
#undef ML_LOAD
#undef ML_GLOAD
#undef ML_ROWBASE
    __syncthreads();
}

constexpr int S5_IMG = 8192;
__device__ __forceinline__ int s5_st(int k, int t) { const int k6 = k & 63; const int kk = (k6 & ~0xC) | ((k6 & 4) << 1) | ((k6 & 8) >> 1); return (k >> 6) * 4096 + (kk >> 3) * 512 + ((kk & 7) * 32 + t) * 2; }
__device__ __forceinline__ void s5_disc(const float* lre, const float* lim, float dt, int n, float& ar, float& ai, float& kr, float& ki) {
    const float lr = fminf(lre[n], -1e-4f), li = lim[n]; const float mag = expf(lr * dt); float sn, cs; sincosf(li * dt, &sn, &cs); ar = mag * cs; ai = mag * sn;
    const float den = lr * lr + li * li; kr = ((ar - 1.f) * lr + ai * li) / den; ki = (ai * lr - (ar - 1.f) * li) / den;
}
__device__ __forceinline__ void s5_task(int lane, const float* const* in, const bf16* __restrict__ Hb, float* __restrict__ out, int b, int g, int dr, char* img) {
    const int r32 = lane & 31, hi = lane >> 5; const size_t pg = (size_t)(dr * S5G + g);
    const float dt = expf(in[IN_S5LDT][pg]); const float* lre = in[IN_S5LRE] + pg * S5N; const float* lim = in[IN_S5LIM] + pg * S5N;
    float ar, ai, kr_o, ki_o, ar2, ai2, kr_p, ki_p;
    s5_disc(lre, lim, dt, lane, ar, ai, kr_o, ki_o);
    float kr0, ki0, kr1, ki1;
    s5_disc(lre, lim, dt, r32, ar2, ai2, kr0, ki0); s5_disc(lre, lim, dt, 32 + r32, ar2, ai2, kr1, ki1); (void)kr_o; (void)ki_o; (void)kr_p; (void)ki_p;
    bf16x8 Bf[4];
#pragma unroll
    for (int q = 0; q < 4; ++q) { const int n = (q & 1) * 32 + r32; const float kr = (q & 1) ? kr1 : kr0, ki = (q & 1) ? ki1 : ki0;
        const float* bre = in[IN_S5BRE] + (pg * S5N + n) * 16 + 8 * hi; const float* bim = in[IN_S5BIM] + (pg * S5N + n) * 16 + 8 * hi; u32x4v w;
        float v[8];
#pragma unroll
        for (int j = 0; j < 8; ++j) v[j] = (q < 2) ? (kr * bre[j] - ki * bim[j]) : (kr * bim[j] + ki * bre[j]);
        w.x = cvtpk(v[0], v[1]); w.y = cvtpk(v[2], v[3]); w.z = cvtpk(v[4], v[5]); w.w = cvtpk(v[6], v[7]); Bf[q] = *reinterpret_cast<bf16x8*>(&w); }
    bf16x8 Cf[8];
#pragma unroll
    for (int kb = 0; kb < 8; ++kb) { u32x4v w = {0u, 0u, 0u, 0u};
        if (r32 < 16) { const int k0 = 16 * kb + 8 * hi; const float* cp = (k0 < 64 ? in[IN_S5CRE] : in[IN_S5CIM]) + (pg * 16 + r32) * S5N + (k0 & 63); const float sgn = k0 < 64 ? 1.f : -1.f;
            w.x = cvtpk(sgn * cp[0], sgn * cp[1]); w.y = cvtpk(sgn * cp[2], sgn * cp[3]); w.z = cvtpk(sgn * cp[4], sgn * cp[5]); w.w = cvtpk(sgn * cp[6], sgn * cp[7]); }
        Cf[kb] = *reinterpret_cast<bf16x8*>(&w); }
    float xr = 0.f, xi = 0.f;
    const int vb = (int)(uintptr_t)img + v_rd_base(lane);
#define S5_ROW(s) (dr == 0 ? (s) : ((s) < CTXL ? CTXL - 1 - (s) : TPB - 1 - ((s) - CTXL)))
    bf16x8 uf = *reinterpret_cast<const bf16x8*>(Hb + ((size_t)b * TPB + S5_ROW(r32)) * D + 16 * g + 8 * hi);
#pragma unroll 1
    for (int blk = 0; blk < TPB / 32; ++blk) {
        const bf16x8 ucur = uf;
        if (blk + 1 < TPB / 32) uf = *reinterpret_cast<const bf16x8*>(Hb + ((size_t)b * TPB + S5_ROW(32 * (blk + 1) + r32)) * D + 16 * g + 8 * hi);
        f32x16 d0 = {}, d1 = {}, d2 = {}, d3 = {};
        d0 = __builtin_amdgcn_mfma_f32_32x32x16_bf16(ucur, Bf[0], d0, 0, 0, 0); d1 = __builtin_amdgcn_mfma_f32_32x32x16_bf16(ucur, Bf[1], d1, 0, 0, 0);
        d2 = __builtin_amdgcn_mfma_f32_32x32x16_bf16(ucur, Bf[2], d2, 0, 0, 0); d3 = __builtin_amdgcn_mfma_f32_32x32x16_bf16(ucur, Bf[3], d3, 0, 0, 0);
#pragma unroll
        for (int r = 0; r < 16; ++r) { auto s0 = __builtin_amdgcn_permlane32_swap(__float_as_uint(d0[r]), __float_as_uint(d1[r]), false, false); d0[r] = __uint_as_float(s0[0]); d1[r] = __uint_as_float(s0[1]);
            auto s1 = __builtin_amdgcn_permlane32_swap(__float_as_uint(d2[r]), __float_as_uint(d3[r]), false, false); d2[r] = __uint_as_float(s1[0]); d3[r] = __uint_as_float(s1[1]); }
        unsigned pre[16], pim[16]; float lr_ = 0.f, li_ = 0.f;
#pragma unroll
        for (int t = 0; t < 32; ++t) { const int odd = (t >> 2) & 1, tt = odd ? t - 4 : t, r = (tt & 3) + 4 * (tt >> 3);
            const float br = odd ? d1[r] : d0[r], bi = odd ? d3[r] : d2[r];
            const float nr = fmaf(ar, xr, fmaf(-ai, xi, br)), ni = fmaf(ar, xi, fmaf(ai, xr, bi)); xr = nr; xi = ni;
            if (t & 1) { pre[t >> 1] = cvtpk(lr_, xr); pim[t >> 1] = cvtpk(li_, xi); } else { lr_ = xr; li_ = xi; } }
#pragma unroll
        for (int j = 0; j < 4; ++j) { *(u32x4v*)(img + s5_st(lane, 8 * j)) = (u32x4v){pre[4 * j], pre[4 * j + 1], pre[4 * j + 2], pre[4 * j + 3]};
            *(u32x4v*)(img + s5_st(64 + lane, 8 * j)) = (u32x4v){pim[4 * j], pim[4 * j + 1], pim[4 * j + 2], pim[4 * j + 3]}; }
        asm volatile("s_waitcnt lgkmcnt(0)" ::: "memory");
        f32x16 y = {};
#define S5_TR(KB, L, H) const s16x4 L = tr_read<((KB) >> 2) * 4096 + ((KB) & 3) * 1024>(vb), H = tr_read<((KB) >> 2) * 4096 + ((KB) & 3) * 1024 + 512>(vb)
        S5_TR(0, l0, h0); S5_TR(1, l1, h1); S5_TR(2, l2, h2); S5_TR(3, l3, h3); S5_TR(4, l4, h4); S5_TR(5, l5, h5); S5_TR(6, l6, h6); S5_TR(7, l7, h7);
        asm volatile("s_waitcnt lgkmcnt(0)" ::: "memory"); SBAR();
#define S5_MM(KB, L, H) y = __builtin_amdgcn_mfma_f32_32x32x16_bf16((bf16x8){L[0], L[1], L[2], L[3], H[0], H[1], H[2], H[3]}, Cf[KB], y, 0, 0, 0)
        S5_MM(0, l0, h0); S5_MM(1, l1, h1); S5_MM(2, l2, h2); S5_MM(3, l3, h3); S5_MM(4, l4, h4); S5_MM(5, l5, h5); S5_MM(6, l6, h6); S5_MM(7, l7, h7);
#undef S5_TR
#undef S5_MM
        if (r32 < 16) {
#pragma unroll
            for (int r = 0; r < 16; ++r) out[((size_t)b * TPB + S5_ROW(32 * blk + crow(r, hi))) * D + 16 * g + r32] = y[r]; }
    }
#undef S5_ROW
}
#undef KSWZ
#undef SBAR
}

template <bool WINDOW>
__device__ __forceinline__ void ph_attn_fast(const Frame& F0, const float* sinkp) {
    const Frame F = launder(F0);
    const int bx = blockIdx.x; const int vcu = (F.G % 8 == 0) ? (bx % 8) * (F.G / 8) + bx / 8 : bx;
    const int nlat = NB * NH * 8, nslots = nlat / 2 + (WINDOW ? 0 : NB * NH);
    for (int slot = vcu; slot < nslots; slot += F.G) {
#pragma unroll 1
        for (int k = 0; k < 2; ++k) {
            int u = slot < nlat / 2 ? 2 * slot + k : nlat + (slot - nlat / 2);
            if (slot >= nlat / 2 && k == 1) continue;
            int b, h, qb;
            if (u < nlat) { const int grp = u / 32, w = u % 32; b = grp / NKV; h = (grp % NKV) * 4 + w / 8; qb = 1 + w % 8; } else { const int c = u - nlat; b = c / NH; h = c % NH; qb = 0; }
            const int kv = h / 4; const size_t row0 = (size_t)b * TPB + qb * 256;
            const bf16* Qb = F.Q() + row0 * QW + h * HD; const bf16* Kh = F.K() + (size_t)b * TPB * KVW + kv * HD; const bf16* Vh = F.V() + (size_t)b * TPB * KVW + kv * HD; bf16* Ob = F.O() + row0 * QW + h * HD;
            int NT, kband = CTXL, tkb = 0, T0 = 0; float sk = 0.f;
            if (WINDOW) { T0 = (qb - 1) * 256; const int ks = T0 - 128 < 0 ? 0 : T0 - 128, ke = T0 + 384 > SEQ ? SEQ : T0 + 384; NT = 4 + (ke - ks) / 64; kband = CTXL + ks; tkb = ks; sk = sinkp[h]; }
            else NT = qb == 0 ? 4 : TPB / 64;
            att::attn_body<WINDOW>(F.tid, Qb, Kh, Vh, Ob, NT, kband, tkb, T0, sk, (char*)(unsigned char*)F.lds);
            __syncthreads();
        }
    }
}

__device__ __forceinline__ void ph_s5_naive(const Frame& F0) {
    const Frame F = launder(F0);
    const int n = F.lane;
    for (int it = F.gw; it < NB * S5G * 2; it += F.NGW) {
        const int dr = it & 1, g = (it >> 1) % S5G, b = it / (2 * S5G);
        const size_t pg = (size_t)(dr * S5G + g);
        const float lr = fminf(F.in[IN_S5LRE][pg * S5N + n], -1e-4f), li = F.in[IN_S5LIM][pg * S5N + n], dt = expf(F.in[IN_S5LDT][pg]);
        const float mag = expf(lr * dt); float sn, cs; sincosf(li * dt, &sn, &cs); const float ar = mag * cs, ai = mag * sn;
        const float den = lr * lr + li * li; const float kr = ((ar - 1.f) * lr + ai * li) / den, ki = (ai * lr - (ar - 1.f) * li) / den;
        float bre[16], bim[16], cre[16], cim[16];
#pragma unroll
        for (int c = 0; c < 16; ++c) { const float br_ = F.in[IN_S5BRE][(pg * S5N + n) * 16 + c], bi_ = F.in[IN_S5BIM][(pg * S5N + n) * 16 + c];
            bre[c] = kr * br_ - ki * bi_; bim[c] = kr * bi_ + ki * br_;
            cre[c] = F.in[IN_S5CRE][(pg * 16 + c) * S5N + n]; cim[c] = F.in[IN_S5CIM][(pg * 16 + c) * S5N + n]; }
        float xr = 0.f, xi = 0.f;
        float* out = F.HDb() + (size_t)dr * NR * D;
        for (int s = 0; s < TPB; ++s) {
            int p; if (dr == 0) p = s; else p = s < CTXL ? CTXL - 1 - s : TPB - 1 - (s - CTXL);
            const size_t r = (size_t)b * TPB + p;
            const u32x4 u0 = *(const u32x4*)(F.H() + r * D + 16 * g), u1 = *(const u32x4*)(F.H() + r * D + 16 * g + 8);
            float u[16]; u[0] = bf2f(u0.x & 0xffffu); u[1] = bf2f(u0.x >> 16); u[2] = bf2f(u0.y & 0xffffu); u[3] = bf2f(u0.y >> 16); u[4] = bf2f(u0.z & 0xffffu); u[5] = bf2f(u0.z >> 16); u[6] = bf2f(u0.w & 0xffffu); u[7] = bf2f(u0.w >> 16);
            u[8] = bf2f(u1.x & 0xffffu); u[9] = bf2f(u1.x >> 16); u[10] = bf2f(u1.y & 0xffffu); u[11] = bf2f(u1.y >> 16); u[12] = bf2f(u1.z & 0xffffu); u[13] = bf2f(u1.z >> 16); u[14] = bf2f(u1.w & 0xffffu); u[15] = bf2f(u1.w >> 16);
            float br = 0.f, bi = 0.f;
#pragma unroll
            for (int c = 0; c < 16; ++c) { br += bre[c] * u[c]; bi += bim[c] * u[c]; }
            const float nr = ar * xr - ai * xi + br, ni = ar * xi + ai * xr + bi; xr = nr; xi = ni;
            float mine = 0.f;
#pragma unroll
            for (int c = 0; c < 16; ++c) { const float y = wave_sum(xr * cre[c] - xi * cim[c]); if (n == c) mine = y; }
            if (n < 16) out[r * D + 16 * g + n] = mine;
        }
    }
}
__device__ __forceinline__ void ph_s5_fast(const Frame& F0) {
    const Frame F = launder(F0);
    if (F.wave < 4) {
        for (int task = blockIdx.x * 4 + F.wave; task < NB * 2 * S5G; task += F.G * 4) {
            const int g = task % S5G, dr = (task / S5G) & 1, b = task / (2 * S5G);
            att::s5_task(F.lane, F.in, F.H(), F.HDb() + (size_t)dr * NR * D, b, g, dr, (char*)(unsigned char*)F.lds + F.wave * att::S5_IMG);
        }
    }
}
__device__ __forceinline__ void ph_s5_combine(const Frame& F0) {
    const Frame F = launder(F0);
    const size_t n4 = (size_t)NR * D / 4, stride = (size_t)F.G * NTHREADS; const f32x4* yf = (const f32x4*)F.HDb(); const f32x4* yb = (const f32x4*)(F.HDb() + (size_t)NR * D);
    for (size_t i0 = (size_t)blockIdx.x * NTHREADS + F.tid; i0 < n4; i0 += 4 * stride) {
        f32x4 dsk[4], f[4], bb[4]; u32x2 hw[4];
#pragma unroll
        for (int k = 0; k < 4; ++k) { const size_t i = i0 + k * stride; dsk[k] = ((const f32x4*)F.in[IN_S5D])[(int)(i % (D / 4))]; hw[k] = ((const u32x2*)F.H())[i]; f[k] = yf[i]; bb[k] = yb[i]; }
#pragma unroll
        for (int k = 0; k < 4; ++k) { const size_t i = i0 + k * stride; f32x4 h; h.x = bf2f(hw[k].x & 0xffffu); h.y = bf2f(hw[k].x >> 16); h.z = bf2f(hw[k].y & 0xffffu); h.w = bf2f(hw[k].y >> 16);
            const f32x4 y = dsk[k] * h + f[k] + bb[k];
            u32x2 w; w.x = pk2(gelu_tanh_f(y.x), gelu_tanh_f(y.y)); w.y = pk2(gelu_tanh_f(y.z), gelu_tanh_f(y.w)); ((u32x2*)F.O())[i] = w; }
    }
}
__device__ __forceinline__ void ph_mlstm_naive(const Frame& F0) {
    const Frame F = launder(F0);
    LAS float* sk = (LAS float*)F.lds; LAS float* sq = sk + 128; LAS float* sn = sq + 128; LAS float* spart = sn + 128; LAS float* snq = spart + 512;
    const int tid = F.tid, v = tid & 255, kh = tid >> 8;
    for (int it = blockIdx.x; it < NB * MH * 2; it += F.G) {
        const int dr = it & 1, hh = (it >> 1) % MH, b = it / (2 * MH);
        float C[64];
#pragma unroll
        for (int i = 0; i < 64; ++i) C[i] = 0.f;
        if (tid < 128) sn[tid] = 0.f;
        float m = 0.f;
        float* out = F.HDb() + (size_t)dr * NR * D;
        __syncthreads();
        for (int s = 0; s < TPB; ++s) {
            int p; if (dr == 0) p = s; else p = s < CTXL ? CTXL - 1 - s : TPB - 1 - (s - CTXL);
            const size_t r = (size_t)b * TPB + p; const bf16* row = F.QKVO() + r * MINW;
            const float ig = F.GATES()[r * 32 + dr * 16 + hh], fg = F.GATES()[r * 32 + dr * 16 + 8 + hh];
            const float logf = fminf(fg, 0.f) - log1pf(expf(-fabsf(fg)));
            const float mn = fmaxf(logf + m, ig); const float fp = expf(logf + m - mn), ip = expf(ig - mn); m = mn;
            const float vv = bf2f(row[2 * MQKW + hh * MDV + v]);
            if (tid < 128) { const float kk = bf2f(row[MQKW + hh * MDQK + tid]) * 0.08838834764831845f, qq = bf2f(row[hh * MDQK + tid]); sk[tid] = kk; sq[tid] = qq;
                const float nn = fp * sn[tid] + ip * kk; sn[tid] = nn; const float pq = wave_sum(nn * qq); if (F.lane == 0) snq[tid >> 6] = pq; }
            __syncthreads();
            float part = 0.f; const float iv = ip * vv;
#pragma unroll
            for (int i = 0; i < 64; ++i) { C[i] = fp * C[i] + iv * sk[kh * 64 + i]; part += C[i] * sq[kh * 64 + i]; }
            spart[kh * 256 + v] = part;
            __syncthreads();
            if (tid < 256) { const float num = spart[v] + spart[256 + v]; const float nq = snq[0] + snq[1]; const float dn = fmaxf(fabsf(nq), expf(-m)); out[r * D + hh * MDV + v] = num / dn; }
            __syncthreads();
        }
    }
}
__device__ __forceinline__ void ph_mlstm_fast(const Frame& F0) {
    const Frame F = launder(F0);
    for (int u = blockIdx.x; u < NB * MH * 2 * 4; u += F.G) {
        const int vq = u & 3, dr = (u >> 2) & 1, hh = (u >> 3) % MH, b = u / (8 * MH);
        att::ph_mlstm_body(F.tid, F.QKVO(), F.GATES(), F.HDb() + (size_t)dr * NR * D, b, hh, dr, vq, (char*)(unsigned char*)F.lds);
    }
}
__device__ __forceinline__ void ph_mlstm_readout(const Frame& F0) {
    const Frame F = launder(F0);
    const int lane = F.lane; const float* h0 = F.HDb(); const float* h1 = F.HDb() + (size_t)NR * D; const float* ng = F.in[IN_MNORMG];
    for (int r = F.gw; r < NR; r += F.NGW) {
        f32x4 a[MH], g[MH]; u32x2 ow[MH];
#pragma unroll
        for (int hh = 0; hh < MH; ++hh) { const size_t off = (size_t)r * D + hh * MDV + 4 * lane; a[hh] = *(const f32x4*)(h0 + off) + *(const f32x4*)(h1 + off); g[hh] = *(const f32x4*)(ng + hh * MDV + 4 * lane);
            ow[hh] = *(const u32x2*)(F.QKVO() + (size_t)r * MINW + 2 * MQKW + MVW + hh * MDV + 4 * lane); }
#pragma unroll
        for (int hh = 0; hh < MH; ++hh) {
            const float ss = wave_sum((a[hh].x * a[hh].x + a[hh].y * a[hh].y) + (a[hh].z * a[hh].z + a[hh].w * a[hh].w)); const float rstd = 1.0f / sqrtf(ss * (1.0f / MDV) + NORM_EPS);
            f32x4 y = a[hh] * rstd * g[hh]; y.x *= sigmoid_f(bf2f(ow[hh].x & 0xffffu)); y.y *= sigmoid_f(bf2f(ow[hh].x >> 16)); y.z *= sigmoid_f(bf2f(ow[hh].y & 0xffffu)); y.w *= sigmoid_f(bf2f(ow[hh].y >> 16));
            u32x2 w; w.x = pk2(y.x, y.y); w.y = pk2(y.z, y.w); *(u32x2*)(F.O() + (size_t)r * D + hh * MDV + 4 * lane) = w; }
    }
}

__global__ void __launch_bounds__(NTHREADS, 2) fwd(Args args) {
    extern __shared__ __attribute__((aligned(16))) unsigned char lds_raw[];
    Frame F; F.lds = (LAS unsigned char*)lds_raw; F.tid = threadIdx.x; F.lane = F.tid & 63; F.wave = __builtin_amdgcn_readfirstlane(F.tid >> 6); F.G = gridDim.x;
    F.gw = blockIdx.x * NWAVES + F.wave; F.NGW = F.G * NWAVES; F.in = args.in; F.out = args.out; F.ws = args.ws;
    unsigned char* ws = args.ws;
    volatile LAS unsigned* MISC = (volatile LAS unsigned*)(F.lds + MISC_OFF);
    if (F.tid < 32) MISC[F.tid] = 0u;
    __syncthreads();
    XcdBarrier bar; bar.bar = (unsigned*)(ws + WS_CTL) + CW_BAR; bar.x = 0; bar.st = nullptr;
#if !MK_PER_PHASE
    bar = xcd_barrier_post((unsigned*)(ws + WS_CTL) + CW_BAR, MISC + 8);
#endif
    const int lo = args.ph_lo, hi = args.ph_hi; int ph = 0;
#define RUN() (lo <= ph && ph < hi)
#if MK_PER_PHASE
#define SEAM() do { ++ph; } while (0)
#else
#define SEAM() do { if (lo <= ph && ph + 1 < hi) xcd_barrier(bar.bar, bar.x, bar.st); ++ph; } while (0)
#endif
#if FAST_GEMM
#define GEMM(DUAL, A, lda, Wf, ldw, Bt, M, N, Nbt, K, doff, E) gemm_fast<DUAL>(F, A, Bt, (M) / 256, 0, Nbt, K, E)
    if (RUN()) { ph_mod(F); ph_cvt_weights(F); } SEAM();
#else
#define GEMM(DUAL, A, lda, Wf, ldw, Bt, M, N, Nbt, K, doff, E) gemm_naive<DUAL>(F, A, lda, Wf, ldw, M, N, K, doff, E)
    if (RUN()) { ph_init(F); ph_mod(F); } SEAM();
#endif
#pragma unroll 1
    for (int L = 0; L < DEPTH; ++L) {
#pragma unroll 1
        for (int half = 0; half < 2; ++half) {
            if (half == 1) {
                const float* pg1 = F.MOD() + ((size_t)(L * 5 + 4) * NMOD + 2) * D;
                if (RUN()) ph_norm<false>(F, L, 1, pg1, 0.5f);
                SEAM();
                const float* g5 = F.MOD() + ((size_t)(L * 5) * NMOD + 5) * D;
                if (L == 0 || L == 3) {
                    const float* wqkv = F.in[L == 0 ? IN_AWQKV : IN_WWQKV]; const float* qkg = F.in[L == 0 ? IN_AQKG : IN_WQKG]; const float* wo = F.in[L == 0 ? IN_AWO : IN_WWO];
                    const bf16* wqkv_t = F.WT() + (L == 0 ? WT_AWQKV : WT_WWQKV); const bf16* wo_t = F.WT() + (L == 0 ? WT_AWO : WT_WWO);
                    if (RUN()) { EpiQKV E{F.Q(), F.K(), F.V()}; GEMM(false, F.H(), D, wqkv, QKVW, wqkv_t, NR, QKVW, QKVW, D, 0, E); } SEAM();
                    if (RUN()) ph_qknorm_rope(F, qkg); SEAM();
#if FAST_ATTN
                    if (L == 0) { if (RUN()) { ph_attn_fast<false>(F, nullptr); if (PROBE_DUP == 3) { __syncthreads(); ph_attn_fast<false>(F, nullptr); } } } else { if (RUN()) { ph_attn_fast<true>(F, F.in[IN_WSINK]); if (PROBE_DUP == 3) { __syncthreads(); ph_attn_fast<true>(F, F.in[IN_WSINK]); } } }
#else
                    if (L == 0) { if (RUN()) ph_attn_naive<false>(F, nullptr); } else { if (RUN()) ph_attn_naive<true>(F, F.in[IN_WSINK]); }
#endif
                    SEAM();
                    if (RUN()) { EpiRmw<0> E{F.X(), g5, nullptr}; gemm_down(F, F.O(), wo_t, D, L == 3 ? 0 : 1, E); } SEAM();
                } else if (L == 1) {
#if FAST_S5
                    if (RUN()) { ph_s5_fast(F); if (PROBE_DUP == 4) { __syncthreads(); ph_s5_fast(F); } } SEAM();
#else
                    if (RUN()) ph_s5_naive(F); SEAM();
#endif
                    if (RUN()) ph_s5_combine(F); SEAM();
                    if (RUN()) { EpiRmw<3> E{F.X(), g5, nullptr}; GEMM(true, F.O(), D, F.in[IN_S5WGLU], 2 * D, F.WT() + WT_GLU, NR, D, 2 * D, D, D, E); } SEAM();
                } else {
                    if (RUN()) { EpiMlstmIn E{F.QKVO(), F.GATES(), F.in[IN_MBGATE]}; gemm_fast<false>(F, F.H(), F.WT() + WT_MWIN, 36, 0, MINW + 256, D, E); } SEAM();
#if FAST_MLSTM
                    if (RUN()) { ph_mlstm_fast(F); if (PROBE_DUP == 4) { __syncthreads(); ph_mlstm_fast(F); } } SEAM();
#else
                    if (RUN()) ph_mlstm_naive(F); SEAM();
#endif
                    if (RUN()) ph_mlstm_readout(F); SEAM();
                    if (RUN()) { EpiRmw<0> E{F.X(), g5, nullptr}; gemm_down(F, F.O(), F.WT() + WT_MWOUT, D, 1, E); } SEAM();
                }
            }
            const int j = half * 2;
            const float* pg0 = (half == 0 && L > 0) ? F.MOD() + ((size_t)((L - 1) * 5 + 4) * NMOD + 8) * D : nullptr;
            if (half == 1 && (L == 0 || L == 2)) pg0 = F.MOD() + ((size_t)(L * 5 + 4) * NMOD + 5) * D;
            if (RUN()) ph_norm<false>(F, L, j, pg0, half == 1 ? 1.0f : 0.5f, L == 0 && half == 0); SEAM();
            const float* wi = F.in[IN_FFNWI] + (size_t)(L * 2 + half) * D * 2 * DFF; const float* wo = F.in[IN_FFNWO] + (size_t)(L * 2 + half) * DFF * D;
            const bf16* wi_t = F.WT() + WT_FFNWI + (size_t)(L * 2 + half) * D * 2 * DFF; const bf16* wo_t = F.WT() + WT_FFNWO + (size_t)(L * 2 + half) * DFF * D;
            const int lastff = (L == DEPTH - 1 && half == 1);
            if (RUN()) { EpiSwiglu E{F.HID()}; gemm_fast<true>(F, F.H(), wi_t, lastff ? 32 : 36, lastff, 2 * DFF, D, E); } SEAM();
            const float* gg = F.MOD() + ((size_t)(L * 5) * NMOD + 3 * j + 2) * D;
            if (lastff) { if (RUN()) { EpiRmw<2> E{F.X(), gg, F.out}; gemm_down(F, F.HID(), wo_t, DFF, 0, E); } }
            else { if (RUN()) { EpiRmw<1> E{F.X(), gg, nullptr}; gemm_down(F, F.HID(), wo_t, DFF, 1, E); } }
            SEAM();
        }
    }
#undef RUN
#undef SEAM
}

constexpr int N_PHASES = 1 + 4 * 6 + (1 + 4) * 2 + (1 + 3) + (1 + 4);

extern "C" void kernel_launch(void* const* d_in, const int* in_sizes, int n_in, void* d_out, int out_size, void* d_ws, size_t ws_size, hipStream_t stream) {
    static int grid = 0;
    if (grid == 0) {
        if (n_in != 30 || out_size != NB * SEQ * D || ws_size < WS_END) { fprintf(stderr, "kernel_launch: unexpected shapes n_in %d out %d ws %zu\n", n_in, out_size, ws_size); grid = -1; return; }
        int dev = 0, cus = 0;
        if (hipGetDevice(&dev) != hipSuccess || hipDeviceGetAttribute(&cus, hipDeviceAttributeMultiprocessorCount, dev) != hipSuccess) { grid = -1; return; }
        if (hipFuncSetAttribute((const void*)fwd, hipFuncAttributeMaxDynamicSharedMemorySize, LDS_BYTES) != hipSuccess) { fprintf(stderr, "kernel_launch: hipFuncSetAttribute failed\n"); grid = -1; return; }
        int per_cu = 0; (void)hipOccupancyMaxActiveBlocksPerMultiprocessor(&per_cu, (const void*)fwd, NTHREADS, LDS_BYTES); (void)hipGetLastError();
        grid = cus;
    }
    if (grid < 0) return;
    (void)hipMemsetAsync((char*)d_ws + WS_CTL, 0, CTL_BYTES, stream);
    Args a{};
    for (int i = 0; i < 30; ++i) a.in[i] = (const float*)d_in[i];
    a.out = (float*)d_out; a.ws = (unsigned char*)d_ws;
#if MK_PER_PHASE
    for (int p = 0; p < N_PHASES; ++p) { a.ph_lo = p; a.ph_hi = p + 1; hipLaunchKernelGGL(fwd, dim3(grid), dim3(NTHREADS), LDS_BYTES, stream, a); }
#else
    a.ph_lo = 0; a.ph_hi = N_PHASES; hipLaunchKernelGGL(fwd, dim3(grid), dim3(NTHREADS), LDS_BYTES, stream, a);
#endif
    const hipError_t le = hipPeekAtLastError();
    if (le != hipSuccess) fprintf(stderr, "kernel_launch: launch failed: %s\n", hipGetErrorName(le));
}
```
